# Optimizing an MI355X kernel written in HIP

```python
import math
import jax
import jax.numpy as jnp
from jax import lax
import numpy as np

D_MODEL = 1024
BATCH = 16
SEQ = 2048
DEPTH = 2

DN_HEAD_DIM = 64
DN_WIDTH = D_MODEL // 4
DN_HEADS = DN_WIDTH // DN_HEAD_DIM
DN_CONV = 4
DN_CHUNK = 64
AT_HEAD_DIM = 64
AT_WIDTH = D_MODEL // 2
AT_HEADS = AT_WIDTH // AT_HEAD_DIM
WINDOWS = ((128, 1), (512, 4), (2048, 16))
AT_BLOCK = 128
N_BUCKETS = 32
MAX_DISTANCE = 2048
CV_WIDTH = D_MODEL // 4
CV_KERNEL = 31
MIX_WIDTH = DN_WIDTH + AT_WIDTH + CV_WIDTH
N_IN = 4 * DN_WIDTH + 2 * DN_HEADS + 3 * AT_WIDTH + 2 * CV_WIDTH
N_GROUPS = 4
EXPERTS_PER_GROUP = 8
N_EXPERTS = N_GROUPS * EXPERTS_PER_GROUP
TOP_K = 2
D_EXPERT = D_MODEL // 2
MOE_BLOCK = 128
NEG_INF = -1e30
EPS = 1e-6

kernel_name = 'hymba_style_deltanet_dilated_conformer_hmoe'


def _rms_norm(x, g):
    xf = x.astype(jnp.float32)
    return (xf * lax.rsqrt(jnp.mean(xf * xf, axis=-1, keepdims=True) + EPS) * g).astype(x.dtype)


def _layer_norm(x, g, b):
    xf = x.astype(jnp.float32)
    mu = jnp.mean(xf, axis=-1, keepdims=True)
    var = jnp.mean(jnp.square(xf - mu), axis=-1, keepdims=True)
    return ((xf - mu) * lax.rsqrt(var + EPS) * g + b).astype(x.dtype)


def _l2norm(x):
    return x * lax.rsqrt(jnp.sum(x * x, axis=-1, keepdims=True) + EPS)


def _causal_depthwise_conv(x, w):
    width, ch = w.shape
    return lax.conv_general_dilated(x, w[:, None, :], window_strides=(1,), padding=[(width - 1, 0)],
                                    dimension_numbers=('NWC', 'WIO', 'NWC'), feature_group_count=ch)


def _chunked_gated_delta_rule(q, k, v, g, beta):
    bsz, heads, seq, dk = q.shape
    dv = v.shape[-1]
    n = seq // DN_CHUNK
    q, k, v = (t.reshape(bsz, heads, n, DN_CHUNK, t.shape[-1]) for t in (q, k, v))
    g, beta = (t.reshape(bsz, heads, n, DN_CHUNK) for t in (g, beta))
    G = jnp.cumsum(g, axis=-1)
    idx = jnp.arange(DN_CHUNK)
    causal = idx[:, None] >= idx[None, :]
    strict = idx[:, None] > idx[None, :]
    decay = jnp.exp(jnp.where(causal, G[..., :, None] - G[..., None, :], -jnp.inf))
    kb = k * beta[..., None]
    a_mat = jnp.where(strict, jnp.einsum('bhnid,bhnjd->bhnij', kb, k) * decay, 0.0)
    eye = jnp.eye(DN_CHUNK, dtype=a_mat.dtype)
    t_mat = lax.linalg.triangular_solve(a_mat + eye, jnp.broadcast_to(eye, a_mat.shape),
                                        left_side=True, lower=True, unit_diagonal=True)
    e_g = jnp.exp(G)[..., None]
    w_mat = t_mat @ (kb * e_g)
    u_mat = t_mat @ (v * beta[..., None])
    qk = jnp.einsum('bhnid,bhnjd->bhnij', q, k) * decay
    q_dec = q * e_g
    k_dec = k * jnp.exp(G[..., -1:] - G)[..., None]
    g_last = jnp.exp(G[..., -1])[..., None, None]

    def step(state, xs):
        w_c, u_c, qk_c, qd_c, kd_c, gl_c = xs
        v_new = u_c - w_c @ state
        o_c = qd_c @ state + qk_c @ v_new
        state = state * gl_c + jnp.swapaxes(kd_c, -1, -2) @ v_new
        return state, o_c

    xs = tuple(jnp.moveaxis(t, 2, 0) for t in (w_mat, u_mat, qk, q_dec, k_dec, g_last))
    state0 = jnp.zeros((bsz, heads, dk, dv), q.dtype)
    _, o = lax.scan(step, state0, xs)
    return jnp.moveaxis(o, 0, 2).reshape(bsz, heads, seq, dv)


def _gated_deltanet(q, k, v, z, a, b, conv_w, a_log, dt_bias, out_norm):
    out_dtype = q.dtype
    bsz, seq, _ = q.shape
    qkv = jax.nn.silu(_causal_depthwise_conv(jnp.concatenate([q, k, v], axis=-1), conv_w))
    q, k, v = jnp.split(qkv, 3, axis=-1)

    def heads(t):
        return t.reshape(bsz, seq, DN_HEADS, DN_HEAD_DIM).transpose(0, 2, 1, 3).astype(jnp.float32)

    q, k, v = heads(q), heads(k), heads(v)
    q = _l2norm(q) * (DN_HEAD_DIM ** -0.5)
    k = _l2norm(k)
    beta = jnp.swapaxes(jax.nn.sigmoid(b.astype(jnp.float32)), 1, 2)
    g = -jnp.exp(a_log.astype(jnp.float32)) * jax.nn.softplus(a.astype(jnp.float32) + dt_bias.astype(jnp.float32))
    g = jnp.swapaxes(g, 1, 2)
    o = jnp.swapaxes(_chunked_gated_delta_rule(q, k, v, g, beta), 1, 2)
    zf = z.reshape(bsz, seq, DN_HEADS, DN_HEAD_DIM).astype(jnp.float32)
    o = _rms_norm(o, out_norm.astype(jnp.float32)) * jax.nn.silu(zf)
    return o.reshape(bsz, seq, DN_WIDTH).astype(out_dtype)


def _t5_bucket(dist):
    max_exact = N_BUCKETS // 2
    d = jnp.maximum(dist, 1).astype(jnp.float32)
    log_bucket = max_exact + (jnp.log(d / max_exact) / math.log(MAX_DISTANCE / max_exact)
                              * (N_BUCKETS - max_exact)).astype(jnp.int32)
    return jnp.where(dist < max_exact, dist, jnp.minimum(log_bucket, N_BUCKETS - 1))


def _dilated_band_attention(q, k, v, rel_bias, window, dilation):
    bsz, seq, heads, hd = q.shape
    n_back = window // dilation
    length = seq // dilation
    padded = -(-length // AT_BLOCK) * AT_BLOCK
    nb = padded // AT_BLOCK
    bs = bsz * dilation

    def strided(t):
        t = t.reshape(bsz, length, dilation, heads, hd).transpose(0, 2, 1, 3, 4)
        return t.reshape(bs, length, heads, hd)

    qs = jnp.pad(strided(q), ((0, 0), (0, padded - length), (0, 0), (0, 0))).reshape(bs, nb, AT_BLOCK, heads, hd)

    def band(t):
        t = jnp.pad(strided(t), ((0, 0), (AT_BLOCK, padded - length), (0, 0), (0, 0)))
        t = t.reshape(bs, nb + 1, AT_BLOCK, heads, hd)
        return jnp.concatenate([t[:, :-1], t[:, 1:]], axis=2)

    kb, vb = band(k), band(v)
    rel = jnp.arange(AT_BLOCK)[:, None] + AT_BLOCK - jnp.arange(2 * AT_BLOCK)[None, :]
    key_idx = (jnp.arange(nb)[:, None] - 1) * AT_BLOCK + jnp.arange(2 * AT_BLOCK)[None, :]
    valid = ((rel >= 0) & (rel <= n_back))[None] & (key_idx >= 0)[:, None, :]
    bias = rel_bias[_t5_bucket(dilation * jnp.clip(rel, 0, n_back))]
    scores = jnp.einsum('bnqhd,bnkhd->bnhqk', qs, kb) + jnp.transpose(bias, (2, 0, 1))
    scores = jnp.where(valid[None, :, None], scores, NEG_INF)
    m = jnp.max(scores, axis=-1, keepdims=True)
    p = jnp.exp(scores - m)
    s = jnp.sum(p, axis=-1)
    o = jnp.einsum('bnhqk,bnkhd->bnqhd', p, vb) / jnp.swapaxes(s, 2, 3)[..., None]
    lse = jnp.swapaxes(m[..., 0] + jnp.log(s), 2, 3)

    def unstrided(t):
        t = t.reshape(bsz, dilation, padded, *t.shape[3:])[:, :, :length]
        t = jnp.swapaxes(t, 1, 2)
        return t.reshape(bsz, seq, *t.shape[3:])

    return unstrided(o), unstrided(lse)


def _dilated_attention(q, k, v, q_norm, k_norm, rel_bias):
    out_dtype = q.dtype
    bsz, seq, _ = q.shape

    def heads(t):
        return t.reshape(bsz, seq, AT_HEADS, AT_HEAD_DIM)

    q = _rms_norm(heads(q), q_norm).astype(jnp.float32) * (AT_HEAD_DIM ** -0.5)
    k = _rms_norm(heads(k), k_norm).astype(jnp.float32)
    v = heads(v).astype(jnp.float32)
    table = rel_bias.astype(jnp.float32)
    outs, lses = [], []
    for window, dilation in WINDOWS:
        o_g, lse_g = _dilated_band_attention(q, k, v, table, window, dilation)
        outs.append(o_g)
        lses.append(lse_g)
    weights = jax.nn.softmax(jnp.stack(lses), axis=0)
    o = jnp.einsum('gbsh,gbshd->bshd', weights, jnp.stack(outs))
    return o.reshape(bsz, seq, AT_WIDTH).astype(out_dtype)


def _conformer_conv(u, dw, dw_b, ln_g, ln_b):
    a, gate = jnp.split(u, 2, axis=-1)
    y = a * jax.nn.sigmoid(gate)
    y = _causal_depthwise_conv(y, dw) + dw_b
    y = _layer_norm(y, ln_g, ln_b)
    return jax.nn.silu(y)


def _hierarchical_moe(h, rg_w, rg_b, re_w, re_b, w_gate, w_up, w_down):
    bsz, seq, d = h.shape
    xt = h.reshape(-1, d)
    n_tok = xt.shape[0]
    g_logits = (xt @ rg_w).astype(jnp.float32) + rg_b.astype(jnp.float32)
    g_sel = jnp.argmax(g_logits, axis=-1)
    p_group = jnp.take_along_axis(jax.nn.softmax(g_logits, axis=-1), g_sel[:, None], axis=-1)
    e_logits = ((xt @ re_w).astype(jnp.float32) + re_b.astype(jnp.float32)).reshape(n_tok, N_GROUPS, EXPERTS_PER_GROUP)
    e_logits = jnp.take_along_axis(e_logits, g_sel[:, None, None], axis=1)[:, 0]
    top_v, top_i = lax.top_k(e_logits, TOP_K)
    gate = p_group * jax.nn.softmax(top_v, axis=-1)
    expert_id = g_sel[:, None] * EXPERTS_PER_GROUP + top_i

    n_assign = n_tok * TOP_K
    flat_e = expert_id.reshape(-1)
    order = jnp.argsort(flat_e)
    sorted_e = flat_e[order]
    tok = order // TOP_K
    counts = jnp.bincount(flat_e, length=N_EXPERTS)
    padded = (counts + MOE_BLOCK - 1) // MOE_BLOCK * MOE_BLOCK
    pad_end = jnp.cumsum(padded)
    pad_start = pad_end - padded
    start = jnp.cumsum(counts) - counts
    dest = pad_start[sorted_e] + jnp.arange(n_assign) - start[sorted_e]
    n_blocks = n_assign // MOE_BLOCK + N_EXPERTS
    buf = jnp.zeros((n_blocks * MOE_BLOCK, d), xt.dtype).at[dest].set(xt[tok])
    block_expert = jnp.minimum(jnp.searchsorted(pad_end, jnp.arange(n_blocks) * MOE_BLOCK, side='right'), N_EXPERTS - 1)

    def expert_block(args):
        xb, e = args
        hb = jax.nn.silu(xb @ w_gate[e]) * (xb @ w_up[e])
        return hb @ w_down[e]

    yb = lax.map(expert_block, (buf.reshape(n_blocks, MOE_BLOCK, d), block_expert))
    y_sorted = yb.reshape(-1, d)[dest] * gate.reshape(-1)[order][:, None].astype(xt.dtype)
    out = jnp.zeros((n_tok, d), xt.dtype).at[tok].add(y_sorted)
    return out.reshape(bsz, seq, d)


def setup_inputs(seed: int = 0) -> dict:
    key = jax.random.key(seed)
    ks = jax.random.split(key, 24)
    L = DEPTH

    def nrm(k, shape, scale):
        return jax.random.normal(k, shape, jnp.float32) * scale

    dt = jnp.exp(jax.random.uniform(ks[5], (L, DN_HEADS), minval=math.log(1e-3), maxval=math.log(1e-1)))
    return {
        'x': nrm(ks[0], (BATCH, SEQ, D_MODEL), 1.0),
        'norm_mix': 1.0 + nrm(ks[1], (L, D_MODEL), 0.02),
        'w_in': nrm(ks[2], (L, D_MODEL, N_IN), D_MODEL ** -0.5),
        'dn_conv': nrm(ks[3], (L, DN_CONV, 3 * DN_WIDTH), DN_CONV ** -0.5),
        'dn_a_log': jnp.log(jax.random.uniform(ks[4], (L, DN_HEADS), minval=1.0, maxval=16.0)),
        'dn_dt_bias': dt + jnp.log(-jnp.expm1(-dt)),
        'dn_out_norm': 1.0 + nrm(ks[6], (L, DN_HEAD_DIM), 0.02),
        'at_q_norm': 1.0 + nrm(ks[7], (L, AT_HEAD_DIM), 0.02),
        'at_k_norm': 1.0 + nrm(ks[8], (L, AT_HEAD_DIM), 0.02),
        'rel_bias': nrm(ks[9], (N_BUCKETS, AT_HEADS), 0.5),
        'cv_dw': nrm(ks[10], (L, CV_KERNEL, CV_WIDTH), CV_KERNEL ** -0.5),
        'cv_dw_bias': nrm(ks[11], (L, CV_WIDTH), 0.02),
        'cv_ln_g': 1.0 + nrm(ks[12], (L, CV_WIDTH), 0.02),
        'cv_ln_b': nrm(ks[13], (L, CV_WIDTH), 0.02),
        'w_out': nrm(ks[14], (L, MIX_WIDTH, D_MODEL), MIX_WIDTH ** -0.5),
        'norm_ffn': 1.0 + nrm(ks[15], (L, D_MODEL), 0.02),
        'router_group_w': nrm(ks[16], (L, D_MODEL, N_GROUPS), D_MODEL ** -0.5),
        'router_group_b': nrm(ks[17], (L, N_GROUPS), 0.01),
        'router_expert_w': nrm(ks[18], (L, D_MODEL, N_EXPERTS), D_MODEL ** -0.5),
        'router_expert_b': nrm(ks[19], (L, N_EXPERTS), 0.01),
        'ex_gate': nrm(ks[20], (L, N_EXPERTS, D_MODEL, D_EXPERT), D_MODEL ** -0.5),
        'ex_up': nrm(ks[21], (L, N_EXPERTS, D_MODEL, D_EXPERT), D_MODEL ** -0.5),
        'ex_down': nrm(ks[22], (L, N_EXPERTS, D_EXPERT, D_MODEL), D_EXPERT ** -0.5),
    }


def reference(x, norm_mix, w_in, dn_conv, dn_a_log, dn_dt_bias, dn_out_norm, at_q_norm, at_k_norm,
              rel_bias, cv_dw, cv_dw_bias, cv_ln_g, cv_ln_b, w_out, norm_ffn, router_group_w,
              router_group_b, router_expert_w, router_expert_b, ex_gate, ex_up, ex_down):
    splits = [DN_WIDTH] * 4 + [DN_HEADS] * 2 + [AT_WIDTH] * 3 + [2 * CV_WIDTH]
    offsets = [int(o) for o in np.cumsum(splits)[:-1]]
    for layer in range(DEPTH):
        h = _rms_norm(x, norm_mix[layer])
        proj = h @ w_in[layer]
        dq, dk, dv, dz, da, db, aq, ak, av, cu = jnp.split(proj, offsets, axis=-1)
        y_dn = _gated_deltanet(dq, dk, dv, dz, da, db, dn_conv[layer], dn_a_log[layer],
                               dn_dt_bias[layer], dn_out_norm[layer])
        y_at = _dilated_attention(aq, ak, av, at_q_norm[layer], at_k_norm[layer], rel_bias)
        y_cv = _conformer_conv(cu, cv_dw[layer], cv_dw_bias[layer], cv_ln_g[layer], cv_ln_b[layer])
        mixed = jnp.concatenate([y_dn, y_at, y_cv], axis=-1).astype(x.dtype)
        x = x + mixed @ w_out[layer]
        h = _rms_norm(x, norm_ffn[layer])
        x = x + _hierarchical_moe(h, router_group_w[layer], router_group_b[layer], router_expert_w[layer],
                                  router_expert_b[layer], ex_gate[layer], ex_up[layer], ex_down[layer])
    return x
```

```cpp
#include <hip/hip_runtime.h>
#include <cstdio>
#include <cstdint>

#ifndef MK_ONE_LAUNCH
#define MK_ONE_LAUNCH 1
#endif

#define LAS __attribute__((address_space(3)))
#define GAS __attribute__((address_space(1)))
typedef unsigned short bf16_t;
typedef short bf16x8 __attribute__((ext_vector_type(8)));
typedef float f32x4 __attribute__((ext_vector_type(4)));
typedef float f32x2 __attribute__((ext_vector_type(2)));
typedef unsigned u32x4 __attribute__((ext_vector_type(4)));
typedef unsigned u32x2 __attribute__((ext_vector_type(2)));
typedef GAS unsigned gu32;
#define RLX_AGENT __ATOMIC_RELAXED, __HIP_MEMORY_SCOPE_AGENT
#define LDS_WAIT() asm volatile("s_waitcnt lgkmcnt(0)" ::: "memory")
#define VM_WAIT() asm volatile("s_waitcnt vmcnt(0)" ::: "memory")

constexpr int D = 1024, BATCH = 16, SEQ = 2048, M = BATCH * SEQ, NLAYER = 2;
constexpr int NIN = 3080, NPROJ = 3072;
constexpr int HD = 64, DNH = 4, ATH = 8, CVW = 256, CVK = 31;
constexpr int NGRP = 4, EPG = 8, NE = 32, DE = 512;
constexpr float EPS = 1e-6f;
constexpr int C_DQ = 0, C_DK = 256, C_DV = 512, C_DZ = 768, C_AQ = 1024, C_AK = 1536, C_AV = 2048, C_CU = 2560, C_CG = 2816;
constexpr int NWAVES = 8, NTHREADS = 512;

constexpr size_t MiB = 1u << 20;
constexpr size_t WS_CTL = 0, CTL_ZERO_BYTES = 1 * MiB;
constexpr size_t WS_WIN = 1 * MiB;
constexpr size_t WS_WOUT = 7 * MiB;
constexpr size_t WS_AB = 9 * MiB;
constexpr size_t WS_LTOK = 10 * MiB;
constexpr size_t WS_LGATE = 14 * MiB;
constexpr size_t WS_WGU = 18 * MiB;
constexpr size_t WS_WD = 82 * MiB;
constexpr size_t WS_H = 114 * MiB;
constexpr size_t WS_MIXED = 178 * MiB;
constexpr size_t WS_A = 242 * MiB;
constexpr size_t WS_END = 434 * MiB;
constexpr size_t WS_SCR = WS_WGU;
constexpr size_t WS_O = WS_H;
constexpr int CW_BAR = 4096;
constexpr int CW_CNT = 8192;

constexpr int RING_BYTES = 131072;
constexpr int LDSCTL_OFF = RING_BYTES;
constexpr int LDS_BYTES = 155648;
constexpr int MISC_OFF = LDSCTL_OFF;
constexpr int MOE_OFF = LDSCTL_OFF + 256;

__device__ __forceinline__ float bf2f(unsigned v) { return __uint_as_float(v << 16); }
__device__ __forceinline__ unsigned f2bf(float f) { unsigned u = __float_as_uint(f); return (u + 0x7fffu + ((u >> 16) & 1u)) >> 16; }
__device__ __forceinline__ unsigned pk2(float lo, float hi) { return f2bf(lo) | (f2bf(hi) << 16); }
__device__ __forceinline__ float wave_sum(float v) {
#pragma unroll
    for (int o = 1; o < 64; o <<= 1) v += __shfl_xor(v, o);
    return v;
}
__device__ __forceinline__ float wave_max(float v) {
#pragma unroll
    for (int o = 1; o < 64; o <<= 1) v = fmaxf(v, __shfl_xor(v, o));
    return v;
}
__device__ __forceinline__ float sigm(float x) { return 1.f / (1.f + expf(-x)); }
__device__ __forceinline__ float siluf(float x) { return x * sigm(x); }

namespace pg8 {
constexpr int BM = 256, BK = 64, HALF = 128, HTB = HALF * BK * 2, STAGE_BYTES = 8 * HTB, NXCD = 8, WGM = 8;
__host__ __device__ __forceinline__ int lds_byte(int r, int c) { const int st = (r >> 4) * 2 + (c >> 5), rr = r & 15, cc = c & 31, ob = rr * 64 + cc * 2; return st * 1024 + (ob ^ (((ob >> 9) & 1) << 5)); }
__host__ __device__ __forceinline__ void stage_rc(int b, int& R, int& C) { const int st = b / 1024, sb = b % 1024, swz = sb ^ (((sb >> 9) & 1) << 5); R = (st >> 1) * 16 + swz / 64; C = (st & 1) * 32 + (swz % 64) / 2; }
__host__ __device__ __forceinline__ int perm32(int rho) { const int n = rho >> 4, i = rho & 15; return 8 * (i >> 2) + 4 * n + (i & 3); }
__device__ __forceinline__ unsigned cvt_pk_bf16(float lo, float hi) { unsigned r; asm volatile("v_cvt_pk_bf16_f32 %0, %1, %2" : "=v"(r) : "v"(lo), "v"(hi)); return r; }

template <class Epi, class Sched>
__device__ __forceinline__ void gemm_phase(LAS unsigned char* lds, const bf16_t* Abase, const int K, const Sched& S, const Epi& E) {
    int tid_ = threadIdx.x; asm volatile("" : "+v"(tid_));
    const int tid = tid_, wid = __builtin_amdgcn_readfirstlane(tid >> 6), lane = tid & 63, wr = wid >> 2, wc = wid & 3, fr = lane & 15, fq = lane >> 4;
    const int nt = K / BK;
    int Rr[2], Cc2[2]; unsigned voffB[2];
#pragma unroll
    for (int i = 0; i < 2; ++i) { int R, C; stage_rc(tid * 16 + i * 8192, R, C); const int Rb = Epi::PERM ? ((R & ~31) + perm32(R & 31)) : R;
        Rr[i] = R; Cc2[i] = C * 2; voffB[i] = (unsigned)(Rb * K + C) * 2u; }
    const size_t kstep = (size_t)(BK * 2);
    const size_t hstep = (size_t)HALF * K * 2;
    const unsigned ldsw = (unsigned)wid * 1024u;
    const int aoff = lds_byte(wr * 64 + fr, fq * 8), boff = lds_byte(wc * 32 + fr, fq * 8);
    const char* Ab = (const char*)Abase;
#define PG8_SA(b, h) (((b) * 2 + (h)) * HTB)
#define PG8_SB(b, h) ((4 + (b) * 2 + (h)) * HTB)
#define PG8_STAGE(bufoff, gbase, voff) do { _Pragma("unroll") for (int _i = 0; _i < 2; ++_i) \
        __builtin_amdgcn_global_load_lds((const unsigned*)((const char*)(gbase) + (voff)[_i]), (LAS unsigned*)(lds + (bufoff) + ldsw + _i * 8192), 16, 0, 0); } while (0)
#define PG8_LDA(dst, b, h) do { _Pragma("unroll") for (int m = 0; m < 4; ++m) _Pragma("unroll") for (int k = 0; k < 2; ++k) dst[m][k] = *(const LAS bf16x8*)(lds + PG8_SA(b, h) + aoff + m * 2048 + k * 1024); } while (0)
#define PG8_LDB(dst, b, h) do { _Pragma("unroll") for (int n = 0; n < 2; ++n) _Pragma("unroll") for (int k = 0; k < 2; ++k) dst[n][k] = *(const LAS bf16x8*)(lds + PG8_SB(b, h) + boff + n * 2048 + k * 1024); } while (0)
#define PG8_MMA(ai, bj, At, Bt) do { __builtin_amdgcn_s_setprio(1); _Pragma("unroll") for (int m = 0; m < 4; ++m) _Pragma("unroll") for (int n = 0; n < 2; ++n) _Pragma("unroll") for (int k = 0; k < 2; ++k) \
        acc[ai][bj][m][n] = __builtin_amdgcn_mfma_f32_16x16x32_bf16(Bt[n][k], At[m][k], acc[ai][bj][m][n], 0, 0, 0); __builtin_amdgcn_s_setprio(0); } while (0)
#define PG8_WAIT_V(n) asm volatile("s_waitcnt vmcnt(" #n ")" ::: "memory")
#define PG8_WAIT_L(n) asm volatile("s_waitcnt lgkmcnt(" #n ")" ::: "memory")
#define PG8_BAR __builtin_amdgcn_s_barrier()
#define PG8_SCHED __builtin_amdgcn_sched_barrier(0)
    typename Sched::Unit cur, nxt; int ui = 0;
    if (!S.next(0, cur)) return;
    unsigned va0[2], va1[2], vn0[2], vn1[2];
    const char* cA = Ab; const char* nA = Ab;
    if constexpr (Sched::GATHER) {
#pragma unroll
        for (int i = 0; i < 2; ++i) { va0[i] = S.a_off(cur, Rr[i]) + (unsigned)Cc2[i]; va1[i] = S.a_off(cur, HALF + Rr[i]) + (unsigned)Cc2[i]; }
    } else {
#pragma unroll
        for (int i = 0; i < 2; ++i) { va0[i] = (unsigned)(Rr[i] * K * 2 + Cc2[i]); va1[i] = va0[i] + (unsigned)hstep; vn0[i] = va0[i]; vn1[i] = va1[i]; }
        cA = Ab + S.a_base(cur);
    }
    f32x4 acc[2][2][4][2];
#pragma unroll
    for (int a = 0; a < 2; ++a)
#pragma unroll
        for (int b = 0; b < 2; ++b)
#pragma unroll
            for (int m = 0; m < 4; ++m)
#pragma unroll
                for (int n = 0; n < 2; ++n) acc[a][b][m][n] = (f32x4){0.f, 0.f, 0.f, 0.f};
    bf16x8 At[4][2], B0[2][2], B1[2][2];
    const char* cB = S.b_base(cur);
    PG8_STAGE(PG8_SB(0, 0), cB, voffB); PG8_STAGE(PG8_SB(0, 1), cB + hstep, voffB); PG8_STAGE(PG8_SA(0, 0), cA, va0); PG8_STAGE(PG8_SA(0, 1), cA, va1);
    if (wr == 1) PG8_BAR;
    PG8_WAIT_V(2); PG8_BAR;
    PG8_STAGE(PG8_SB(1, 0), cB + kstep, voffB); PG8_STAGE(PG8_SA(1, 0), cA + kstep, va0); PG8_STAGE(PG8_SB(1, 1), cB + hstep + kstep, voffB);
    PG8_WAIT_V(6); PG8_BAR;
    for (;;) {
        const bool has_next = S.next(ui + 1, nxt);
        const char* nB = cB; nA = cA;
        if (has_next) { nB = S.b_base(nxt);
            if constexpr (Sched::GATHER) {
#pragma unroll
                for (int i = 0; i < 2; ++i) { vn0[i] = S.a_off(nxt, Rr[i]) + (unsigned)Cc2[i]; vn1[i] = S.a_off(nxt, HALF + Rr[i]) + (unsigned)Cc2[i]; }
            } else nA = Ab + S.a_base(nxt);
        } else if constexpr (Sched::GATHER) {
#pragma unroll
            for (int i = 0; i < 2; ++i) { vn0[i] = va0[i]; vn1[i] = va1[i]; } }
        for (int t = 0; t < nt; t += 2) {
            const bool last = (t == nt - 2);
            const char* a1 = cA + (size_t)(t + 1) * kstep;
            const char* a2 = last ? nA : cA + (size_t)(t + 2) * kstep; const char* b2 = last ? nB : cB + (size_t)(t + 2) * kstep;
            const char* a3 = a2 + kstep; const char* b3 = b2 + kstep;
            unsigned w0[2], w1[2];
#pragma unroll
            for (int i = 0; i < 2; ++i) { if constexpr (Sched::GATHER) { w0[i] = last ? vn0[i] : va0[i]; w1[i] = last ? vn1[i] : va1[i]; } else { w0[i] = va0[i]; w1[i] = va1[i]; } }
            PG8_LDB(B0, 0, 0); PG8_LDB(B1, 0, 1); PG8_SCHED; PG8_LDA(At, 0, 0); PG8_STAGE(PG8_SA(1, 1), a1, va1);
            PG8_WAIT_V(8); PG8_WAIT_L(0); PG8_BAR; PG8_MMA(0, 0, At, B0); PG8_MMA(0, 1, At, B1); PG8_BAR; PG8_SCHED;
            PG8_LDA(At, 0, 1); PG8_STAGE(PG8_SB(0, 0), b2, voffB); PG8_STAGE(PG8_SB(0, 1), b2 + hstep, voffB); PG8_STAGE(PG8_SA(0, 0), a2, w0);
            PG8_WAIT_V(8); PG8_WAIT_L(0); PG8_BAR; PG8_MMA(1, 0, At, B0); PG8_MMA(1, 1, At, B1); PG8_BAR; PG8_SCHED;
            PG8_LDB(B0, 1, 0); PG8_LDB(B1, 1, 1); PG8_SCHED; PG8_LDA(At, 1, 0); PG8_STAGE(PG8_SA(0, 1), a2, w1);
            PG8_WAIT_V(8); PG8_WAIT_L(0); PG8_BAR; PG8_MMA(0, 0, At, B0); PG8_MMA(0, 1, At, B1); PG8_BAR; PG8_SCHED;
            PG8_LDA(At, 1, 1); PG8_STAGE(PG8_SB(1, 0), b3, voffB); PG8_STAGE(PG8_SB(1, 1), b3 + hstep, voffB); PG8_STAGE(PG8_SA(1, 0), a3, w0);
            PG8_WAIT_V(8); PG8_WAIT_L(0); PG8_BAR; PG8_MMA(1, 0, At, B0); PG8_MMA(1, 1, At, B1); PG8_BAR; PG8_SCHED;
        }
        if (wr == 0) PG8_BAR;
        E(acc, cur, wr, wc, fr, fq);
        if (!has_next) break;
#pragma unroll
        for (int a = 0; a < 2; ++a)
#pragma unroll
            for (int b = 0; b < 2; ++b)
#pragma unroll
                for (int m = 0; m < 4; ++m)
#pragma unroll
                    for (int n = 0; n < 2; ++n) acc[a][b][m][n] = (f32x4){0.f, 0.f, 0.f, 0.f};
        cur = nxt; cB = nB; cA = nA; ++ui;
        if constexpr (Sched::GATHER) {
#pragma unroll
            for (int i = 0; i < 2; ++i) { va0[i] = vn0[i]; va1[i] = vn1[i]; } }
        if (wr == 1) PG8_BAR;
    }
    PG8_WAIT_V(0);
    PG8_BAR;
#undef PG8_SA
#undef PG8_SB
#undef PG8_STAGE
#undef PG8_LDA
#undef PG8_LDB
#undef PG8_MMA
#undef PG8_WAIT_V
#undef PG8_WAIT_L
#undef PG8_BAR
#undef PG8_SCHED
}

struct DUnit { int pm, pn; };
template <int NM, int NN>
struct DenseSched {
    typedef DUnit Unit; static constexpr bool GATHER = false;
    int G, c, K; const bf16_t* Bt;
    __device__ __forceinline__ bool next(int i, Unit& u) const {
        constexpr int nwg = NM * NN, q = nwg / NXCD; static_assert(nwg % NXCD == 0 && NM % WGM == 0, "tile counts");
        const int L = i * G + c; if (L >= nwg) return false;
        const int wgid = (L % NXCD) * q + L / NXCD;
        constexpr int nig = WGM * NN; const int gid = wgid / nig, fm = gid * WGM;
        u.pm = fm + ((wgid % nig) % WGM); u.pn = (wgid % nig) / WGM; return true;
    }
    __device__ __forceinline__ size_t a_base(const Unit& u) const { return (size_t)u.pm * BM * K * 2; }
    __device__ __forceinline__ unsigned a_off(const Unit&, int) const { return 0u; }
    __device__ __forceinline__ const char* b_base(const Unit& u) const { return (const char*)(Bt + (size_t)u.pn * BM * K); }
};
struct MUnit { int e, mt, pn, cnt, hoff; };
template <bool DOWN>
struct MoeSched {
    typedef MUnit Unit; static constexpr bool GATHER = true;
    __device__ __forceinline__ size_t a_base(const Unit&) const { return 0; }
    const LAS int* cntL; const LAS int* hoffL; const LAS int* tstartL;
    int G, vc; const int* ltok; const bf16_t* Bt;
    __device__ __forceinline__ bool next(int i, Unit& u) const {
        const int total = tstartL[NE] * 4; const long L = (long)i * G + vc; if (L >= total) return false;
        const int mtg = (int)L >> 2; u.pn = (int)L & 3;
        int e = 0;
#pragma unroll 1
        for (int k = 1; k < NE; ++k) if (tstartL[k] <= mtg) e = k;
        u.e = e; u.mt = mtg - tstartL[e]; u.cnt = cntL[e]; u.hoff = hoffL[e]; return true;
    }
    __device__ __forceinline__ unsigned a_off(const Unit& u, int row) const {
        int idx = u.mt * BM + row; idx = idx < u.cnt ? idx : u.cnt - 1;
        if (DOWN) return (unsigned)(u.hoff + idx) * (unsigned)(DE * 2);
        const int t2 = ltok[(size_t)u.e * M + idx]; return (unsigned)(t2 >> 1) * (unsigned)(D * 2);
    }
    __device__ __forceinline__ const char* b_base(const Unit& u) const { return (const char*)(Bt + ((size_t)u.e * 1024 + (size_t)u.pn * BM) * (DOWN ? DE : D)); }
};

struct EpiProj {
    static constexpr bool PERM = true;
    bf16_t* O; int ldc;
    __device__ __forceinline__ void operator()(const f32x4 (&acc)[2][2][4][2], const DUnit& u, int wr, int wc, int fr, int fq) const {
        const int row0 = u.pm * BM + wr * 64 + fr, col0 = u.pn * BM + wc * 32 + 8 * fq;
#pragma unroll
        for (int ai = 0; ai < 2; ++ai)
#pragma unroll
            for (int m = 0; m < 4; ++m) { bf16_t* rowp = O + (size_t)(row0 + ai * HALF + m * 16) * ldc + col0;
#pragma unroll
                for (int bj = 0; bj < 2; ++bj) { const f32x4 v0 = acc[ai][bj][m][0], v1 = acc[ai][bj][m][1];
                    u32x4 w; w.x = cvt_pk_bf16(v0[0], v0[1]); w.y = cvt_pk_bf16(v0[2], v0[3]); w.z = cvt_pk_bf16(v1[0], v1[1]); w.w = cvt_pk_bf16(v1[2], v1[3]);
                    *(u32x4*)(rowp + bj * HALF) = w; } }
    }
};
struct EpiResid {
    static constexpr bool PERM = false;
    const float* resid; float* out; int ldc;
    __device__ __forceinline__ void operator()(const f32x4 (&acc)[2][2][4][2], const DUnit& u, int wr, int wc, int fr, int fq) const {
        const int row0 = u.pm * BM + wr * 64 + fr, col0 = u.pn * BM + wc * 32 + 4 * fq;
#pragma unroll
        for (int ai = 0; ai < 2; ++ai)
#pragma unroll
            for (int m = 0; m < 4; ++m) { const size_t off = (size_t)(row0 + ai * HALF + m * 16) * ldc + col0;
#pragma unroll
                for (int bj = 0; bj < 2; ++bj)
#pragma unroll
                    for (int n = 0; n < 2; ++n) { const f32x4 r = *(const f32x4*)(resid + off + bj * HALF + n * 16); *(f32x4*)(out + off + bj * HALF + n * 16) = r + acc[ai][bj][m][n]; } }
    }
};
struct EpiGU {
    static constexpr bool PERM = true;
    bf16_t* HID;
    __device__ __forceinline__ void operator()(const f32x4 (&acc)[2][2][4][2], const MUnit& u, int wr, int wc, int fr, int fq) const {
        const int r0 = wr * 64 + fr, j0 = u.pn * 128 + wc * 16 + 4 * fq;
#pragma unroll
        for (int ai = 0; ai < 2; ++ai)
#pragma unroll
            for (int m = 0; m < 4; ++m) { const int idx = u.mt * BM + r0 + ai * HALF + m * 16;
                if (idx < u.cnt) { bf16_t* rowp = HID + (size_t)(u.hoff + idx) * DE + j0;
#pragma unroll
                    for (int bj = 0; bj < 2; ++bj) { const f32x4 v0 = acc[ai][bj][m][0], v1 = acc[ai][bj][m][1];
                        const float h0 = siluf(v0[0]) * v0[1], h1 = siluf(v0[2]) * v0[3], h2 = siluf(v1[0]) * v1[1], h3 = siluf(v1[2]) * v1[3];
                        u32x2 w; w.x = cvt_pk_bf16(h0, h1); w.y = cvt_pk_bf16(h2, h3);
                        *(u32x2*)(rowp + bj * 64) = w; } } }
    }
};
struct EpiDown {
    static constexpr bool PERM = true;
    bf16_t* YS; const int* ltok; const float* lgate;
    __device__ __forceinline__ void operator()(const f32x4 (&acc)[2][2][4][2], const MUnit& u, int wr, int wc, int fr, int fq) const {
        const int r0 = wr * 64 + fr, col0 = u.pn * BM + wc * 32 + 8 * fq;
#pragma unroll
        for (int ai = 0; ai < 2; ++ai)
#pragma unroll
            for (int m = 0; m < 4; ++m) { const int idx = u.mt * BM + r0 + ai * HALF + m * 16;
                if (idx < u.cnt) { const int t2 = ltok[(size_t)u.e * M + idx]; const float g = lgate[(size_t)u.e * M + idx];
                    bf16_t* rowp = YS + (size_t)t2 * D + col0;
#pragma unroll
                    for (int bj = 0; bj < 2; ++bj) { const f32x4 v0 = acc[ai][bj][m][0] * g, v1 = acc[ai][bj][m][1] * g;
                        u32x4 w; w.x = cvt_pk_bf16(v0[0], v0[1]); w.y = cvt_pk_bf16(v0[2], v0[3]); w.z = cvt_pk_bf16(v1[0], v1[1]); w.w = cvt_pk_bf16(v1[2], v1[3]);
                        *(u32x4*)(rowp + bj * HALF) = w; } } }
    }
};
}

#define XB_TMO      128
#define XB_XCNT(j)  (256  + 64 * (j))
#define XB_XSUB(j)  (1280 + 64 * (j))
#define XB_XGEN(j)  (2304 + 64 * (j))
#define XB_TOP      3328
#define XB_TOPGEN   3392
#define XCD_BAR_WORDS 3456
#define XB_SPIN_CAP (1u << 22)
__device__ __forceinline__ unsigned xb_ld(unsigned* p)              { return __hip_atomic_load(p, __ATOMIC_RELAXED, __HIP_MEMORY_SCOPE_AGENT); }
__device__ __forceinline__ unsigned xb_add(unsigned* p, unsigned v) { return __hip_atomic_fetch_add(p, v, __ATOMIC_RELAXED, __HIP_MEMORY_SCOPE_AGENT); }
__device__ __forceinline__ unsigned xb_xcc_id() { return (unsigned)__builtin_amdgcn_s_getreg((3 << 11) | 20) & 0xFu; }
#define XB_SPIN(cond, bar) do { unsigned _sp = 0; while (cond) { __builtin_amdgcn_s_sleep(1); \
    if ((++_sp & 255u) == 0u) { if (xb_ld(&(bar)[XB_TMO])) break; if (_sp > XB_SPIN_CAP) { atomicAdd(&(bar)[XB_TMO], 1u); break; } } } } while (0)
struct XcdBarrier { unsigned* bar; unsigned x; volatile LAS unsigned* st; };
__device__ __forceinline__ XcdBarrier xcd_barrier_post(unsigned* bar, volatile LAS unsigned* st) {
    XcdBarrier b; b.bar = bar; b.x = xb_xcc_id(); b.st = st;
    if (threadIdx.x == 0) (void)xb_add(&bar[XB_XCNT(b.x)], 1u);
    return b;
}
__device__ __forceinline__ void xcd_barrier_complete(unsigned* bar, unsigned x, unsigned& nloc, unsigned& nx) {
    const unsigned G = gridDim.x * gridDim.y * gridDim.z;
    unsigned sum, cnt, mine, sp = 0u;
    for (;;) {
        sum = 0u; cnt = 0u; mine = 0u;
#pragma unroll
        for (unsigned j = 0; j < 16; ++j) { const unsigned c = xb_ld(&bar[XB_XCNT(j)]); sum += c; cnt += (c > 0u) ? 1u : 0u; mine = (j == x) ? c : mine; }
        if (sum == G) break;
        __builtin_amdgcn_s_sleep(1);
        if ((++sp & 255u) == 0u) { if (xb_ld(&bar[XB_TMO])) break; if (sp > XB_SPIN_CAP) { atomicAdd(&bar[XB_TMO], 1u); break; } }
    }
    nloc = mine > 0u ? mine : 1u; nx = cnt > 0u ? cnt : 1u;
}
__device__ __forceinline__ void xcd_barrier(const XcdBarrier& b) {
    asm volatile("s_waitcnt vmcnt(0)" ::: "memory");
    __syncthreads();
    if (threadIdx.x == 0) {
        unsigned* bar = b.bar;
        __builtin_amdgcn_s_waitcnt(0);
        unsigned nloc = b.st[0], nx = b.st[1];
        if (nloc == 0u) { xcd_barrier_complete(bar, b.x, nloc, nx); b.st[0] = nloc; b.st[1] = nx; }
        const unsigned old = xb_add(&bar[XB_XSUB(b.x)], 1u);
        const unsigned gen = old / nloc;
        if (old + 1u == (gen + 1u) * nloc) {
            __builtin_amdgcn_fence(__ATOMIC_RELEASE, "agent");
            asm volatile("s_waitcnt vmcnt(0)" ::: "memory");
            const unsigned og = xb_add(&bar[XB_TOP], 1u);
            const unsigned tg = og / nx;
            if (og + 1u == (tg + 1u) * nx) xb_add(&bar[XB_TOPGEN], 1u);
            else XB_SPIN(xb_ld(&bar[XB_TOPGEN]) == tg, bar);
            __builtin_amdgcn_fence(__ATOMIC_ACQUIRE, "agent");
            xb_add(&bar[XB_XGEN(b.x)], 1u);
            asm volatile("s_waitcnt vmcnt(0)" ::: "memory");
        } else {
            XB_SPIN(xb_ld(&bar[XB_XGEN(b.x)]) == gen, bar);
            __builtin_amdgcn_fence(__ATOMIC_ACQUIRE, "agent");
            asm volatile("s_waitcnt vmcnt(0)" ::: "memory");
        }
    }
    __syncthreads();
}

struct Args {
    const float* in[23]; float* out; unsigned char* ws; int ph_lo, ph_hi;
};
struct Frame {
    LAS unsigned char* lds; volatile LAS unsigned* MISC; unsigned* ctl;
    int tid, lane, wave, vcu, G, gw, NGW;
};
enum { I_X = 0, I_NORM_MIX, I_W_IN, I_DN_CONV, I_DN_ALOG, I_DN_DTB, I_DN_ONORM, I_AT_QN, I_AT_KN, I_RELB, I_CV_DW, I_CV_DWB, I_CV_LNG, I_CV_LNB,
       I_W_OUT, I_NORM_FFN, I_RG_W, I_RG_B, I_RE_W, I_RE_B, I_EX_GATE, I_EX_UP, I_EX_DOWN };

__device__ __forceinline__ void transpose_item(const float* W, int ldw, int src_col0, int k0, bf16_t* WT, int Kd, int dst_row0, int dst_mul, LAS float* scr, int lane) {
#pragma unroll 8
    for (int i = 0; i < 32; ++i) { const int kk = 2 * i + (lane >> 5); scr[kk * 33 + (lane & 31)] = W[(size_t)(k0 + kk) * ldw + src_col0 + (lane & 31)]; }
    LDS_WAIT(); asm volatile("" ::: "memory");
    const int c = lane & 7;
#pragma unroll
    for (int j = 0; j < 4; ++j) { const int n = (lane >> 3) + 8 * j; const LAS float* s = scr + (8 * c) * 33 + n;
        u32x4 o; o.x = pk2(s[0 * 33], s[1 * 33]); o.y = pk2(s[2 * 33], s[3 * 33]); o.z = pk2(s[4 * 33], s[5 * 33]); o.w = pk2(s[6 * 33], s[7 * 33]);
        *(u32x4*)(WT + (size_t)(dst_row0 + dst_mul * n) * Kd + k0 + 8 * c) = o; }
    LDS_WAIT(); asm volatile("" ::: "memory");
}

__device__ __forceinline__ void phase_p0(const Frame& F, const Args& A, int layer) {
    unsigned char* ws = A.ws;
    LAS float* scr = (LAS float*)(F.lds + F.wave * 16384);
    const float* w_in = A.in[I_W_IN] + (size_t)layer * D * NIN;
    const float* w_out = A.in[I_W_OUT] + (size_t)layer * D * D;
    bf16_t* WIN = (bf16_t*)(ws + WS_WIN); bf16_t* WOUT = (bf16_t*)(ws + WS_WOUT);
    constexpr int I_IN = (D / 64) * (NPROJ / 32), I_OUT = (D / 64) * (D / 32);
    for (int it = F.gw; it < I_IN + I_OUT; it += F.NGW) {
        if (it < I_IN) { const int nblk = NPROJ / 32, kb = it / nblk, nb = it % nblk, n0 = nb * 32; const int src = n0 < 1024 ? n0 : n0 + 8;
            transpose_item(w_in, NIN, src, kb * 64, WIN, D, n0, 1, scr, F.lane); }
        else { const int r = it - I_IN, nblk = D / 32, kb = r / nblk, nb = r % nblk;
            transpose_item(w_out, D, nb * 32, kb * 64, WOUT, D, nb * 32, 1, scr, F.lane); }
    }
    const float* xin = layer == 0 ? A.in[I_X] : A.out;
    const float* gmix = A.in[I_NORM_MIX] + layer * D;
    bf16_t* H = (bf16_t*)(ws + WS_H); float* AB = (float*)(ws + WS_AB);
    const bf16_t* YS = (const bf16_t*)(ws + WS_A + 64 * MiB);
    f32x4 gv[4];
#pragma unroll
    for (int j = 0; j < 4; ++j) gv[j] = *((const f32x4*)gmix + F.lane + 64 * j);
    for (int m = F.gw; m < M; m += F.NGW) {
        const f32x4* xr = (const f32x4*)(xin + (size_t)m * D) + F.lane;
        f32x4 v[4]; float s = 0.f;
#pragma unroll
        for (int j = 0; j < 4; ++j) v[j] = xr[64 * j];
        if (layer > 0) {
            const u32x2* y0 = (const u32x2*)(YS + (size_t)(2 * m) * D) + F.lane; const u32x2* y1 = (const u32x2*)(YS + (size_t)(2 * m + 1) * D) + F.lane;
#pragma unroll
            for (int j = 0; j < 4; ++j) { const u32x2 a = y0[64 * j], b = y1[64 * j];
                v[j].x += bf2f(a.x & 0xffffu) + bf2f(b.x & 0xffffu); v[j].y += bf2f(a.x >> 16) + bf2f(b.x >> 16);
                v[j].z += bf2f(a.y & 0xffffu) + bf2f(b.y & 0xffffu); v[j].w += bf2f(a.y >> 16) + bf2f(b.y >> 16); }
            f32x4* xo = (f32x4*)(A.out + (size_t)m * D) + F.lane;
#pragma unroll
            for (int j = 0; j < 4; ++j) xo[64 * j] = v[j];
        }
#pragma unroll
        for (int j = 0; j < 4; ++j) s += (v[j].x * v[j].x + v[j].y * v[j].y) + (v[j].z * v[j].z + v[j].w * v[j].w);
        const float rstd = rsqrtf(wave_sum(s) * (1.f / D) + EPS);
        u32x2* ho = (u32x2*)(H + (size_t)m * D) + F.lane;
        float ab[8];
#pragma unroll
        for (int o = 0; o < 8; ++o) ab[o] = 0.f;
#pragma unroll
        for (int j = 0; j < 4; ++j) { v[j] = v[j] * rstd * gv[j];
            u32x2 w; w.x = pk2(v[j].x, v[j].y); w.y = pk2(v[j].z, v[j].w); ho[64 * j] = w;
#pragma unroll
            for (int e = 0; e < 4; ++e) { const int k = 4 * F.lane + 256 * j + e; const f32x4* wp = (const f32x4*)(w_in + (size_t)k * NIN + 1024);
                const f32x4 wa = wp[0], wb = wp[1]; const float hv = v[j][e];
                ab[0] += hv * wa.x; ab[1] += hv * wa.y; ab[2] += hv * wa.z; ab[3] += hv * wa.w; ab[4] += hv * wb.x; ab[5] += hv * wb.y; ab[6] += hv * wb.z; ab[7] += hv * wb.w; } }
        float mine = 0.f;
#pragma unroll
        for (int o = 0; o < 8; ++o) { const float t = wave_sum(ab[o]); if (F.lane == o) mine = t; }
        if (F.lane < 8) AB[(size_t)m * 8 + F.lane] = mine;
    }
}

__device__ __forceinline__ void phase_dn_pre(const Frame& F, const Args& A, int layer) {
    const bf16_t* PROJ = (const bf16_t*)(A.ws + WS_A); float* SCR = (float*)(A.ws + WS_SCR); float* AB = (float*)(A.ws + WS_AB);
    const float* cw = A.in[I_DN_CONV] + (size_t)layer * 4 * 768;
    const float* alog = A.in[I_DN_ALOG] + layer * 4; const float* dtb = A.in[I_DN_DTB] + layer * 4;
    for (int m = F.gw; m < M; m += F.NGW) {
        const int s = m % SEQ;
#pragma unroll
        for (int j = 0; j < 12; ++j) { const int c = F.lane + 64 * j; float y = 0.f;
#pragma unroll
            for (int i = 0; i < 4; ++i) { if (s - 3 + i >= 0) y += cw[i * 768 + c] * bf2f(PROJ[(size_t)(m - 3 + i) * NPROJ + c]); }
            y = siluf(y);
            if (j < 8) { const float ss = wave_sum(y * y); y *= rsqrtf(ss + EPS) * (j < 4 ? 0.125f : 1.f); }
            SCR[(size_t)m * 768 + c] = y; }
        if (F.lane < 8) { const float a = AB[(size_t)m * 8 + F.lane]; float r;
            if (F.lane < 4) { const float x = a + dtb[F.lane]; const float sp = fmaxf(x, 0.f) + log1pf(expf(-fabsf(x))); r = -expf(alog[F.lane]) * sp; }
            else r = sigm(a);
            AB[(size_t)m * 8 + F.lane] = r; }
    }
}
__device__ __forceinline__ void phase_dn_scan_naive(const Frame& F, const Args& A) {
    if (blockIdx.x >= 32) return;
    const float* SCR = (const float*)(A.ws + WS_SCR); const float* AB = (const float*)(A.ws + WS_AB); float* O = (float*)(A.ws + WS_O);
    const int pair = blockIdx.x * 2 + (F.wave >> 2), b = pair >> 2, h = pair & 3;
    const int j = (F.wave & 3) * 16 + (F.lane >> 2), dg = F.lane & 3;
    float S[16];
#pragma unroll
    for (int i = 0; i < 16; ++i) S[i] = 0.f;
    for (int s = 0; s < SEQ; ++s) { const size_t m = (size_t)b * SEQ + s;
        const f32x4* kp = (const f32x4*)(SCR + m * 768 + 256 + h * 64 + dg * 16); const f32x4* qp = (const f32x4*)(SCR + m * 768 + h * 64 + dg * 16);
        const float v = SCR[m * 768 + 512 + h * 64 + j]; const float eg = expf(AB[m * 8 + h]), beta = AB[m * 8 + 4 + h];
        float k[16], q[16];
#pragma unroll
        for (int i = 0; i < 4; ++i) { const f32x4 a = kp[i], c = qp[i]; k[4 * i] = a.x; k[4 * i + 1] = a.y; k[4 * i + 2] = a.z; k[4 * i + 3] = a.w; q[4 * i] = c.x; q[4 * i + 1] = c.y; q[4 * i + 2] = c.z; q[4 * i + 3] = c.w; }
        float ks = 0.f;
#pragma unroll
        for (int i = 0; i < 16; ++i) ks += k[i] * S[i];
        ks += __shfl_xor(ks, 1); ks += __shfl_xor(ks, 2);
        const float c = beta * (v - eg * ks); float o = 0.f;
#pragma unroll
        for (int i = 0; i < 16; ++i) { S[i] = eg * S[i] + k[i] * c; o += q[i] * S[i]; }
        o += __shfl_xor(o, 1); o += __shfl_xor(o, 2);
        if (dg == 0) O[m * 256 + h * 64 + j] = o;
    }
}
__device__ __forceinline__ void phase_dn_gate(const Frame& F, const Args& A, int layer) {
    const bf16_t* PROJ = (const bf16_t*)(A.ws + WS_A); const float* O = (const float*)(A.ws + WS_O); bf16_t* MIXED = (bf16_t*)(A.ws + WS_MIXED);
    const float gn = A.in[I_DN_ONORM][layer * 64 + F.lane];
    for (int idx = F.gw; idx < M * DNH; idx += F.NGW) { const int m = idx >> 2, h = idx & 3;
        const float o = O[(size_t)m * 256 + h * 64 + F.lane]; const float ms = wave_sum(o * o) * (1.f / 64.f);
        const float z = bf2f(PROJ[(size_t)m * NPROJ + C_DZ + h * 64 + F.lane]);
        MIXED[(size_t)m * D + h * 64 + F.lane] = (bf16_t)f2bf(o * rsqrtf(ms + EPS) * gn * siluf(z)); }
}
__device__ __forceinline__ float t5_bias(const float* relb, int h, int dist) {
    int bucket;
    if (dist < 16) bucket = dist;
    else { const int lb = 16 + (int)(logf((float)dist / 16.f) / 4.852030263919617f * 16.f); bucket = lb < 31 ? lb : 31; }
    return relb[bucket * ATH + h];
}
__device__ __forceinline__ void phase_attn_naive(const Frame& F, const Args& A, int layer) {
    const bf16_t* PROJ = (const bf16_t*)(A.ws + WS_A); bf16_t* MIXED = (bf16_t*)(A.ws + WS_MIXED);
    LAS float* qk = (LAS float*)(F.lds + F.wave * 4096); LAS float* pl = qk + 64;
    const float qn = A.in[I_AT_QN][layer * 64 + F.lane], kn = A.in[I_AT_KN][layer * 64 + F.lane];
    const float* relb = A.in[I_RELB];
    const int dil[3] = {1, 4, 16};
    for (int idx = F.gw; idx < M * ATH; idx += F.NGW) { const int m = idx >> 3, h = idx & 7, s = m % SEQ;
        const float qv = bf2f(PROJ[(size_t)m * NPROJ + C_AQ + h * 64 + F.lane]);
        const float qss = wave_sum(qv * qv) * (1.f / 64.f);
        qk[F.lane] = qv * rsqrtf(qss + EPS) * qn * 0.125f * kn;
        LDS_WAIT(); asm volatile("" ::: "memory");
        float sc[9]; float mx = -1e30f;
#pragma unroll
        for (int di = 0; di < 3; ++di)
#pragma unroll
            for (int jb = 0; jb < 3; ++jb) { const int j = jb * 64 + F.lane, p = s - j * dil[di]; float v = -1e30f;
                if (j <= 128 && p >= 0) { const u32x4* kr = (const u32x4*)(PROJ + (size_t)(m - j * dil[di]) * NPROJ + C_AK + h * 64);
                    float dot = 0.f, ss = 0.f;
#pragma unroll
                    for (int c = 0; c < 8; ++c) { const u32x4 w = kr[c]; const unsigned ww[4] = {w.x, w.y, w.z, w.w};
#pragma unroll
                        for (int e = 0; e < 4; ++e) { const float k0 = bf2f(ww[e] & 0xffffu), k1 = bf2f(ww[e] >> 16);
                            dot += k0 * qk[c * 8 + 2 * e] + k1 * qk[c * 8 + 2 * e + 1]; ss += k0 * k0 + k1 * k1; } }
                    v = dot * rsqrtf(ss * (1.f / 64.f) + EPS) + t5_bias(relb, h, dil[di] * j); }
                sc[di * 3 + jb] = v; mx = fmaxf(mx, v); }
        mx = wave_max(mx);
        float sum = 0.f;
#pragma unroll
        for (int i = 0; i < 9; ++i) { const float p = sc[i] > -1e29f ? expf(sc[i] - mx) : 0.f; sum += p; pl[i * 64 + F.lane] = p; }
        sum = wave_sum(sum);
        LDS_WAIT(); asm volatile("" ::: "memory");
        float o = 0.f;
#pragma unroll 1
        for (int di = 0; di < 3; ++di) { const int jmax = (s / dil[di]) < 128 ? (s / dil[di]) : 128;
            for (int j = 0; j <= jmax; ++j) o += pl[(di * 3 + (j >> 6)) * 64 + (j & 63)] * bf2f(PROJ[(size_t)(m - j * dil[di]) * NPROJ + C_AV + h * 64 + F.lane]); }
        MIXED[(size_t)m * D + 256 + h * 64 + F.lane] = (bf16_t)f2bf(o / sum);
        LDS_WAIT(); asm volatile("" ::: "memory");
    }
}
__device__ __forceinline__ void phase_conf_naive(const Frame& F, const Args& A, int layer) {
    const bf16_t* PROJ = (const bf16_t*)(A.ws + WS_A); bf16_t* MIXED = (bf16_t*)(A.ws + WS_MIXED);
    const float* dw = A.in[I_CV_DW] + (size_t)layer * CVK * CVW;
    const f32x4 bias = *((const f32x4*)(A.in[I_CV_DWB] + layer * CVW) + F.lane), lg = *((const f32x4*)(A.in[I_CV_LNG] + layer * CVW) + F.lane), lb = *((const f32x4*)(A.in[I_CV_LNB] + layer * CVW) + F.lane);
    for (int m = F.gw; m < M; m += F.NGW) { const int s = m % SEQ;
        f32x4 acc = bias;
#pragma unroll 1
        for (int i = 0; i < CVK; ++i) { if (s - 30 + i < 0) continue;
            const u32x2 a = *((const u32x2*)(PROJ + (size_t)(m - 30 + i) * NPROJ + C_CU) + F.lane), g = *((const u32x2*)(PROJ + (size_t)(m - 30 + i) * NPROJ + C_CG) + F.lane);
            const f32x4 w = *((const f32x4*)(dw + i * CVW) + F.lane);
            acc.x += w.x * bf2f(a.x & 0xffffu) * sigm(bf2f(g.x & 0xffffu)); acc.y += w.y * bf2f(a.x >> 16) * sigm(bf2f(g.x >> 16));
            acc.z += w.z * bf2f(a.y & 0xffffu) * sigm(bf2f(g.y & 0xffffu)); acc.w += w.w * bf2f(a.y >> 16) * sigm(bf2f(g.y >> 16)); }
        const float mean = wave_sum((acc.x + acc.y) + (acc.z + acc.w)) * (1.f / CVW);
        const f32x4 d = acc - mean; const float var = wave_sum((d.x * d.x + d.y * d.y) + (d.z * d.z + d.w * d.w)) * (1.f / CVW);
        const float rs = rsqrtf(var + EPS); f32x4 y = d * rs * lg + lb;
        u32x2 w; w.x = pk2(siluf(y.x), siluf(y.y)); w.y = pk2(siluf(y.z), siluf(y.w));
        *((u32x2*)(MIXED + (size_t)m * D + 768) + F.lane) = w;
    }
}
__device__ __forceinline__ void phase_p4(const Frame& F, const Args& A, int layer) {
    unsigned char* ws = A.ws;
    LAS float* scr = (LAS float*)(F.lds + F.wave * 16384);
    const float* eg = A.in[I_EX_GATE] + (size_t)layer * NE * D * DE; const float* eu = A.in[I_EX_UP] + (size_t)layer * NE * D * DE; const float* ed = A.in[I_EX_DOWN] + (size_t)layer * NE * DE * D;
    bf16_t* WGU = (bf16_t*)(ws + WS_WGU); bf16_t* WD = (bf16_t*)(ws + WS_WD);
    for (int it = F.gw; it < NE * 768; it += F.NGW) { const int e = it / 768, r = it % 768;
        if (r < 256) { const int kb = r / 16, nb = r % 16; transpose_item(eg + (size_t)e * D * DE, DE, nb * 32, kb * 64, WGU + (size_t)e * 1024 * D, D, 2 * nb * 32, 2, scr, F.lane); }
        else if (r < 512) { const int q = r - 256, kb = q / 16, nb = q % 16; transpose_item(eu + (size_t)e * D * DE, DE, nb * 32, kb * 64, WGU + (size_t)e * 1024 * D, D, 2 * nb * 32 + 1, 2, scr, F.lane); }
        else { const int q = r - 512, kb = q / 32, nb = q % 32; transpose_item(ed + (size_t)e * DE * D, D, nb * 32, kb * 64, WD + (size_t)e * 1024 * DE, DE, nb * 32, 1, scr, F.lane); }
    }
    const float* gffn = A.in[I_NORM_FFN] + layer * D;
    const float* rgw = A.in[I_RG_W] + (size_t)layer * D * NGRP; const float* rgb = A.in[I_RG_B] + layer * NGRP;
    const float* rew = A.in[I_RE_W] + (size_t)layer * D * NE; const float* reb = A.in[I_RE_B] + layer * NE;
    bf16_t* H = (bf16_t*)(ws + WS_H); int* ltok = (int*)(ws + WS_LTOK); float* lgate = (float*)(ws + WS_LGATE);
    unsigned* cnt = F.ctl + CW_CNT + layer * NE * 16;
    f32x4 gv[4];
#pragma unroll
    for (int j = 0; j < 4; ++j) gv[j] = *((const f32x4*)gffn + F.lane + 64 * j);
    for (int m = F.gw; m < M; m += F.NGW) {
        const f32x4* xr = (const f32x4*)(A.out + (size_t)m * D) + F.lane;
        f32x4 v[4]; float s = 0.f;
#pragma unroll
        for (int j = 0; j < 4; ++j) { v[j] = xr[64 * j]; s += (v[j].x * v[j].x + v[j].y * v[j].y) + (v[j].z * v[j].z + v[j].w * v[j].w); }
        const float rstd = rsqrtf(wave_sum(s) * (1.f / D) + EPS);
        u32x2* ho = (u32x2*)(H + (size_t)m * D) + F.lane;
        float gl[4] = {0.f, 0.f, 0.f, 0.f};
#pragma unroll
        for (int j = 0; j < 4; ++j) { v[j] = v[j] * rstd * gv[j];
            u32x2 w; w.x = pk2(v[j].x, v[j].y); w.y = pk2(v[j].z, v[j].w); ho[64 * j] = w;
#pragma unroll
            for (int e = 0; e < 4; ++e) { const int k = 4 * F.lane + 256 * j + e; const f32x4 wg = *(const f32x4*)(rgw + (size_t)k * NGRP); const float hv = v[j][e];
                gl[0] += hv * wg.x; gl[1] += hv * wg.y; gl[2] += hv * wg.z; gl[3] += hv * wg.w; } }
#pragma unroll
        for (int o = 0; o < 4; ++o) gl[o] = wave_sum(gl[o]) + rgb[o];
        int gs = 0; float gm = gl[0];
#pragma unroll
        for (int o = 1; o < 4; ++o) if (gl[o] > gm) { gm = gl[o]; gs = o; }
        float den = 0.f;
#pragma unroll
        for (int o = 0; o < 4; ++o) den += expf(gl[o] - gm);
        const float pgrp = 1.f / den;
        float el[8];
#pragma unroll
        for (int o = 0; o < 8; ++o) el[o] = 0.f;
#pragma unroll
        for (int j = 0; j < 4; ++j)
#pragma unroll
            for (int e = 0; e < 4; ++e) { const int k = 4 * F.lane + 256 * j + e; const f32x4* wp = (const f32x4*)(rew + (size_t)k * NE + gs * EPG); const f32x4 wa = wp[0], wb = wp[1]; const float hv = v[j][e];
                el[0] += hv * wa.x; el[1] += hv * wa.y; el[2] += hv * wa.z; el[3] += hv * wa.w; el[4] += hv * wb.x; el[5] += hv * wb.y; el[6] += hv * wb.z; el[7] += hv * wb.w; }
#pragma unroll
        for (int o = 0; o < 8; ++o) el[o] = wave_sum(el[o]) + reb[gs * EPG + o];
        int i0 = 0; float v0 = el[0];
#pragma unroll
        for (int o = 1; o < 8; ++o) if (el[o] > v0) { v0 = el[o]; i0 = o; }
        int i1 = -1; float v1 = -3.0e38f;
#pragma unroll
        for (int o = 0; o < 8; ++o) if (o != i0 && el[o] > v1) { v1 = el[o]; i1 = o; }
        const float e1 = expf(v1 - v0), g0 = pgrp / (1.f + e1), g1 = pgrp * e1 / (1.f + e1);
        if (F.lane < 2) { const int e = gs * EPG + (F.lane == 0 ? i0 : i1); const float g = F.lane == 0 ? g0 : g1;
            const unsigned pos = atomicAdd(cnt + e * 16, 1u);
            ltok[(size_t)e * M + pos] = 2 * m + F.lane; lgate[(size_t)e * M + pos] = g; }
    }
}
__device__ __forceinline__ void moe_tables(const Frame& F, int layer) {
    LAS int* cntL = (LAS int*)(F.lds + MOE_OFF); LAS int* hoffL = cntL + 32; LAS int* tstartL = hoffL + 32;
    __syncthreads();
    if (F.tid < NE) cntL[F.tid] = (int)__hip_atomic_load(F.ctl + CW_CNT + (layer * NE + F.tid) * 16, RLX_AGENT);
    __syncthreads();
    if (F.tid == 0) { int h = 0, t = 0; for (int e = 0; e < NE; ++e) { hoffL[e] = h; tstartL[e] = t; h += cntL[e]; t += (cntL[e] + 255) >> 8; } tstartL[NE] = t; }
    __syncthreads();
}
__device__ __forceinline__ void phase_final(const Frame& F, const Args& A) {
    const bf16_t* YS = (const bf16_t*)(A.ws + WS_A + 64 * MiB);
    for (int m = F.gw; m < M; m += F.NGW) {
        f32x4* xr = (f32x4*)(A.out + (size_t)m * D) + F.lane;
        const u32x2* y0 = (const u32x2*)(YS + (size_t)(2 * m) * D) + F.lane; const u32x2* y1 = (const u32x2*)(YS + (size_t)(2 * m + 1) * D) + F.lane;
#pragma unroll
        for (int j = 0; j < 4; ++j) { f32x4 v = xr[64 * j]; const u32x2 a = y0[64 * j], b = y1[64 * j];
            v.x += bf2f(a.x & 0xffffu) + bf2f(b.x & 0xffffu); v.y += bf2f(a.x >> 16) + bf2f(b.x >> 16);
            v.z += bf2f(a.y & 0xffffu) + bf2f(b.y & 0xffffu); v.w += bf2f(a.y >> 16) + bf2f(b.y >> 16); xr[64 * j] = v; }
    }
}

constexpr int PH_PER_LAYER = 9, N_PHASES = NLAYER * PH_PER_LAYER + 1;
__global__ void __launch_bounds__(NTHREADS, 2) hymba_fwd(Args args) {
    extern __shared__ __attribute__((aligned(16))) unsigned char lds_raw[];
    Frame F;
    F.lds = (LAS unsigned char*)lds_raw; F.MISC = (volatile LAS unsigned*)(F.lds + MISC_OFF);
    F.tid = threadIdx.x; F.lane = F.tid & 63; F.wave = __builtin_amdgcn_readfirstlane(F.tid >> 6);
    F.G = gridDim.x; { const int bx = blockIdx.x; F.vcu = (F.G % 8 == 0) ? (bx % 8) * (F.G / 8) + bx / 8 : bx; }
    F.gw = F.vcu * NWAVES + F.wave; F.NGW = F.G * NWAVES;
    F.ctl = (unsigned*)(args.ws + WS_CTL);
    for (int u = F.tid; u < (LDS_BYTES - LDSCTL_OFF) / 4; u += NTHREADS) ((LAS unsigned*)(F.lds + LDSCTL_OFF))[u] = 0u;
    __syncthreads();
    XcdBarrier bar; bar.bar = F.ctl + CW_BAR; bar.x = 0; bar.st = nullptr;
#if MK_ONE_LAUNCH
    bar = xcd_barrier_post(F.ctl + CW_BAR, F.MISC + 8);
#define GRID_BAR() xcd_barrier(bar)
#else
#define GRID_BAR() do { } while (0)
#endif
    const int lo = args.ph_lo, hi = args.ph_hi;
    unsigned char* ws = args.ws;
    for (int ph = lo; ph < hi; ++ph) {
        Frame Fp = F; asm volatile("" : "+v"(Fp.lane), "+v"(Fp.tid));
        const int layer = ph / PH_PER_LAYER, p = ph % PH_PER_LAYER;
        if (ph == N_PHASES - 1) { phase_final(Fp, args); }
        else if (p == 0) { phase_p0(Fp, args, layer); }
        else if (p == 1) {
            pg8::DenseSched<M / 256, NPROJ / 256> S{Fp.G, (int)blockIdx.x, D, (const bf16_t*)(ws + WS_WIN)};
            pg8::EpiProj E{(bf16_t*)(ws + WS_A), NPROJ};
            pg8::gemm_phase<pg8::EpiProj, pg8::DenseSched<M / 256, NPROJ / 256>>(Fp.lds, (const bf16_t*)(ws + WS_H), D, S, E);
        }
        else if (p == 2) { phase_dn_pre(Fp, args, layer); }
        else if (p == 3) { phase_dn_scan_naive(Fp, args); phase_attn_naive(Fp, args, layer); phase_conf_naive(Fp, args, layer); }
        else if (p == 4) { phase_dn_gate(Fp, args, layer); }
        else if (p == 5) {
            pg8::DenseSched<M / 256, D / 256> S{Fp.G, (int)blockIdx.x, D, (const bf16_t*)(ws + WS_WOUT)};
            pg8::EpiResid E{layer == 0 ? args.in[I_X] : args.out, args.out, D};
            pg8::gemm_phase<pg8::EpiResid, pg8::DenseSched<M / 256, D / 256>>(Fp.lds, (const bf16_t*)(ws + WS_MIXED), D, S, E);
        }
        else if (p == 6) { phase_p4(Fp, args, layer); }
        else if (p == 7) {
            moe_tables(Fp, layer);
            pg8::MoeSched<false> S; S.cntL = (const LAS int*)(Fp.lds + MOE_OFF); S.hoffL = S.cntL + 32; S.tstartL = S.hoffL + 32; S.G = Fp.G; S.vc = Fp.vcu;
            S.ltok = (const int*)(ws + WS_LTOK); S.Bt = (const bf16_t*)(ws + WS_WGU);
            pg8::EpiGU E{(bf16_t*)(ws + WS_A)};
            pg8::gemm_phase<pg8::EpiGU, pg8::MoeSched<false>>(Fp.lds, (const bf16_t*)(ws + WS_H), D, S, E);
        }
        else {
            moe_tables(Fp, layer);
            pg8::MoeSched<true> S; S.cntL = (const LAS int*)(Fp.lds + MOE_OFF); S.hoffL = S.cntL + 32; S.tstartL = S.hoffL + 32; S.G = Fp.G; S.vc = Fp.vcu;
            S.ltok = (const int*)(ws + WS_LTOK); S.Bt = (const bf16_t*)(ws + WS_WD);
            pg8::EpiDown E{(bf16_t*)(ws + WS_A + 64 * MiB), (const int*)(ws + WS_LTOK), (const float*)(ws + WS_LGATE)};
            pg8::gemm_phase<pg8::EpiDown, pg8::MoeSched<true>>(Fp.lds, (const bf16_t*)(ws + WS_A), DE, S, E);
        }
        if (ph + 1 < hi) GRID_BAR();
    }
}

extern "C" void kernel_launch(void* const* d_in, const int* in_sizes, int n_in, void* d_out, int out_size, void* d_ws, size_t ws_size, hipStream_t stream) {
    static int grid = 0;
    if (grid == 0) {
        if (n_in != 23 || out_size != M * D || ws_size < WS_END) { fprintf(stderr, "kernel_launch: unexpected shapes (n_in %d out %d ws %zu)\n", n_in, out_size, ws_size); grid = -1; return; }
        int dev = 0, cus = 0, per_cu = 0;
        if (hipGetDevice(&dev) != hipSuccess || hipDeviceGetAttribute(&cus, hipDeviceAttributeMultiprocessorCount, dev) != hipSuccess) { grid = -1; return; }
        if (hipFuncSetAttribute((const void*)hymba_fwd, hipFuncAttributeMaxDynamicSharedMemorySize, LDS_BYTES) != hipSuccess) { fprintf(stderr, "kernel_launch: hipFuncSetAttribute failed\n"); grid = -1; return; }
        if (hipOccupancyMaxActiveBlocksPerMultiprocessor(&per_cu, (const void*)hymba_fwd, NTHREADS, LDS_BYTES) != hipSuccess || per_cu < 1) { fprintf(stderr, "kernel_launch: occupancy query says %d\n", per_cu); per_cu = 1; }
        (void)hipGetLastError();
        grid = cus;
    }
    if (grid < 0) return;
    (void)hipMemsetAsync((char*)d_ws + WS_CTL, 0, CTL_ZERO_BYTES, stream);
    Args a{};
    for (int i = 0; i < 23; ++i) a.in[i] = (const float*)d_in[i];
    a.out = (float*)d_out; a.ws = (unsigned char*)d_ws;
#if MK_ONE_LAUNCH
    a.ph_lo = 0; a.ph_hi = N_PHASES;
    void* kargs[] = {&a};
    hipError_t e = hipLaunchCooperativeKernel((const void*)hymba_fwd, dim3(grid), dim3(NTHREADS), kargs, LDS_BYTES, stream);
    if (e != hipSuccess) fprintf(stderr, "kernel_launch: cooperative launch failed: %s (grid %d)\n", hipGetErrorString(e), grid);
#else
    for (int ph = 0; ph < N_PHASES; ++ph) { a.ph_lo = ph; a.ph_hi = ph + 1;
        hipLaunchKernelGGL(hymba_fwd, dim3(grid), dim3(NTHREADS), LDS_BYTES, stream, a); }
#endif
}
```

```cpp
#include <hip/hip_runtime.h>
#include <cstdio>
#include <cstdint>

#ifndef MK_ONE_LAUNCH
#define MK_ONE_LAUNCH 1
#endif

#define LAS __attribute__((address_space(3)))
#define GAS __attribute__((address_space(1)))
typedef unsigned short bf16_t;
typedef short bf16x8 __attribute__((ext_vector_type(8)));
typedef float f32x4 __attribute__((ext_vector_type(4)));
typedef float f32x2 __attribute__((ext_vector_type(2)));
typedef unsigned u32x4 __attribute__((ext_vector_type(4)));
typedef unsigned u32x2 __attribute__((ext_vector_type(2)));
typedef GAS unsigned gu32;
#define RLX_AGENT __ATOMIC_RELAXED, __HIP_MEMORY_SCOPE_AGENT
#define LDS_WAIT() asm volatile("s_waitcnt lgkmcnt(0)" ::: "memory")
#define VM_WAIT() asm volatile("s_waitcnt vmcnt(0)" ::: "memory")

constexpr int D = 1024, BATCH = 16, SEQ = 2048, M = BATCH * SEQ, NLAYER = 2;
constexpr int NIN = 3080, NPROJ = 3072;
constexpr int HD = 64, DNH = 4, ATH = 8, CVW = 256, CVK = 31;
constexpr int NGRP = 4, EPG = 8, NE = 32, DE = 512;
constexpr float EPS = 1e-6f;
constexpr int C_DQ = 0, C_DK = 256, C_DV = 512, C_DZ = 768, C_AQ = 1024, C_AK = 1536, C_AV = 2048, C_CU = 2560, C_CG = 2816;
constexpr int NWAVES = 8, NTHREADS = 512;

constexpr size_t MiB = 1u << 20;
constexpr size_t WS_CTL = 0, CTL_ZERO_BYTES = 1 * MiB;
constexpr size_t WS_WIN = 1 * MiB;
constexpr size_t WS_WOUT = 7 * MiB;
constexpr size_t WS_AB = 9 * MiB;
constexpr size_t WS_LTOK = 10 * MiB;
constexpr size_t WS_LGATE = 14 * MiB;
constexpr size_t WS_WGU = 18 * MiB;
constexpr size_t WS_WD = 82 * MiB;
constexpr size_t WS_H = 114 * MiB;
constexpr size_t WS_MIXED = 178 * MiB;
constexpr size_t WS_A = 242 * MiB;
constexpr size_t WS_ATTO = 434 * MiB;
constexpr size_t WS_ATTL = 498 * MiB;
constexpr size_t WS_END = 500 * MiB;
constexpr size_t WS_SCR = WS_WGU;
constexpr size_t WS_O = WS_H;
constexpr int CW_BAR = 4096;
constexpr int CW_CNT = 8192;

constexpr int RING_BYTES = 131072;
constexpr int LDSCTL_OFF = RING_BYTES;
constexpr int LDS_BYTES = 155648;
constexpr int MISC_OFF = LDSCTL_OFF;
constexpr int MOE_OFF = LDSCTL_OFF + 256;

__device__ __forceinline__ float bf2f(unsigned v) { return __uint_as_float(v << 16); }
__device__ __forceinline__ unsigned f2bf(float f) { unsigned u = __float_as_uint(f); return (u + 0x7fffu + ((u >> 16) & 1u)) >> 16; }
__device__ __forceinline__ unsigned pk2(float lo, float hi) { return f2bf(lo) | (f2bf(hi) << 16); }
__device__ __forceinline__ float wave_sum(float v) {
#pragma unroll
    for (int o = 1; o < 64; o <<= 1) v += __shfl_xor(v, o);
    return v;
}
__device__ __forceinline__ float wave_max(float v) {
#pragma unroll
    for (int o = 1; o < 64; o <<= 1) v = fmaxf(v, __shfl_xor(v, o));
    return v;
}
__device__ __forceinline__ float sigm(float x) { return 1.f / (1.f + expf(-x)); }
__device__ __forceinline__ float siluf(float x) { return x * sigm(x); }

namespace pg8 {
constexpr int BM = 256, BK = 64, HALF = 128, HTB = HALF * BK * 2, STAGE_BYTES = 8 * HTB, NXCD = 8, WGM = 8;
__host__ __device__ __forceinline__ int lds_byte(int r, int c) { const int st = (r >> 4) * 2 + (c >> 5), rr = r & 15, cc = c & 31, ob = rr * 64 + cc * 2; return st * 1024 + (ob ^ (((ob >> 9) & 1) << 5)); }
__host__ __device__ __forceinline__ void stage_rc(int b, int& R, int& C) { const int st = b / 1024, sb = b % 1024, swz = sb ^ (((sb >> 9) & 1) << 5); R = (st >> 1) * 16 + swz / 64; C = (st & 1) * 32 + (swz % 64) / 2; }
__host__ __device__ __forceinline__ int perm32(int rho) { const int n = rho >> 4, i = rho & 15; return 8 * (i >> 2) + 4 * n + (i & 3); }
typedef __bf16 bf16x2_t __attribute__((ext_vector_type(2)));
__device__ __forceinline__ unsigned cvt_pk_bf16(float lo, float hi) { f32x2 v = {lo, hi}; bf16x2_t b = __builtin_convertvector(v, bf16x2_t); return __builtin_bit_cast(unsigned, b); }

template <class Epi, class Sched>
__device__ __forceinline__ void gemm_phase(LAS unsigned char* lds, const bf16_t* Abase, const int K, const Sched& S, const Epi& E) {
    int tid_ = threadIdx.x; asm volatile("" : "+v"(tid_));
    const int tid = tid_, wid = __builtin_amdgcn_readfirstlane(tid >> 6), lane = tid & 63, wr = wid >> 2, wc = wid & 3, fr = lane & 15, fq = lane >> 4;
    const int nt = K / BK;
    int Rr[2], Cc2[2]; unsigned voffB[2];
#pragma unroll
    for (int i = 0; i < 2; ++i) { int R, C; stage_rc(tid * 16 + i * 8192, R, C); const int Rb = Epi::PERM ? ((R & ~31) + perm32(R & 31)) : R;
        Rr[i] = R; Cc2[i] = C * 2; voffB[i] = (unsigned)(Rb * K + C) * 2u; }
    const size_t kstep = (size_t)(BK * 2);
    const size_t hstep = (size_t)HALF * K * 2;
    const unsigned ldsw = (unsigned)wid * 1024u;
    const int aoff = lds_byte(wr * 64 + fr, fq * 8), boff = lds_byte(wc * 32 + fr, fq * 8);
    const char* Ab = (const char*)Abase;
#define PG8_SA(b, h) (((b) * 2 + (h)) * HTB)
#define PG8_SB(b, h) ((4 + (b) * 2 + (h)) * HTB)
#define PG8_STAGE(bufoff, gbase, voff) do { _Pragma("unroll") for (int _i = 0; _i < 2; ++_i) \
        __builtin_amdgcn_global_load_lds((const unsigned*)((const char*)(gbase) + (voff)[_i]), (LAS unsigned*)(lds + (bufoff) + ldsw + _i * 8192), 16, 0, 0); } while (0)
#define PG8_LDA(dst, b, h) do { _Pragma("unroll") for (int m = 0; m < 4; ++m) _Pragma("unroll") for (int k = 0; k < 2; ++k) dst[m][k] = *(const LAS bf16x8*)(lds + PG8_SA(b, h) + aoff + m * 2048 + k * 1024); } while (0)
#define PG8_LDB(dst, b, h) do { _Pragma("unroll") for (int n = 0; n < 2; ++n) _Pragma("unroll") for (int k = 0; k < 2; ++k) dst[n][k] = *(const LAS bf16x8*)(lds + PG8_SB(b, h) + boff + n * 2048 + k * 1024); } while (0)
#define PG8_MMA(ai, bj, At, Bt) do { __builtin_amdgcn_s_setprio(1); _Pragma("unroll") for (int m = 0; m < 4; ++m) _Pragma("unroll") for (int n = 0; n < 2; ++n) _Pragma("unroll") for (int k = 0; k < 2; ++k) \
        acc[ai][bj][m][n] = __builtin_amdgcn_mfma_f32_16x16x32_bf16(Bt[n][k], At[m][k], acc[ai][bj][m][n], 0, 0, 0); __builtin_amdgcn_s_setprio(0); } while (0)
#define PG8_WAIT_V(n) asm volatile("s_waitcnt vmcnt(" #n ")" ::: "memory")
#define PG8_WAIT_L(n) asm volatile("s_waitcnt lgkmcnt(" #n ")" ::: "memory")
#define PG8_BAR __builtin_amdgcn_s_barrier()
#define PG8_SCHED __builtin_amdgcn_sched_barrier(0)
    typename Sched::Unit cur, nxt; int ui = 0;
    if (!S.next(0, cur)) return;
    unsigned va0[2], va1[2], vn0[2], vn1[2];
    const char* cA = Ab; const char* nA = Ab;
    if constexpr (Sched::GATHER) {
#pragma unroll
        for (int i = 0; i < 2; ++i) { va0[i] = S.a_off(cur, Rr[i]) + (unsigned)Cc2[i]; va1[i] = S.a_off(cur, HALF + Rr[i]) + (unsigned)Cc2[i]; }
    } else {
#pragma unroll
        for (int i = 0; i < 2; ++i) { va0[i] = (unsigned)(Rr[i] * K * 2 + Cc2[i]); va1[i] = va0[i] + (unsigned)hstep; vn0[i] = va0[i]; vn1[i] = va1[i]; }
        cA = Ab + S.a_base(cur);
    }
    f32x4 acc[2][2][4][2];
#pragma unroll
    for (int a = 0; a < 2; ++a)
#pragma unroll
        for (int b = 0; b < 2; ++b)
#pragma unroll
            for (int m = 0; m < 4; ++m)
#pragma unroll
                for (int n = 0; n < 2; ++n) acc[a][b][m][n] = (f32x4){0.f, 0.f, 0.f, 0.f};
    bf16x8 At[4][2], B0[2][2], B1[2][2];
    const char* cB = S.b_base(cur);
    PG8_STAGE(PG8_SB(0, 0), cB, voffB); PG8_STAGE(PG8_SB(0, 1), cB + hstep, voffB); PG8_STAGE(PG8_SA(0, 0), cA, va0); PG8_STAGE(PG8_SA(0, 1), cA, va1);
    if (wr == 1) PG8_BAR;
    PG8_WAIT_V(2); PG8_BAR;
    PG8_STAGE(PG8_SB(1, 0), cB + kstep, voffB); PG8_STAGE(PG8_SA(1, 0), cA + kstep, va0); PG8_STAGE(PG8_SB(1, 1), cB + hstep + kstep, voffB);
    PG8_WAIT_V(6); PG8_BAR;
    for (;;) {
        const bool has_next = S.next(ui + 1, nxt);
        const char* nB = cB; nA = cA;
        if (has_next) { nB = S.b_base(nxt);
            if constexpr (Sched::GATHER) {
#pragma unroll
                for (int i = 0; i < 2; ++i) { vn0[i] = S.a_off(nxt, Rr[i]) + (unsigned)Cc2[i]; vn1[i] = S.a_off(nxt, HALF + Rr[i]) + (unsigned)Cc2[i]; }
            } else nA = Ab + S.a_base(nxt);
        } else if constexpr (Sched::GATHER) {
#pragma unroll
            for (int i = 0; i < 2; ++i) { vn0[i] = va0[i]; vn1[i] = va1[i]; } }
        for (int t = 0; t < nt; t += 2) {
            const bool last = (t == nt - 2);
            const char* a1 = cA + (size_t)(t + 1) * kstep;
            const char* a2 = last ? nA : cA + (size_t)(t + 2) * kstep; const char* b2 = last ? nB : cB + (size_t)(t + 2) * kstep;
            const char* a3 = a2 + kstep; const char* b3 = b2 + kstep;
            unsigned w0[2], w1[2];
#pragma unroll
            for (int i = 0; i < 2; ++i) { if constexpr (Sched::GATHER) { w0[i] = last ? vn0[i] : va0[i]; w1[i] = last ? vn1[i] : va1[i]; } else { w0[i] = va0[i]; w1[i] = va1[i]; } }
            PG8_LDB(B0, 0, 0); PG8_LDB(B1, 0, 1); PG8_SCHED; PG8_LDA(At, 0, 0); PG8_STAGE(PG8_SA(1, 1), a1, va1);
            PG8_WAIT_V(8); PG8_WAIT_L(0); PG8_BAR; PG8_MMA(0, 0, At, B0); PG8_MMA(0, 1, At, B1); PG8_BAR; PG8_SCHED;
            PG8_LDA(At, 0, 1); PG8_STAGE(PG8_SB(0, 0), b2, voffB); PG8_STAGE(PG8_SB(0, 1), b2 + hstep, voffB); PG8_STAGE(PG8_SA(0, 0), a2, w0);
            PG8_WAIT_V(8); PG8_WAIT_L(0); PG8_BAR; PG8_MMA(1, 0, At, B0); PG8_MMA(1, 1, At, B1); PG8_BAR; PG8_SCHED;
            PG8_LDB(B0, 1, 0); PG8_LDB(B1, 1, 1); PG8_SCHED; PG8_LDA(At, 1, 0); PG8_STAGE(PG8_SA(0, 1), a2, w1);
            PG8_WAIT_V(8); PG8_WAIT_L(0); PG8_BAR; PG8_MMA(0, 0, At, B0); PG8_MMA(0, 1, At, B1); PG8_BAR; PG8_SCHED;
            PG8_LDA(At, 1, 1); PG8_STAGE(PG8_SB(1, 0), b3, voffB); PG8_STAGE(PG8_SB(1, 1), b3 + hstep, voffB); PG8_STAGE(PG8_SA(1, 0), a3, w0);
            PG8_WAIT_V(8); PG8_WAIT_L(0); PG8_BAR; PG8_MMA(1, 0, At, B0); PG8_MMA(1, 1, At, B1); PG8_BAR; PG8_SCHED;
        }
        if (wr == 0) PG8_BAR;
        E(acc, cur, wr, wc, fr, fq);
        if (!has_next) break;
#pragma unroll
        for (int a = 0; a < 2; ++a)
#pragma unroll
            for (int b = 0; b < 2; ++b)
#pragma unroll
                for (int m = 0; m < 4; ++m)
#pragma unroll
                    for (int n = 0; n < 2; ++n) acc[a][b][m][n] = (f32x4){0.f, 0.f, 0.f, 0.f};
        cur = nxt; cB = nB; cA = nA; ++ui;
        if constexpr (Sched::GATHER) {
#pragma unroll
            for (int i = 0; i < 2; ++i) { va0[i] = vn0[i]; va1[i] = vn1[i]; } }
        if (wr == 1) PG8_BAR;
    }
    PG8_WAIT_V(0);
    PG8_BAR;
#undef PG8_SA
#undef PG8_SB
#undef PG8_STAGE
#undef PG8_LDA
#undef PG8_LDB
#undef PG8_MMA
#undef PG8_WAIT_V
#undef PG8_WAIT_L
#undef PG8_BAR
#undef PG8_SCHED
}

struct DUnit { int pm, pn; };
template <int NM, int NN>
struct DenseSched {
    typedef DUnit Unit; static constexpr bool GATHER = false;
    int G, c, K; const bf16_t* Bt;
    __device__ __forceinline__ bool next(int i, Unit& u) const {
        constexpr int nwg = NM * NN, q = nwg / NXCD; static_assert(nwg % NXCD == 0 && NM % WGM == 0, "tile counts");
        const int L = i * G + c; if (L >= nwg) return false;
        const int wgid = (L % NXCD) * q + L / NXCD;
        constexpr int nig = WGM * NN; const int gid = wgid / nig, fm = gid * WGM;
        u.pm = fm + ((wgid % nig) % WGM); u.pn = (wgid % nig) / WGM; return true;
    }
    __device__ __forceinline__ size_t a_base(const Unit& u) const { return (size_t)u.pm * BM * K * 2; }
    __device__ __forceinline__ unsigned a_off(const Unit&, int) const { return 0u; }
    __device__ __forceinline__ const char* b_base(const Unit& u) const { return (const char*)(Bt + (size_t)u.pn * BM * K); }
};
struct MUnit { int e, mt, pn, cnt, hoff; };
template <bool DOWN>
struct MoeSched {
    typedef MUnit Unit; static constexpr bool GATHER = true;
    __device__ __forceinline__ size_t a_base(const Unit&) const { return 0; }
    const LAS int* cntL; const LAS int* hoffL; const LAS int* tstartL;
    int G, vc; const int* ltok; const bf16_t* Bt;
    __device__ __forceinline__ bool next(int i, Unit& u) const {
        const int total = tstartL[NE] * 4; const long L = (long)i * G + vc; if (L >= total) return false;
        const int mtg = (int)L >> 2; u.pn = (int)L & 3;
        int e = 0;
#pragma unroll 1
        for (int k = 1; k < NE; ++k) if (tstartL[k] <= mtg) e = k;
        u.e = e; u.mt = mtg - tstartL[e]; u.cnt = cntL[e]; u.hoff = hoffL[e]; return true;
    }
    __device__ __forceinline__ unsigned a_off(const Unit& u, int row) const {
        int idx = u.mt * BM + row; idx = idx < u.cnt ? idx : u.cnt - 1;
        if (DOWN) return (unsigned)(u.hoff + idx) * (unsigned)(DE * 2);
        const int t2 = ltok[(size_t)u.e * M + idx]; return (unsigned)(t2 >> 1) * (unsigned)(D * 2);
    }
    __device__ __forceinline__ const char* b_base(const Unit& u) const { return (const char*)(Bt + ((size_t)u.e * 1024 + (size_t)u.pn * BM) * (DOWN ? DE : D)); }
};

struct EpiProj {
    static constexpr bool PERM = true;
    bf16_t* O; int ldc;
    __device__ __forceinline__ void operator()(const f32x4 (&acc)[2][2][4][2], const DUnit& u, int wr, int wc, int fr, int fq) const {
        const int row0 = u.pm * BM + wr * 64 + fr, col0 = u.pn * BM + wc * 32 + 8 * fq;
#pragma unroll
        for (int ai = 0; ai < 2; ++ai)
#pragma unroll
            for (int m = 0; m < 4; ++m) { bf16_t* rowp = O + (size_t)(row0 + ai * HALF + m * 16) * ldc + col0;
#pragma unroll
                for (int bj = 0; bj < 2; ++bj) { const f32x4 v0 = acc[ai][bj][m][0], v1 = acc[ai][bj][m][1];
                    u32x4 w; w.x = cvt_pk_bf16(v0[0], v0[1]); w.y = cvt_pk_bf16(v0[2], v0[3]); w.z = cvt_pk_bf16(v1[0], v1[1]); w.w = cvt_pk_bf16(v1[2], v1[3]);
                    *(u32x4*)(rowp + bj * HALF) = w; } }
    }
};
struct EpiResid {
    static constexpr bool PERM = false;
    const float* resid; float* out; int ldc;
    __device__ __forceinline__ void operator()(const f32x4 (&acc)[2][2][4][2], const DUnit& u, int wr, int wc, int fr, int fq) const {
        const int row0 = u.pm * BM + wr * 64 + fr, col0 = u.pn * BM + wc * 32 + 4 * fq;
#pragma unroll
        for (int ai = 0; ai < 2; ++ai)
#pragma unroll
            for (int m = 0; m < 4; ++m) { const size_t off = (size_t)(row0 + ai * HALF + m * 16) * ldc + col0;
#pragma unroll
                for (int bj = 0; bj < 2; ++bj)
#pragma unroll
                    for (int n = 0; n < 2; ++n) { const f32x4 r = *(const f32x4*)(resid + off + bj * HALF + n * 16); *(f32x4*)(out + off + bj * HALF + n * 16) = r + acc[ai][bj][m][n]; } }
    }
};
struct EpiGU {
    static constexpr bool PERM = true;
    bf16_t* HID;
    __device__ __forceinline__ void operator()(const f32x4 (&acc)[2][2][4][2], const MUnit& u, int wr, int wc, int fr, int fq) const {
        const int r0 = wr * 64 + fr, j0 = u.pn * 128 + wc * 16 + 4 * fq;
#pragma unroll
        for (int ai = 0; ai < 2; ++ai)
#pragma unroll
            for (int m = 0; m < 4; ++m) { const int idx = u.mt * BM + r0 + ai * HALF + m * 16;
                if (idx < u.cnt) { bf16_t* rowp = HID + (size_t)(u.hoff + idx) * DE + j0;
#pragma unroll
                    for (int bj = 0; bj < 2; ++bj) { const f32x4 v0 = acc[ai][bj][m][0], v1 = acc[ai][bj][m][1];
                        const float h0 = siluf(v0[0]) * v0[1], h1 = siluf(v0[2]) * v0[3], h2 = siluf(v1[0]) * v1[1], h3 = siluf(v1[2]) * v1[3];
                        u32x2 w; w.x = cvt_pk_bf16(h0, h1); w.y = cvt_pk_bf16(h2, h3);
                        *(u32x2*)(rowp + bj * 64) = w; } } }
    }
};
struct EpiDown {
    static constexpr bool PERM = true;
    bf16_t* YS; const int* ltok; const float* lgate;
    __device__ __forceinline__ void operator()(const f32x4 (&acc)[2][2][4][2], const MUnit& u, int wr, int wc, int fr, int fq) const {
        const int r0 = wr * 64 + fr, col0 = u.pn * BM + wc * 32 + 8 * fq;
#pragma unroll
        for (int ai = 0; ai < 2; ++ai)
#pragma unroll
            for (int m = 0; m < 4; ++m) { const int idx = u.mt * BM + r0 + ai * HALF + m * 16;
                if (idx < u.cnt) { const int t2 = ltok[(size_t)u.e * M + idx]; const float g = lgate[(size_t)u.e * M + idx];
                    bf16_t* rowp = YS + (size_t)t2 * D + col0;
#pragma unroll
                    for (int bj = 0; bj < 2; ++bj) { const f32x4 v0 = acc[ai][bj][m][0] * g, v1 = acc[ai][bj][m][1] * g;
                        u32x4 w; w.x = cvt_pk_bf16(v0[0], v0[1]); w.y = cvt_pk_bf16(v0[2], v0[3]); w.z = cvt_pk_bf16(v1[0], v1[1]); w.w = cvt_pk_bf16(v1[2], v1[3]);
                        *(u32x4*)(rowp + bj * HALF) = w; } } }
    }
};
}

#define XB_TMO      128
#define XB_XCNT(j)  (256  + 64 * (j))
#define XB_XSUB(j)  (1280 + 64 * (j))
#define XB_XGEN(j)  (2304 + 64 * (j))
#define XB_TOP      3328
#define XB_TOPGEN   3392
#define XCD_BAR_WORDS 3456
#define XB_SPIN_CAP (1u << 22)
__device__ __forceinline__ unsigned xb_ld(unsigned* p)              { return __hip_atomic_load(p, __ATOMIC_RELAXED, __HIP_MEMORY_SCOPE_AGENT); }
__device__ __forceinline__ unsigned xb_add(unsigned* p, unsigned v) { return __hip_atomic_fetch_add(p, v, __ATOMIC_RELAXED, __HIP_MEMORY_SCOPE_AGENT); }
__device__ __forceinline__ unsigned xb_xcc_id() { return (unsigned)__builtin_amdgcn_s_getreg((3 << 11) | 20) & 0xFu; }
#define XB_SPIN(cond, bar) do { unsigned _sp = 0; while (cond) { __builtin_amdgcn_s_sleep(1); \
    if ((++_sp & 255u) == 0u) { if (xb_ld(&(bar)[XB_TMO])) break; if (_sp > XB_SPIN_CAP) { atomicAdd(&(bar)[XB_TMO], 1u); break; } } } } while (0)
struct XcdBarrier { unsigned* bar; unsigned x; volatile LAS unsigned* st; };
__device__ __forceinline__ XcdBarrier xcd_barrier_post(unsigned* bar, volatile LAS unsigned* st) {
    XcdBarrier b; b.bar = bar; b.x = xb_xcc_id(); b.st = st;
    if (threadIdx.x == 0) (void)xb_add(&bar[XB_XCNT(b.x)], 1u);
    return b;
}
__device__ __forceinline__ void xcd_barrier_complete(unsigned* bar, unsigned x, unsigned& nloc, unsigned& nx) {
    const unsigned G = gridDim.x * gridDim.y * gridDim.z;
    unsigned sum, cnt, mine, sp = 0u;
    for (;;) {
        sum = 0u; cnt = 0u; mine = 0u;
#pragma unroll
        for (unsigned j = 0; j < 16; ++j) { const unsigned c = xb_ld(&bar[XB_XCNT(j)]); sum += c; cnt += (c > 0u) ? 1u : 0u; mine = (j == x) ? c : mine; }
        if (sum == G) break;
        __builtin_amdgcn_s_sleep(1);
        if ((++sp & 255u) == 0u) { if (xb_ld(&bar[XB_TMO])) break; if (sp > XB_SPIN_CAP) { atomicAdd(&bar[XB_TMO], 1u); break; } }
    }
    nloc = mine > 0u ? mine : 1u; nx = cnt > 0u ? cnt : 1u;
}
__device__ __forceinline__ void xcd_barrier(const XcdBarrier& b) {
    asm volatile("s_waitcnt vmcnt(0)" ::: "memory");
    __syncthreads();
    if (threadIdx.x == 0) {
        unsigned* bar = b.bar;
        __builtin_amdgcn_s_waitcnt(0);
        unsigned nloc = b.st[0], nx = b.st[1];
        if (nloc == 0u) { xcd_barrier_complete(bar, b.x, nloc, nx); b.st[0] = nloc; b.st[1] = nx; }
        const unsigned old = xb_add(&bar[XB_XSUB(b.x)], 1u);
        const unsigned gen = old / nloc;
        if (old + 1u == (gen + 1u) * nloc) {
            __builtin_amdgcn_fence(__ATOMIC_RELEASE, "agent");
            asm volatile("s_waitcnt vmcnt(0)" ::: "memory");
            const unsigned og = xb_add(&bar[XB_TOP], 1u);
            const unsigned tg = og / nx;
            if (og + 1u == (tg + 1u) * nx) xb_add(&bar[XB_TOPGEN], 1u);
            else XB_SPIN(xb_ld(&bar[XB_TOPGEN]) == tg, bar);
            __builtin_amdgcn_fence(__ATOMIC_ACQUIRE, "agent");
            xb_add(&bar[XB_XGEN(b.x)], 1u);
            asm volatile("s_waitcnt vmcnt(0)" ::: "memory");
        } else {
            XB_SPIN(xb_ld(&bar[XB_XGEN(b.x)]) == gen, bar);
            __builtin_amdgcn_fence(__ATOMIC_ACQUIRE, "agent");
            asm volatile("s_waitcnt vmcnt(0)" ::: "memory");
        }
    }
    __syncthreads();
}

struct Args {
    const float* in[23]; float* out; unsigned char* ws; int ph_lo, ph_hi;
};
struct Frame {
    LAS unsigned char* lds; volatile LAS unsigned* MISC; unsigned* ctl;
    int tid, lane, wave, vcu, G, gw, NGW;
};
enum { I_X = 0, I_NORM_MIX, I_W_IN, I_DN_CONV, I_DN_ALOG, I_DN_DTB, I_DN_ONORM, I_AT_QN, I_AT_KN, I_RELB, I_CV_DW, I_CV_DWB, I_CV_LNG, I_CV_LNB,
       I_W_OUT, I_NORM_FFN, I_RG_W, I_RG_B, I_RE_W, I_RE_B, I_EX_GATE, I_EX_UP, I_EX_DOWN };

__device__ __forceinline__ void transpose_item(const float* W, int ldw, int src_col0, int k0, bf16_t* WT, int Kd, int dst_row0, int dst_mul, LAS float* scr, int lane) {
#pragma unroll 8
    for (int i = 0; i < 32; ++i) { const int kk = 2 * i + (lane >> 5); scr[kk * 33 + (lane & 31)] = W[(size_t)(k0 + kk) * ldw + src_col0 + (lane & 31)]; }
    LDS_WAIT(); asm volatile("" ::: "memory");
    const int c = lane & 7;
#pragma unroll
    for (int j = 0; j < 4; ++j) { const int n = (lane >> 3) + 8 * j; const LAS float* s = scr + (8 * c) * 33 + n;
        u32x4 o; o.x = pk2(s[0 * 33], s[1 * 33]); o.y = pk2(s[2 * 33], s[3 * 33]); o.z = pk2(s[4 * 33], s[5 * 33]); o.w = pk2(s[6 * 33], s[7 * 33]);
        *(u32x4*)(WT + (size_t)(dst_row0 + dst_mul * n) * Kd + k0 + 8 * c) = o; }
    LDS_WAIT(); asm volatile("" ::: "memory");
}

__device__ __forceinline__ void phase_p0(const Frame& F, const Args& A, int layer) {
    unsigned char* ws = A.ws;
    LAS float* scr = (LAS float*)(F.lds + F.wave * 16384);
    const float* w_in = A.in[I_W_IN] + (size_t)layer * D * NIN;
    const float* w_out = A.in[I_W_OUT] + (size_t)layer * D * D;
    bf16_t* WIN = (bf16_t*)(ws + WS_WIN); bf16_t* WOUT = (bf16_t*)(ws + WS_WOUT);
    constexpr int I_IN = (D / 64) * (NPROJ / 32), I_OUT = (D / 64) * (D / 32);
    for (int it = F.gw; it < I_IN + I_OUT; it += F.NGW) {
        if (it < I_IN) { const int nblk = NPROJ / 32, kb = it / nblk, nb = it % nblk, n0 = nb * 32; const int src = n0 < 1024 ? n0 : n0 + 8;
            transpose_item(w_in, NIN, src, kb * 64, WIN, D, n0, 1, scr, F.lane); }
        else { const int r = it - I_IN, nblk = D / 32, kb = r / nblk, nb = r % nblk;
            transpose_item(w_out, D, nb * 32, kb * 64, WOUT, D, nb * 32, 1, scr, F.lane); }
    }
    const float* xin = layer == 0 ? A.in[I_X] : A.out;
    const float* gmix = A.in[I_NORM_MIX] + layer * D;
    bf16_t* H = (bf16_t*)(ws + WS_H); float* AB = (float*)(ws + WS_AB);
    const bf16_t* YS = (const bf16_t*)(ws + WS_A + 64 * MiB);
    f32x4 gv[4];
#pragma unroll
    for (int j = 0; j < 4; ++j) gv[j] = *((const f32x4*)gmix + F.lane + 64 * j);
    for (int m = F.gw; m < M; m += F.NGW) {
        const f32x4* xr = (const f32x4*)(xin + (size_t)m * D) + F.lane;
        f32x4 v[4]; float s = 0.f;
#pragma unroll
        for (int j = 0; j < 4; ++j) v[j] = xr[64 * j];
        if (layer > 0) {
            const u32x2* y0 = (const u32x2*)(YS + (size_t)(2 * m) * D) + F.lane; const u32x2* y1 = (const u32x2*)(YS + (size_t)(2 * m + 1) * D) + F.lane;
#pragma unroll
            for (int j = 0; j < 4; ++j) { const u32x2 a = y0[64 * j], b = y1[64 * j];
                v[j].x += bf2f(a.x & 0xffffu) + bf2f(b.x & 0xffffu); v[j].y += bf2f(a.x >> 16) + bf2f(b.x >> 16);
                v[j].z += bf2f(a.y & 0xffffu) + bf2f(b.y & 0xffffu); v[j].w += bf2f(a.y >> 16) + bf2f(b.y >> 16); }
            f32x4* xo = (f32x4*)(A.out + (size_t)m * D) + F.lane;
#pragma unroll
            for (int j = 0; j < 4; ++j) xo[64 * j] = v[j];
        }
#pragma unroll
        for (int j = 0; j < 4; ++j) s += (v[j].x * v[j].x + v[j].y * v[j].y) + (v[j].z * v[j].z + v[j].w * v[j].w);
        const float rstd = rsqrtf(wave_sum(s) * (1.f / D) + EPS);
        u32x2* ho = (u32x2*)(H + (size_t)m * D) + F.lane;
        float ab[8];
#pragma unroll
        for (int o = 0; o < 8; ++o) ab[o] = 0.f;
#pragma unroll
        for (int j = 0; j < 4; ++j) { v[j] = v[j] * rstd * gv[j];
            u32x2 w; w.x = pk2(v[j].x, v[j].y); w.y = pk2(v[j].z, v[j].w); ho[64 * j] = w;
#pragma unroll
            for (int e = 0; e < 4; ++e) { const int k = 4 * F.lane + 256 * j + e; const f32x4* wp = (const f32x4*)(w_in + (size_t)k * NIN + 1024);
                const f32x4 wa = wp[0], wb = wp[1]; const float hv = v[j][e];
                ab[0] += hv * wa.x; ab[1] += hv * wa.y; ab[2] += hv * wa.z; ab[3] += hv * wa.w; ab[4] += hv * wb.x; ab[5] += hv * wb.y; ab[6] += hv * wb.z; ab[7] += hv * wb.w; } }
        float mine = 0.f;
#pragma unroll
        for (int o = 0; o < 8; ++o) { const float t = wave_sum(ab[o]); if (F.lane == o) mine = t; }
        if (F.lane < 8) AB[(size_t)m * 8 + F.lane] = mine;
    }
}

__device__ __forceinline__ void phase_dn_pre(const Frame& F, const Args& A, int layer) {
    const bf16_t* PROJ = (const bf16_t*)(A.ws + WS_A); float* SCR = (float*)(A.ws + WS_SCR); float* AB = (float*)(A.ws + WS_AB);
    const float* cw = A.in[I_DN_CONV] + (size_t)layer * 4 * 768;
    const float* alog = A.in[I_DN_ALOG] + layer * 4; const float* dtb = A.in[I_DN_DTB] + layer * 4;
    for (int m = F.gw; m < M; m += F.NGW) {
        const int s = m % SEQ;
#pragma unroll
        for (int j = 0; j < 12; ++j) { const int c = F.lane + 64 * j; float y = 0.f;
#pragma unroll
            for (int i = 0; i < 4; ++i) { if (s - 3 + i >= 0) y += cw[i * 768 + c] * bf2f(PROJ[(size_t)(m - 3 + i) * NPROJ + c]); }
            y = siluf(y);
            if (j < 8) { const float ss = wave_sum(y * y); y *= rsqrtf(ss + EPS) * (j < 4 ? 0.125f : 1.f); }
            SCR[(size_t)m * 768 + c] = y; }
        if (F.lane < 8) { const float a = AB[(size_t)m * 8 + F.lane]; float r;
            if (F.lane < 4) { const float x = a + dtb[F.lane]; const float sp = fmaxf(x, 0.f) + log1pf(expf(-fabsf(x))); r = -expf(alog[F.lane]) * sp; }
            else r = sigm(a);
            AB[(size_t)m * 8 + F.lane] = r; }
    }
}
__device__ __forceinline__ void phase_dn_scan_naive(const Frame& F, const Args& A) {
    if (blockIdx.x >= 32) return;
    const float* SCR = (const float*)(A.ws + WS_SCR); const float* AB = (const float*)(A.ws + WS_AB); float* O = (float*)(A.ws + WS_O);
    const int pair = blockIdx.x * 2 + (F.wave >> 2), b = pair >> 2, h = pair & 3;
    const int j = (F.wave & 3) * 16 + (F.lane >> 2), dg = F.lane & 3;
    float S[16];
#pragma unroll
    for (int i = 0; i < 16; ++i) S[i] = 0.f;
    for (int s = 0; s < SEQ; ++s) { const size_t m = (size_t)b * SEQ + s;
        const f32x4* kp = (const f32x4*)(SCR + m * 768 + 256 + h * 64 + dg * 16); const f32x4* qp = (const f32x4*)(SCR + m * 768 + h * 64 + dg * 16);
        const float v = SCR[m * 768 + 512 + h * 64 + j]; const float eg = expf(AB[m * 8 + h]), beta = AB[m * 8 + 4 + h];
        float k[16], q[16];
#pragma unroll
        for (int i = 0; i < 4; ++i) { const f32x4 a = kp[i], c = qp[i]; k[4 * i] = a.x; k[4 * i + 1] = a.y; k[4 * i + 2] = a.z; k[4 * i + 3] = a.w; q[4 * i] = c.x; q[4 * i + 1] = c.y; q[4 * i + 2] = c.z; q[4 * i + 3] = c.w; }
        float ks = 0.f;
#pragma unroll
        for (int i = 0; i < 16; ++i) ks += k[i] * S[i];
        ks += __shfl_xor(ks, 1); ks += __shfl_xor(ks, 2);
        const float c = beta * (v - eg * ks); float o = 0.f;
#pragma unroll
        for (int i = 0; i < 16; ++i) { S[i] = eg * S[i] + k[i] * c; o += q[i] * S[i]; }
        o += __shfl_xor(o, 1); o += __shfl_xor(o, 2);
        if (dg == 0) O[m * 256 + h * 64 + j] = o;
    }
}
__device__ __forceinline__ void phase_dn_gate(const Frame& F, const Args& A, int layer) {
    const bf16_t* PROJ = (const bf16_t*)(A.ws + WS_A); const float* O = (const float*)(A.ws + WS_O); bf16_t* MIXED = (bf16_t*)(A.ws + WS_MIXED);
    const float gn = A.in[I_DN_ONORM][layer * 64 + F.lane];
    for (int idx = F.gw; idx < M * DNH; idx += F.NGW) { const int m = idx >> 2, h = idx & 3;
        const float o = O[(size_t)m * 256 + h * 64 + F.lane]; const float ms = wave_sum(o * o) * (1.f / 64.f);
        const float z = bf2f(PROJ[(size_t)m * NPROJ + C_DZ + h * 64 + F.lane]);
        MIXED[(size_t)m * D + h * 64 + F.lane] = (bf16_t)f2bf(o * rsqrtf(ms + EPS) * gn * siluf(z)); }
}
__device__ __forceinline__ float t5_bias(const float* relb, int h, int dist) {
    int bucket;
    if (dist < 16) bucket = dist;
    else { const int lb = 16 + (int)(logf((float)dist / 16.f) / 4.852030263919617f * 16.f); bucket = lb < 31 ? lb : 31; }
    return relb[bucket * ATH + h];
}
__device__ __forceinline__ void phase_attn_naive(const Frame& F, const Args& A, int layer) {
    const bf16_t* PROJ = (const bf16_t*)(A.ws + WS_A); bf16_t* MIXED = (bf16_t*)(A.ws + WS_MIXED);
    LAS float* qk = (LAS float*)(F.lds + F.wave * 4096); LAS float* pl = qk + 64;
    const float qn = A.in[I_AT_QN][layer * 64 + F.lane], kn = A.in[I_AT_KN][layer * 64 + F.lane];
    const float* relb = A.in[I_RELB];
    const int dil[3] = {1, 4, 16};
    for (int idx = F.gw; idx < M * ATH; idx += F.NGW) { const int m = idx >> 3, h = idx & 7, s = m % SEQ;
        const float qv = bf2f(PROJ[(size_t)m * NPROJ + C_AQ + h * 64 + F.lane]);
        const float qss = wave_sum(qv * qv) * (1.f / 64.f);
        qk[F.lane] = qv * rsqrtf(qss + EPS) * qn * 0.125f * kn;
        LDS_WAIT(); asm volatile("" ::: "memory");
        float sc[9]; float mx = -1e30f;
#pragma unroll
        for (int di = 0; di < 3; ++di)
#pragma unroll
            for (int jb = 0; jb < 3; ++jb) { const int j = jb * 64 + F.lane, p = s - j * dil[di]; float v = -1e30f;
                if (j <= 128 && p >= 0) { const u32x4* kr = (const u32x4*)(PROJ + (size_t)(m - j * dil[di]) * NPROJ + C_AK + h * 64);
                    float dot = 0.f, ss = 0.f;
#pragma unroll
                    for (int c = 0; c < 8; ++c) { const u32x4 w = kr[c]; const unsigned ww[4] = {w.x, w.y, w.z, w.w};
#pragma unroll
                        for (int e = 0; e < 4; ++e) { const float k0 = bf2f(ww[e] & 0xffffu), k1 = bf2f(ww[e] >> 16);
                            dot += k0 * qk[c * 8 + 2 * e] + k1 * qk[c * 8 + 2 * e + 1]; ss += k0 * k0 + k1 * k1; } }
                    v = dot * rsqrtf(ss * (1.f / 64.f) + EPS) + t5_bias(relb, h, dil[di] * j); }
                sc[di * 3 + jb] = v; mx = fmaxf(mx, v); }
        mx = wave_max(mx);
        float sum = 0.f;
#pragma unroll
        for (int i = 0; i < 9; ++i) { const float p = sc[i] > -1e29f ? expf(sc[i] - mx) : 0.f; sum += p; pl[i * 64 + F.lane] = p; }
        sum = wave_sum(sum);
        LDS_WAIT(); asm volatile("" ::: "memory");
        float o = 0.f;
#pragma unroll 1
        for (int di = 0; di < 3; ++di) { const int jmax = (s / dil[di]) < 128 ? (s / dil[di]) : 128;
            for (int j = 0; j <= jmax; ++j) o += pl[(di * 3 + (j >> 6)) * 64 + (j & 63)] * bf2f(PROJ[(size_t)(m - j * dil[di]) * NPROJ + C_AV + h * 64 + F.lane]); }
        MIXED[(size_t)m * D + 256 + h * 64 + F.lane] = (bf16_t)f2bf(o / sum);
        LDS_WAIT(); asm volatile("" ::: "memory");
    }
}

namespace att {
typedef float f32x16 __attribute__((ext_vector_type(16)));
typedef short s16x4 __attribute__((ext_vector_type(4)));
constexpr int TB_STRIDE = 200, TB_PAD = 32;
constexpr int TB_OFF = LDSCTL_OFF + 1024;
constexpr float LOG2E = 1.4426950408889634f;
struct Sub { int b, h, dil, di, res, n; };
__device__ __forceinline__ unsigned cvtpk(float lo, float hi) { return pg8::cvt_pk_bf16(lo, hi); }
__device__ __forceinline__ bf16x8 pack8(const f32x16& x, int s) {
    u32x4 w; w.x = cvtpk(x[8 * s], x[8 * s + 1]); w.y = cvtpk(x[8 * s + 2], x[8 * s + 3]); w.z = cvtpk(x[8 * s + 4], x[8 * s + 5]); w.w = cvtpk(x[8 * s + 6], x[8 * s + 7]);
    return __builtin_bit_cast(bf16x8, w);
}
__device__ __forceinline__ void build_table(const Frame& F, const float* relb) {
    LAS float* T = (LAS float*)(F.lds + TB_OFF);
    for (int e = F.tid; e < 3 * 8 * TB_STRIDE; e += NTHREADS) { const int di = e / (8 * TB_STRIDE), h = (e / TB_STRIDE) % 8, x = e % TB_STRIDE - TB_PAD; const int rel = 128 - x;
        float v = -1e30f;
        if (rel >= 0 && rel <= 128) { const int dist = rel * (di == 0 ? 1 : di == 1 ? 4 : 16); v = t5_bias(relb, h, dist) * LOG2E; }
        T[e] = v; }
}
template <bool COMBINE>
__device__ __forceinline__ void run_pair(const Frame& F, const Args& A, const Sub& sb) {
    const bf16_t* PROJ = (const bf16_t*)(A.ws + WS_A);
    const int sub = F.wave >> 2, wq = F.wave & 3, lane = F.lane, r = lane & 31, hh = lane >> 5;
    LAS unsigned char* Kb = F.lds + sub * 65536; LAS unsigned char* Vb = Kb + 32768;
    const size_t tok0 = (size_t)sb.b * SEQ;
    {
        const int ht = F.tid & 255, c = ht & 7; const int kstart = sb.n == 0 ? 128 : 0;
        u32x4 kr[8], vr[8];
#pragma unroll
        for (int i = 0; i < 8; ++i) { const int kj = (ht >> 3) + 32 * i;
            if (kj >= kstart) { const int p = (sb.n - 1) * 128 + kj; const bf16_t* row = PROJ + (tok0 + (size_t)p * sb.dil + sb.res) * NPROJ + sb.h * 64 + c * 8;
                kr[i] = *(const u32x4*)(row + C_AK); vr[i] = *(const u32x4*)(row + C_AV); } }
#pragma unroll
        for (int i = 0; i < 8; ++i) { const int kj = (ht >> 3) + 32 * i;
            if (kj >= kstart) { *(LAS u32x4*)(Kb + kj * 128 + ((c ^ ((kj >> 1) & 7)) << 4)) = kr[i]; *(LAS u32x4*)(Vb + kj * 128 + ((c ^ (((kj >> 1) & 1) << 2)) << 4)) = vr[i]; } }
    }
    const int qpos = sb.n * 128 + wq * 32 + r; const size_t mq = tok0 + (size_t)qpos * sb.dil + sb.res;
    bf16x8 qf[4];
#pragma unroll
    for (int s = 0; s < 4; ++s) qf[s] = *(const bf16x8*)(PROJ + mq * NPROJ + C_AQ + sb.h * 64 + 16 * s + 8 * hh);
    __syncthreads();
    const int dmin = sb.n == 0 ? 4 - wq : 0;
    const LAS float* T = (const LAS float*)(F.lds + TB_OFF) + (sb.di * 8 + sb.h) * TB_STRIDE + TB_PAD - r + 4 * hh;
    f32x16 p[5]; float mx = -1e30f;
#pragma unroll
    for (int t = 0; t < 5; ++t) {
        if (t >= dmin) { const int row = (wq + t) * 32 + r; f32x16 acc;
#pragma unroll
            for (int i = 0; i < 16; ++i) acc[i] = 0.f;
#pragma unroll
            for (int s = 0; s < 4; ++s) { const bf16x8 kf = *(const LAS bf16x8*)(Kb + row * 128 + (((2 * s + hh) ^ ((row >> 1) & 7)) << 4));
                acc = __builtin_amdgcn_mfma_f32_32x32x16_bf16(kf, qf[s], acc, 0, 0, 0); }
#pragma unroll
            for (int i = 0; i < 16; ++i) { acc[i] += T[32 * t + (i & 3) + 8 * (i >> 2)]; mx = fmaxf(mx, acc[i]); }
            p[t] = acc; }
    }
    mx = fmaxf(mx, __shfl_xor(mx, 32));
    float l = 0.f;
#pragma unroll
    for (int t = 0; t < 5; ++t) if (t >= dmin) {
#pragma unroll
        for (int i = 0; i < 16; ++i) { const float e = __builtin_amdgcn_exp2f(p[t][i] - mx); p[t][i] = e; l += e; } }
    l += __shfl_xor(l, 32);
    f32x16 o[2];
#pragma unroll
    for (int i = 0; i < 16; ++i) { o[0][i] = 0.f; o[1][i] = 0.f; }
    const int q4 = (lane & 15) >> 2, p4 = lane & 3, blk = (lane >> 4) & 1, sw = (lane >> 3) & 1;
    const int vlane = (4 * hh + q4) * 128 + ((2 * blk + (p4 >> 1)) << 4) + 8 * (p4 & 1);
    const int voff0 = vlane + sw * 64, voff1 = vlane + (1 - sw) * 64;
#pragma unroll
    for (int t = 0; t < 5; ++t) if (t >= dmin) {
#pragma unroll
        for (int s = 0; s < 2; ++s) { const bf16x8 pf = pack8(p[t], s); const int rowb = ((wq + t) * 32 + 16 * s) * 128;
            const s16x4 a0 = __builtin_amdgcn_ds_read_tr16_b64_v4i16((LAS s16x4*)(Vb + rowb + voff0)), a1 = __builtin_amdgcn_ds_read_tr16_b64_v4i16((LAS s16x4*)(Vb + rowb + 1024 + voff0));
            const s16x4 b0 = __builtin_amdgcn_ds_read_tr16_b64_v4i16((LAS s16x4*)(Vb + rowb + voff1)), b1 = __builtin_amdgcn_ds_read_tr16_b64_v4i16((LAS s16x4*)(Vb + rowb + 1024 + voff1));
            const bf16x8 v0 = __builtin_shufflevector(a0, a1, 0, 1, 2, 3, 4, 5, 6, 7), v1 = __builtin_shufflevector(b0, b1, 0, 1, 2, 3, 4, 5, 6, 7);
            o[0] = __builtin_amdgcn_mfma_f32_32x32x16_bf16(v0, pf, o[0], 0, 0, 0);
            o[1] = __builtin_amdgcn_mfma_f32_32x32x16_bf16(v1, pf, o[1], 0, 0, 0); } }
    const float inv = 1.f / l; const float lse2 = mx + __builtin_amdgcn_logf(l);
    if (COMBINE) {
        const bf16_t* O4 = (const bf16_t*)(A.ws + WS_ATTO); const bf16_t* O16 = O4 + (size_t)M * 512; const float* L4 = (const float*)(A.ws + WS_ATTL); const float* L16 = L4 + (size_t)M * 8;
        const float l4 = L4[mq * 8 + sb.h], l16 = L16[mq * 8 + sb.h]; const float mm = fmaxf(lse2, fmaxf(l4, l16));
        const float w1 = __builtin_amdgcn_exp2f(lse2 - mm), w4 = __builtin_amdgcn_exp2f(l4 - mm), w16 = __builtin_amdgcn_exp2f(l16 - mm); const float wi = 1.f / (w1 + w4 + w16);
        const float c1 = w1 * wi * inv, c4 = w4 * wi, c16 = w16 * wi;
        bf16_t* MX = (bf16_t*)(A.ws + WS_MIXED) + mq * D + 256 + sb.h * 64;
#pragma unroll
        for (int dt = 0; dt < 2; ++dt)
#pragma unroll
            for (int g = 0; g < 4; ++g) { const int d = 32 * dt + 8 * g + 4 * hh; const u32x2 a = *(const u32x2*)(O4 + mq * 512 + sb.h * 64 + d), b = *(const u32x2*)(O16 + mq * 512 + sb.h * 64 + d);
                const float y0 = c1 * o[dt][4 * g] + c4 * bf2f(a.x & 0xffffu) + c16 * bf2f(b.x & 0xffffu), y1 = c1 * o[dt][4 * g + 1] + c4 * bf2f(a.x >> 16) + c16 * bf2f(b.x >> 16);
                const float y2 = c1 * o[dt][4 * g + 2] + c4 * bf2f(a.y & 0xffffu) + c16 * bf2f(b.y & 0xffffu), y3 = c1 * o[dt][4 * g + 3] + c4 * bf2f(a.y >> 16) + c16 * bf2f(b.y >> 16);
                u32x2 w; w.x = cvtpk(y0, y1); w.y = cvtpk(y2, y3); *(u32x2*)(MX + d) = w; }
    } else {
        bf16_t* OD = (bf16_t*)(A.ws + WS_ATTO) + (size_t)(sb.di - 1) * M * 512 + mq * 512 + sb.h * 64; float* LD = (float*)(A.ws + WS_ATTL) + (size_t)(sb.di - 1) * M * 8;
#pragma unroll
        for (int dt = 0; dt < 2; ++dt)
#pragma unroll
            for (int g = 0; g < 4; ++g) { const int d = 32 * dt + 8 * g + 4 * hh;
                u32x2 w; w.x = cvtpk(o[dt][4 * g] * inv, o[dt][4 * g + 1] * inv); w.y = cvtpk(o[dt][4 * g + 2] * inv, o[dt][4 * g + 3] * inv); *(u32x2*)(OD + d) = w; }
        if (hh == 0) LD[mq * 8 + sb.h] = lse2;
    }
    __syncthreads();
}
__device__ __forceinline__ void phase_a(const Frame& F, const Args& A) {
    build_table(F, A.in[I_RELB]); __syncthreads();
    const int sub = F.wave >> 2;
    for (int bi = F.vcu; bi < 2048; bi += F.G) { const int round = bi >> 8, j = bi & 255; Sub sb;
        if (round < 4) { const int id = round * 256 + j, bh = id >> 3, k = 2 * (id & 7) + sub; sb.b = bh >> 3; sb.h = bh & 7; sb.dil = 4; sb.di = 1; sb.res = k >> 2; sb.n = k & 3; }
        else { const int id = (round - 4) * 256 + j, bh = id >> 3, k = 2 * (id & 7) + sub; sb.b = bh >> 3; sb.h = bh & 7; sb.dil = 16; sb.di = 2; sb.res = k; sb.n = 0; }
        run_pair<false>(F, A, sb); }
}
__device__ __forceinline__ void phase_b(const Frame& F, const Args& A) {
    build_table(F, A.in[I_RELB]); __syncthreads();
    const int sub = F.wave >> 2;
    for (int bi = F.vcu; bi < 1024; bi += F.G) { const int bh = bi >> 3; Sub sb; sb.b = bh >> 3; sb.h = bh & 7; sb.dil = 1; sb.di = 0; sb.res = 0; sb.n = 2 * (bi & 7) + sub;
        run_pair<true>(F, A, sb); }
}
__device__ __forceinline__ void phase_qknorm(const Frame& F, const Args& A, int layer) {
    bf16_t* PROJ = (bf16_t*)(A.ws + WS_A);
    const float qs = A.in[I_AT_QN][layer * 64 + F.lane] * A.in[I_AT_KN][layer * 64 + F.lane] * 0.125f * LOG2E;
    for (int m = F.gw; m < M; m += F.NGW) { bf16_t* row = PROJ + (size_t)m * NPROJ + C_AQ + F.lane;
#pragma unroll
        for (int j = 0; j < 16; ++j) { const float v = bf2f(row[64 * j]); const float ss = wave_sum(v * v) * (1.f / 64.f);
            row[64 * j] = (bf16_t)f2bf(v * rsqrtf(ss + EPS) * (j < 8 ? qs : 1.f)); } }
}
}

__device__ __forceinline__ void phase_conf_naive(const Frame& F, const Args& A, int layer) {
    const bf16_t* PROJ = (const bf16_t*)(A.ws + WS_A); bf16_t* MIXED = (bf16_t*)(A.ws + WS_MIXED);
    const float* dw = A.in[I_CV_DW] + (size_t)layer * CVK * CVW;
    const f32x4 bias = *((const f32x4*)(A.in[I_CV_DWB] + layer * CVW) + F.lane), lg = *((const f32x4*)(A.in[I_CV_LNG] + layer * CVW) + F.lane), lb = *((const f32x4*)(A.in[I_CV_LNB] + layer * CVW) + F.lane);
    for (int m = F.gw; m < M; m += F.NGW) { const int s = m % SEQ;
        f32x4 acc = bias;
#pragma unroll 1
        for (int i = 0; i < CVK; ++i) { if (s - 30 + i < 0) continue;
            const u32x2 a = *((const u32x2*)(PROJ + (size_t)(m - 30 + i) * NPROJ + C_CU) + F.lane), g = *((const u32x2*)(PROJ + (size_t)(m - 30 + i) * NPROJ + C_CG) + F.lane);
            const f32x4 w = *((const f32x4*)(dw + i * CVW) + F.lane);
            acc.x += w.x * bf2f(a.x & 0xffffu) * sigm(bf2f(g.x & 0xffffu)); acc.y += w.y * bf2f(a.x >> 16) * sigm(bf2f(g.x >> 16));
            acc.z += w.z * bf2f(a.y & 0xffffu) * sigm(bf2f(g.y & 0xffffu)); acc.w += w.w * bf2f(a.y >> 16) * sigm(bf2f(g.y >> 16)); }
        const float mean = wave_sum((acc.x + acc.y) + (acc.z + acc.w)) * (1.f / CVW);
        const f32x4 d = acc - mean; const float var = wave_sum((d.x * d.x + d.y * d.y) + (d.z * d.z + d.w * d.w)) * (1.f / CVW);
        const float rs = rsqrtf(var + EPS); f32x4 y = d * rs * lg + lb;
        u32x2 w; w.x = pk2(siluf(y.x), siluf(y.y)); w.y = pk2(siluf(y.z), siluf(y.w));
        *((u32x2*)(MIXED + (size_t)m * D + 768) + F.lane) = w;
    }
}
__device__ __forceinline__ void phase_p4(const Frame& F, const Args& A, int layer) {
    unsigned char* ws = A.ws;
    LAS float* scr = (LAS float*)(F.lds + F.wave * 16384);
    const float* eg = A.in[I_EX_GATE] + (size_t)layer * NE * D * DE; const float* eu = A.in[I_EX_UP] + (size_t)layer * NE * D * DE; const float* ed = A.in[I_EX_DOWN] + (size_t)layer * NE * DE * D;
    bf16_t* WGU = (bf16_t*)(ws + WS_WGU); bf16_t* WD = (bf16_t*)(ws + WS_WD);
    for (int it = F.gw; it < NE * 768; it += F.NGW) { const int e = it / 768, r = it % 768;
        if (r < 256) { const int kb = r / 16, nb = r % 16; transpose_item(eg + (size_t)e * D * DE, DE, nb * 32, kb * 64, WGU + (size_t)e * 1024 * D, D, 2 * nb * 32, 2, scr, F.lane); }
        else if (r < 512) { const int q = r - 256, kb = q / 16, nb = q % 16; transpose_item(eu + (size_t)e * D * DE, DE, nb * 32, kb * 64, WGU + (size_t)e * 1024 * D, D, 2 * nb * 32 + 1, 2, scr, F.lane); }
        else { const int q = r - 512, kb = q / 32, nb = q % 32; transpose_item(ed + (size_t)e * DE * D, D, nb * 32, kb * 64, WD + (size_t)e * 1024 * DE, DE, nb * 32, 1, scr, F.lane); }
    }
    const float* gffn = A.in[I_NORM_FFN] + layer * D;
    const float* rgw = A.in[I_RG_W] + (size_t)layer * D * NGRP; const float* rgb = A.in[I_RG_B] + layer * NGRP;
    const float* rew = A.in[I_RE_W] + (size_t)layer * D * NE; const float* reb = A.in[I_RE_B] + layer * NE;
    bf16_t* H = (bf16_t*)(ws + WS_H); int* ltok = (int*)(ws + WS_LTOK); float* lgate = (float*)(ws + WS_LGATE);
    unsigned* cnt = F.ctl + CW_CNT + layer * NE * 16;
    f32x4 gv[4];
#pragma unroll
    for (int j = 0; j < 4; ++j) gv[j] = *((const f32x4*)gffn + F.lane + 64 * j);
    for (int m = F.gw; m < M; m += F.NGW) {
        const f32x4* xr = (const f32x4*)(A.out + (size_t)m * D) + F.lane;
        f32x4 v[4]; float s = 0.f;
#pragma unroll
        for (int j = 0; j < 4; ++j) { v[j] = xr[64 * j]; s += (v[j].x * v[j].x + v[j].y * v[j].y) + (v[j].z * v[j].z + v[j].w * v[j].w); }
        const float rstd = rsqrtf(wave_sum(s) * (1.f / D) + EPS);
        u32x2* ho = (u32x2*)(H + (size_t)m * D) + F.lane;
        float gl[4] = {0.f, 0.f, 0.f, 0.f};
#pragma unroll
        for (int j = 0; j < 4; ++j) { v[j] = v[j] * rstd * gv[j];
            u32x2 w; w.x = pk2(v[j].x, v[j].y); w.y = pk2(v[j].z, v[j].w); ho[64 * j] = w;
#pragma unroll
            for (int e = 0; e < 4; ++e) { const int k = 4 * F.lane + 256 * j + e; const f32x4 wg = *(const f32x4*)(rgw + (size_t)k * NGRP); const float hv = v[j][e];
                gl[0] += hv * wg.x; gl[1] += hv * wg.y; gl[2] += hv * wg.z; gl[3] += hv * wg.w; } }
#pragma unroll
        for (int o = 0; o < 4; ++o) gl[o] = wave_sum(gl[o]) + rgb[o];
        int gs = 0; float gm = gl[0];
#pragma unroll
        for (int o = 1; o < 4; ++o) if (gl[o] > gm) { gm = gl[o]; gs = o; }
        float den = 0.f;
#pragma unroll
        for (int o = 0; o < 4; ++o) den += expf(gl[o] - gm);
        const float pgrp = 1.f / den;
        float el[8];
#pragma unroll
        for (int o = 0; o < 8; ++o) el[o] = 0.f;
#pragma unroll
        for (int j = 0; j < 4; ++j)
#pragma unroll
            for (int e = 0; e < 4; ++e) { const int k = 4 * F.lane + 256 * j + e; const f32x4* wp = (const f32x4*)(rew + (size_t)k * NE + gs * EPG); const f32x4 wa = wp[0], wb = wp[1]; const float hv = v[j][e];
                el[0] += hv * wa.x; el[1] += hv * wa.y; el[2] += hv * wa.z; el[3] += hv * wa.w; el[4] += hv * wb.x; el[5] += hv * wb.y; el[6] += hv * wb.z; el[7] += hv * wb.w; }
#pragma unroll
        for (int o = 0; o < 8; ++o) el[o] = wave_sum(el[o]) + reb[gs * EPG + o];
        int i0 = 0; float v0 = el[0];
#pragma unroll
        for (int o = 1; o < 8; ++o) if (el[o] > v0) { v0 = el[o]; i0 = o; }
        int i1 = -1; float v1 = -3.0e38f;
#pragma unroll
        for (int o = 0; o < 8; ++o) if (o != i0 && el[o] > v1) { v1 = el[o]; i1 = o; }
        const float e1 = expf(v1 - v0), g0 = pgrp / (1.f + e1), g1 = pgrp * e1 / (1.f + e1);
        if (F.lane < 2) { const int e = gs * EPG + (F.lane == 0 ? i0 : i1); const float g = F.lane == 0 ? g0 : g1;
            const unsigned pos = atomicAdd(cnt + e * 16, 1u);
            ltok[(size_t)e * M + pos] = 2 * m + F.lane; lgate[(size_t)e * M + pos] = g; }
    }
}
__device__ __forceinline__ void moe_tables(const Frame& F, int layer) {
    LAS int* cntL = (LAS int*)(F.lds + MOE_OFF); LAS int* hoffL = cntL + 32; LAS int* tstartL = hoffL + 32;
    __syncthreads();
    if (F.tid < NE) cntL[F.tid] = (int)__hip_atomic_load(F.ctl + CW_CNT + (layer * NE + F.tid) * 16, RLX_AGENT);
    __syncthreads();
    if (F.tid == 0) { int h = 0, t = 0; for (int e = 0; e < NE; ++e) { hoffL[e] = h; tstartL[e] = t; h += cntL[e]; t += (cntL[e] + 255) >> 8; } tstartL[NE] = t; }
    __syncthreads();
}
__device__ __forceinline__ void phase_final(const Frame& F, const Args& A) {
    const bf16_t* YS = (const bf16_t*)(A.ws + WS_A + 64 * MiB);
    for (int m = F.gw; m < M; m += F.NGW) {
        f32x4* xr = (f32x4*)(A.out + (size_t)m * D) + F.lane;
        const u32x2* y0 = (const u32x2*)(YS + (size_t)(2 * m) * D) + F.lane; const u32x2* y1 = (const u32x2*)(YS + (size_t)(2 * m + 1) * D) + F.lane;
#pragma unroll
        for (int j = 0; j < 4; ++j) { f32x4 v = xr[64 * j]; const u32x2 a = y0[64 * j], b = y1[64 * j];
            v.x += bf2f(a.x & 0xffffu) + bf2f(b.x & 0xffffu); v.y += bf2f(a.x >> 16) + bf2f(b.x >> 16);
            v.z += bf2f(a.y & 0xffffu) + bf2f(b.y & 0xffffu); v.w += bf2f(a.y >> 16) + bf2f(b.y >> 16); xr[64 * j] = v; }
    }
}

constexpr int PH_PER_LAYER = 9, N_PHASES = NLAYER * PH_PER_LAYER + 1;
__global__ void __launch_bounds__(NTHREADS, 2) hymba_fwd(Args args) {
    extern __shared__ __attribute__((aligned(16))) unsigned char lds_raw[];
    Frame F;
    F.lds = (LAS unsigned char*)lds_raw; F.MISC = (volatile LAS unsigned*)(F.lds + MISC_OFF);
    F.tid = threadIdx.x; F.lane = F.tid & 63; F.wave = __builtin_amdgcn_readfirstlane(F.tid >> 6);
    F.G = gridDim.x; { const int bx = blockIdx.x; F.vcu = (F.G % 8 == 0) ? (bx % 8) * (F.G / 8) + bx / 8 : bx; }
    F.gw = F.vcu * NWAVES + F.wave; F.NGW = F.G * NWAVES;
    F.ctl = (unsigned*)(args.ws + WS_CTL);
    for (int u = F.tid; u < (LDS_BYTES - LDSCTL_OFF) / 4; u += NTHREADS) ((LAS unsigned*)(F.lds + LDSCTL_OFF))[u] = 0u;
    __syncthreads();
    XcdBarrier bar; bar.bar = F.ctl + CW_BAR; bar.x = 0; bar.st = nullptr;
#if MK_ONE_LAUNCH
    bar = xcd_barrier_post(F.ctl + CW_BAR, F.MISC + 8);
#define GRID_BAR() xcd_barrier(bar)
#else
#define GRID_BAR() do { } while (0)
#endif
    const int lo = args.ph_lo, hi = args.ph_hi;
    unsigned char* ws = args.ws;
    for (int ph = lo; ph < hi; ++ph) {
        Frame Fp = F; asm volatile("" : "+v"(Fp.lane), "+v"(Fp.tid));
        const int layer = ph / PH_PER_LAYER, p = ph % PH_PER_LAYER;
        if (ph == N_PHASES - 1) { phase_final(Fp, args); }
        else if (p == 0) { phase_p0(Fp, args, layer); }
        else if (p == 1) {
            pg8::DenseSched<M / 256, NPROJ / 256> S{Fp.G, (int)blockIdx.x, D, (const bf16_t*)(ws + WS_WIN)};
            pg8::EpiProj E{(bf16_t*)(ws + WS_A), NPROJ};
            pg8::gemm_phase<pg8::EpiProj, pg8::DenseSched<M / 256, NPROJ / 256>>(Fp.lds, (const bf16_t*)(ws + WS_H), D, S, E);
        }
        else if (p == 2) { phase_dn_pre(Fp, args, layer); att::phase_qknorm(Fp, args, layer); }
        else if (p == 3) { phase_dn_scan_naive(Fp, args); att::phase_a(Fp, args); phase_conf_naive(Fp, args, layer); }
        else if (p == 4) { phase_dn_gate(Fp, args, layer); att::phase_b(Fp, args); }
        else if (p == 5) {
            pg8::DenseSched<M / 256, D / 256> S{Fp.G, (int)blockIdx.x, D, (const bf16_t*)(ws + WS_WOUT)};
            pg8::EpiResid E{layer == 0 ? args.in[I_X] : args.out, args.out, D};
            pg8::gemm_phase<pg8::EpiResid, pg8::DenseSched<M / 256, D / 256>>(Fp.lds, (const bf16_t*)(ws + WS_MIXED), D, S, E);
        }
        else if (p == 6) { phase_p4(Fp, args, layer); }
        else if (p == 7) {
            moe_tables(Fp, layer);
            pg8::MoeSched<false> S; S.cntL = (const LAS int*)(Fp.lds + MOE_OFF); S.hoffL = S.cntL + 32; S.tstartL = S.hoffL + 32; S.G = Fp.G; S.vc = Fp.vcu;
            S.ltok = (const int*)(ws + WS_LTOK); S.Bt = (const bf16_t*)(ws + WS_WGU);
            pg8::EpiGU E{(bf16_t*)(ws + WS_A)};
            pg8::gemm_phase<pg8::EpiGU, pg8::MoeSched<false>>(Fp.lds, (const bf16_t*)(ws + WS_H), D, S, E);
        }
        else {
            moe_tables(Fp, layer);
            pg8::MoeSched<true> S; S.cntL = (const LAS int*)(Fp.lds + MOE_OFF); S.hoffL = S.cntL + 32; S.tstartL = S.hoffL + 32; S.G = Fp.G; S.vc = Fp.vcu;
            S.ltok = (const int*)(ws + WS_LTOK); S.Bt = (const bf16_t*)(ws + WS_WD);
            pg8::EpiDown E{(bf16_t*)(ws + WS_A + 64 * MiB), (const int*)(ws + WS_LTOK), (const float*)(ws + WS_LGATE)};
            pg8::gemm_phase<pg8::EpiDown, pg8::MoeSched<true>>(Fp.lds, (const bf16_t*)(ws + WS_A), DE, S, E);
        }
        if (ph + 1 < hi) GRID_BAR();
    }
}

extern "C" void kernel_launch(void* const* d_in, const int* in_sizes, int n_in, void* d_out, int out_size, void* d_ws, size_t ws_size, hipStream_t stream) {
    static int grid = 0;
    if (grid == 0) {
        if (n_in != 23 || out_size != M * D || ws_size < WS_END) { fprintf(stderr, "kernel_launch: unexpected shapes (n_in %d out %d ws %zu)\n", n_in, out_size, ws_size); grid = -1; return; }
        int dev = 0, cus = 0, per_cu = 0;
        if (hipGetDevice(&dev) != hipSuccess || hipDeviceGetAttribute(&cus, hipDeviceAttributeMultiprocessorCount, dev) != hipSuccess) { grid = -1; return; }
        if (hipFuncSetAttribute((const void*)hymba_fwd, hipFuncAttributeMaxDynamicSharedMemorySize, LDS_BYTES) != hipSuccess) { fprintf(stderr, "kernel_launch: hipFuncSetAttribute failed\n"); grid = -1; return; }
        if (hipOccupancyMaxActiveBlocksPerMultiprocessor(&per_cu, (const void*)hymba_fwd, NTHREADS, LDS_BYTES) != hipSuccess || per_cu < 1) { fprintf(stderr, "kernel_launch: occupancy query says %d\n", per_cu); per_cu = 1; }
        (void)hipGetLastError();
        grid = cus;
    }
    if (grid < 0) return;
    (void)hipMemsetAsync((char*)d_ws + WS_CTL, 0, CTL_ZERO_BYTES, stream);
    Args a{};
    for (int i = 0; i < 23; ++i) a.in[i] = (const float*)d_in[i];
    a.out = (float*)d_out; a.ws = (unsigned char*)d_ws;
#if MK_ONE_LAUNCH
    a.ph_lo = 0; a.ph_hi = N_PHASES;
    void* kargs[] = {&a};
    hipError_t e = hipLaunchCooperativeKernel((const void*)hymba_fwd, dim3(grid), dim3(NTHREADS), kargs, LDS_BYTES, stream);
    if (e != hipSuccess) fprintf(stderr, "kernel_launch: cooperative launch failed: %s (grid %d)\n", hipGetErrorString(e), grid);
#else
    for (int ph = 0; ph < N_PHASES; ++ph) { a.ph_lo = ph; a.ph_hi = ph + 1;
        hipLaunchKernelGGL(hymba_fwd, dim3(grid), dim3(NTHREADS), LDS_BYTES, stream, a); }
#endif
}
```

```cpp
#include <hip/hip_runtime.h>
#include <cstdio>
#include <cstdint>

#ifndef PROBE_REP
#define PROBE_REP 0
#endif
#define REP(bit) for (int rep_ = 0; rep_ < (((PROBE_REP) >> (bit)) & 1) + 1; ++rep_)
#ifndef MK_ONE_LAUNCH
#define MK_ONE_LAUNCH 1
#endif

#define LAS __attribute__((address_space(3)))
#define GAS __attribute__((address_space(1)))
typedef unsigned short bf16_t;
typedef short bf16x8 __attribute__((ext_vector_type(8)));
typedef float f32x4 __attribute__((ext_vector_type(4)));
typedef float f32x2 __attribute__((ext_vector_type(2)));
typedef unsigned u32x4 __attribute__((ext_vector_type(4)));
typedef unsigned u32x2 __attribute__((ext_vector_type(2)));
typedef GAS unsigned gu32;
#define RLX_AGENT __ATOMIC_RELAXED, __HIP_MEMORY_SCOPE_AGENT
#define LDS_WAIT() asm volatile("s_waitcnt lgkmcnt(0)" ::: "memory")
#define VM_WAIT() asm volatile("s_waitcnt vmcnt(0)" ::: "memory")

constexpr int D = 1024, BATCH = 16, SEQ = 2048, M = BATCH * SEQ, NLAYER = 2;
constexpr int NIN = 3080, NPROJ = 3072;
constexpr int HD = 64, DNH = 4, ATH = 8, CVW = 256, CVK = 31;
constexpr int NGRP = 4, EPG = 8, NE = 32, DE = 512;
constexpr float EPS = 1e-6f;
constexpr int C_DQ = 0, C_DK = 256, C_DV = 512, C_DZ = 768, C_AQ = 1024, C_AK = 1536, C_AV = 2048, C_CU = 2560, C_CG = 2816;
constexpr int NWAVES = 8, NTHREADS = 512;

constexpr size_t MiB = 1u << 20;
constexpr size_t WS_CTL = 0, CTL_ZERO_BYTES = 1 * MiB;
constexpr size_t WS_WIN = 1 * MiB;
constexpr size_t WS_WOUT = 7 * MiB;
constexpr size_t WS_AB = 9 * MiB;
constexpr size_t WS_LTOK = 10 * MiB;
constexpr size_t WS_LGATE = 14 * MiB;
constexpr size_t WS_WGU = 18 * MiB;
constexpr size_t WS_WD = 82 * MiB;
constexpr size_t WS_H = 114 * MiB;
constexpr size_t WS_MIXED = 178 * MiB;
constexpr size_t WS_A = 242 * MiB;
constexpr size_t WS_ATTO = 434 * MiB;
constexpr size_t WS_ATTL = 498 * MiB;
constexpr size_t WS_END = 500 * MiB;
constexpr size_t WS_SCR = WS_WGU;
constexpr size_t WS_O = WS_H;
constexpr int CW_BAR = 4096;
constexpr int CW_CNT = 8192;
constexpr int CW_Q = 12288;

constexpr int RING_BYTES = 131072;
constexpr int LDS_BYTES = 155648;
constexpr int LDSCTL_OFF = 154624;
constexpr int MISC_OFF = LDSCTL_OFF;
constexpr int MOE_OFF = LDSCTL_OFF + 256;
constexpr int PTR_OFF = LDSCTL_OFF + 768;

__device__ __forceinline__ float bf2f(unsigned v) { return __uint_as_float(v << 16); }
__device__ __forceinline__ unsigned f2bf(float f) { unsigned u = __float_as_uint(f); return (u + 0x7fffu + ((u >> 16) & 1u)) >> 16; }
__device__ __forceinline__ unsigned pk2(float lo, float hi) { return f2bf(lo) | (f2bf(hi) << 16); }
__device__ __forceinline__ float wave_sum(float v) {
#pragma unroll
    for (int o = 1; o < 64; o <<= 1) v += __shfl_xor(v, o);
    return v;
}
__device__ __forceinline__ float wave_max(float v) {
#pragma unroll
    for (int o = 1; o < 64; o <<= 1) v = fmaxf(v, __shfl_xor(v, o));
    return v;
}
__device__ __forceinline__ float sigm(float x) { return 1.f / (1.f + expf(-x)); }
__device__ __forceinline__ float siluf(float x) { return x * sigm(x); }

namespace pg8 {
constexpr int BM = 256, BK = 64, HALF = 128, HTB = HALF * BK * 2, STAGE_BYTES = 8 * HTB, NXCD = 8, WGM = 8;
__host__ __device__ __forceinline__ int lds_byte(int r, int c) { const int st = (r >> 4) * 2 + (c >> 5), rr = r & 15, cc = c & 31, ob = rr * 64 + cc * 2; return st * 1024 + (ob ^ (((ob >> 9) & 1) << 5)); }
__host__ __device__ __forceinline__ void stage_rc(int b, int& R, int& C) { const int st = b / 1024, sb = b % 1024, swz = sb ^ (((sb >> 9) & 1) << 5); R = (st >> 1) * 16 + swz / 64; C = (st & 1) * 32 + (swz % 64) / 2; }
__host__ __device__ __forceinline__ int perm32(int rho) { const int n = rho >> 4, i = rho & 15; return 8 * (i >> 2) + 4 * n + (i & 3); }
typedef __bf16 bf16x2_t __attribute__((ext_vector_type(2)));
__device__ __forceinline__ unsigned cvt_pk_bf16(float lo, float hi) { f32x2 v = {lo, hi}; bf16x2_t b = __builtin_convertvector(v, bf16x2_t); return __builtin_bit_cast(unsigned, b); }

template <class Epi, class Sched>
__device__ __forceinline__ void gemm_phase(LAS unsigned char* lds, const bf16_t* Abase, const int K, const Sched& S, const Epi& E) {
    int tid_ = threadIdx.x; asm volatile("" : "+v"(tid_));
    const int tid = tid_, wid = __builtin_amdgcn_readfirstlane(tid >> 6), lane = tid & 63, wr = wid >> 2, wc = wid & 3, fr = lane & 15, fq = lane >> 4;
    const int nt = K / BK;
    int Rr[2], Cc2[2]; unsigned voffB[2];
#pragma unroll
    for (int i = 0; i < 2; ++i) { int R, C; stage_rc(tid * 16 + i * 8192, R, C); const int Rb = Epi::PERM ? ((R & ~31) + perm32(R & 31)) : R;
        Rr[i] = R; Cc2[i] = C * 2; voffB[i] = (unsigned)(Rb * K + C) * 2u; }
    const size_t kstep = (size_t)(BK * 2);
    const size_t hstep = (size_t)HALF * K * 2;
    const unsigned ldsw = (unsigned)wid * 1024u;
    const int aoff = lds_byte(wr * 64 + fr, fq * 8), boff = lds_byte(wc * 32 + fr, fq * 8);
    const char* Ab = (const char*)Abase;
#define PG8_SA(b, h) (((b) * 2 + (h)) * HTB)
#define PG8_SB(b, h) ((4 + (b) * 2 + (h)) * HTB)
#define PG8_STAGE(bufoff, gbase, voff) do { _Pragma("unroll") for (int _i = 0; _i < 2; ++_i) \
        __builtin_amdgcn_global_load_lds((const unsigned*)((const char*)(gbase) + (voff)[_i]), (LAS unsigned*)(lds + (bufoff) + ldsw + _i * 8192), 16, 0, 0); } while (0)
#define PG8_LDA(dst, b, h) do { _Pragma("unroll") for (int m = 0; m < 4; ++m) _Pragma("unroll") for (int k = 0; k < 2; ++k) dst[m][k] = *(const LAS bf16x8*)(lds + PG8_SA(b, h) + aoff + m * 2048 + k * 1024); } while (0)
#define PG8_LDB(dst, b, h) do { _Pragma("unroll") for (int n = 0; n < 2; ++n) _Pragma("unroll") for (int k = 0; k < 2; ++k) dst[n][k] = *(const LAS bf16x8*)(lds + PG8_SB(b, h) + boff + n * 2048 + k * 1024); } while (0)
#define PG8_MMA(ai, bj, At, Bt) do { __builtin_amdgcn_s_setprio(1); _Pragma("unroll") for (int m = 0; m < 4; ++m) _Pragma("unroll") for (int n = 0; n < 2; ++n) _Pragma("unroll") for (int k = 0; k < 2; ++k) \
        acc[ai][bj][m][n] = __builtin_amdgcn_mfma_f32_16x16x32_bf16(Bt[n][k], At[m][k], acc[ai][bj][m][n], 0, 0, 0); __builtin_amdgcn_s_setprio(0); } while (0)
#define PG8_WAIT_V(n) asm volatile("s_waitcnt vmcnt(" #n ")" ::: "memory")
#define PG8_WAIT_L(n) asm volatile("s_waitcnt lgkmcnt(" #n ")" ::: "memory")
#define PG8_BAR __builtin_amdgcn_s_barrier()
#define PG8_SCHED __builtin_amdgcn_sched_barrier(0)
    typename Sched::Unit cur, nxt; int ui = 0;
    if (!S.next(0, cur)) return;
    unsigned va0[2], va1[2], vn0[2], vn1[2];
    const char* cA = Ab; const char* nA = Ab;
    if constexpr (Sched::GATHER) {
#pragma unroll
        for (int i = 0; i < 2; ++i) { va0[i] = S.a_off(cur, Rr[i]) + (unsigned)Cc2[i]; va1[i] = S.a_off(cur, HALF + Rr[i]) + (unsigned)Cc2[i]; }
    } else {
#pragma unroll
        for (int i = 0; i < 2; ++i) { va0[i] = (unsigned)(Rr[i] * K * 2 + Cc2[i]); va1[i] = va0[i] + (unsigned)hstep; vn0[i] = va0[i]; vn1[i] = va1[i]; }
        cA = Ab + S.a_base(cur);
    }
    f32x4 acc[2][2][4][2];
#pragma unroll
    for (int a = 0; a < 2; ++a)
#pragma unroll
        for (int b = 0; b < 2; ++b)
#pragma unroll
            for (int m = 0; m < 4; ++m)
#pragma unroll
                for (int n = 0; n < 2; ++n) acc[a][b][m][n] = (f32x4){0.f, 0.f, 0.f, 0.f};
    bf16x8 At[4][2], B0[2][2], B1[2][2];
    const char* cB = S.b_base(cur);
    PG8_STAGE(PG8_SB(0, 0), cB, voffB); PG8_STAGE(PG8_SB(0, 1), cB + hstep, voffB); PG8_STAGE(PG8_SA(0, 0), cA, va0); PG8_STAGE(PG8_SA(0, 1), cA, va1);
    if (wr == 1) PG8_BAR;
    PG8_WAIT_V(2); PG8_BAR;
    PG8_STAGE(PG8_SB(1, 0), cB + kstep, voffB); PG8_STAGE(PG8_SA(1, 0), cA + kstep, va0); PG8_STAGE(PG8_SB(1, 1), cB + hstep + kstep, voffB);
    PG8_WAIT_V(6); PG8_BAR;
    for (;;) {
        const bool has_next = S.next(ui + 1, nxt);
        const char* nB = cB; nA = cA;
        if (has_next) { nB = S.b_base(nxt);
            if constexpr (Sched::GATHER) {
#pragma unroll
                for (int i = 0; i < 2; ++i) { vn0[i] = S.a_off(nxt, Rr[i]) + (unsigned)Cc2[i]; vn1[i] = S.a_off(nxt, HALF + Rr[i]) + (unsigned)Cc2[i]; }
            } else nA = Ab + S.a_base(nxt);
        } else if constexpr (Sched::GATHER) {
#pragma unroll
            for (int i = 0; i < 2; ++i) { vn0[i] = va0[i]; vn1[i] = va1[i]; } }
        for (int t = 0; t < nt; t += 2) {
            const bool last = (t == nt - 2);
            const char* a1 = cA + (size_t)(t + 1) * kstep;
            const char* a2 = last ? nA : cA + (size_t)(t + 2) * kstep; const char* b2 = last ? nB : cB + (size_t)(t + 2) * kstep;
            const char* a3 = a2 + kstep; const char* b3 = b2 + kstep;
            unsigned w0[2], w1[2];
#pragma unroll
            for (int i = 0; i < 2; ++i) { if constexpr (Sched::GATHER) { w0[i] = last ? vn0[i] : va0[i]; w1[i] = last ? vn1[i] : va1[i]; } else { w0[i] = va0[i]; w1[i] = va1[i]; } }
            PG8_LDB(B0, 0, 0); PG8_LDB(B1, 0, 1); PG8_SCHED; PG8_LDA(At, 0, 0); PG8_STAGE(PG8_SA(1, 1), a1, va1);
            PG8_WAIT_V(8); PG8_WAIT_L(0); PG8_BAR; PG8_MMA(0, 0, At, B0); PG8_MMA(0, 1, At, B1); PG8_BAR; PG8_SCHED;
            PG8_LDA(At, 0, 1); PG8_STAGE(PG8_SB(0, 0), b2, voffB); PG8_STAGE(PG8_SB(0, 1), b2 + hstep, voffB); PG8_STAGE(PG8_SA(0, 0), a2, w0);
            PG8_WAIT_V(8); PG8_WAIT_L(0); PG8_BAR; PG8_MMA(1, 0, At, B0); PG8_MMA(1, 1, At, B1); PG8_BAR; PG8_SCHED;
            PG8_LDB(B0, 1, 0); PG8_LDB(B1, 1, 1); PG8_SCHED; PG8_LDA(At, 1, 0); PG8_STAGE(PG8_SA(0, 1), a2, w1);
            PG8_WAIT_V(8); PG8_WAIT_L(0); PG8_BAR; PG8_MMA(0, 0, At, B0); PG8_MMA(0, 1, At, B1); PG8_BAR; PG8_SCHED;
            PG8_LDA(At, 1, 1); PG8_STAGE(PG8_SB(1, 0), b3, voffB); PG8_STAGE(PG8_SB(1, 1), b3 + hstep, voffB); PG8_STAGE(PG8_SA(1, 0), a3, w0);
            PG8_WAIT_V(8); PG8_WAIT_L(0); PG8_BAR; PG8_MMA(1, 0, At, B0); PG8_MMA(1, 1, At, B1); PG8_BAR; PG8_SCHED;
        }
        if (wr == 0) PG8_BAR;
        E(acc, cur, wr, wc, fr, fq);
        if (!has_next) break;
#pragma unroll
        for (int a = 0; a < 2; ++a)
#pragma unroll
            for (int b = 0; b < 2; ++b)
#pragma unroll
                for (int m = 0; m < 4; ++m)
#pragma unroll
                    for (int n = 0; n < 2; ++n) acc[a][b][m][n] = (f32x4){0.f, 0.f, 0.f, 0.f};
        cur = nxt; cB = nB; cA = nA; ++ui;
        if constexpr (Sched::GATHER) {
#pragma unroll
            for (int i = 0; i < 2; ++i) { va0[i] = vn0[i]; va1[i] = vn1[i]; } }
        if (wr == 1) PG8_BAR;
    }
    PG8_WAIT_V(0);
    PG8_BAR;
#undef PG8_SA
#undef PG8_SB
#undef PG8_STAGE
#undef PG8_LDA
#undef PG8_LDB
#undef PG8_MMA
#undef PG8_WAIT_V
#undef PG8_WAIT_L
#undef PG8_BAR
#undef PG8_SCHED
}

struct DUnit { int pm, pn; };
template <int NM, int NN>
struct DenseSched {
    typedef DUnit Unit; static constexpr bool GATHER = false;
    int G, c, K; const bf16_t* Bt;
    __device__ __forceinline__ bool next(int i, Unit& u) const {
        constexpr int nwg = NM * NN, q = nwg / NXCD; static_assert(nwg % NXCD == 0 && NM % WGM == 0, "tile counts");
        const int L = i * G + c; if (L >= nwg) return false;
        const int wgid = (L % NXCD) * q + L / NXCD;
        constexpr int nig = WGM * NN; const int gid = wgid / nig, fm = gid * WGM;
        u.pm = fm + ((wgid % nig) % WGM); u.pn = (wgid % nig) / WGM; return true;
    }
    __device__ __forceinline__ size_t a_base(const Unit& u) const { return (size_t)u.pm * BM * K * 2; }
    __device__ __forceinline__ unsigned a_off(const Unit&, int) const { return 0u; }
    __device__ __forceinline__ const char* b_base(const Unit& u) const { return (const char*)(Bt + (size_t)u.pn * BM * K); }
};
struct MUnit { int e, mt, pn, cnt, hoff; };
template <bool DOWN>
struct MoeSched {
    typedef MUnit Unit; static constexpr bool GATHER = true;
    __device__ __forceinline__ size_t a_base(const Unit&) const { return 0; }
    const LAS int* cntL; const LAS int* hoffL; const LAS int* tstartL;
    int G, vc; const int* ltok; const bf16_t* Bt;
    __device__ __forceinline__ bool next(int i, Unit& u) const {
        const int total = tstartL[NE] * 4; const long L = (long)i * G + vc; if (L >= total) return false;
        const int mtg = (int)L >> 2; u.pn = (int)L & 3;
        int e = 0;
#pragma unroll 1
        for (int k = 1; k < NE; ++k) if (tstartL[k] <= mtg) e = k;
        u.e = e; u.mt = mtg - tstartL[e]; u.cnt = cntL[e]; u.hoff = hoffL[e]; return true;
    }
    __device__ __forceinline__ unsigned a_off(const Unit& u, int row) const {
        int idx = u.mt * BM + row; idx = idx < u.cnt ? idx : u.cnt - 1;
        if (DOWN) return (unsigned)(u.hoff + idx) * (unsigned)(DE * 2);
        const int t2 = ltok[(size_t)u.e * M + idx]; return (unsigned)(t2 >> 1) * (unsigned)(D * 2);
    }
    __device__ __forceinline__ const char* b_base(const Unit& u) const { return (const char*)(Bt + ((size_t)u.e * 1024 + (size_t)u.pn * BM) * (DOWN ? DE : D)); }
};

struct EpiProj {
    static constexpr bool PERM = true;
    bf16_t* O; int ldc;
    __device__ __forceinline__ void operator()(const f32x4 (&acc)[2][2][4][2], const DUnit& u, int wr, int wc, int fr, int fq) const {
        const int row0 = u.pm * BM + wr * 64 + fr, col0 = u.pn * BM + wc * 32 + 8 * fq;
#pragma unroll
        for (int ai = 0; ai < 2; ++ai)
#pragma unroll
            for (int m = 0; m < 4; ++m) { bf16_t* rowp = O + (size_t)(row0 + ai * HALF + m * 16) * ldc + col0;
#pragma unroll
                for (int bj = 0; bj < 2; ++bj) { const f32x4 v0 = acc[ai][bj][m][0], v1 = acc[ai][bj][m][1];
                    u32x4 w; w.x = cvt_pk_bf16(v0[0], v0[1]); w.y = cvt_pk_bf16(v0[2], v0[3]); w.z = cvt_pk_bf16(v1[0], v1[1]); w.w = cvt_pk_bf16(v1[2], v1[3]);
                    *(u32x4*)(rowp + bj * HALF) = w; } }
    }
};
struct EpiResid {
    static constexpr bool PERM = false;
    const float* resid; float* out; int ldc;
    __device__ __forceinline__ void operator()(const f32x4 (&acc)[2][2][4][2], const DUnit& u, int wr, int wc, int fr, int fq) const {
        const int row0 = u.pm * BM + wr * 64 + fr, col0 = u.pn * BM + wc * 32 + 4 * fq;
#pragma unroll
        for (int ai = 0; ai < 2; ++ai)
#pragma unroll
            for (int m = 0; m < 4; ++m) { const size_t off = (size_t)(row0 + ai * HALF + m * 16) * ldc + col0;
#pragma unroll
                for (int bj = 0; bj < 2; ++bj)
#pragma unroll
                    for (int n = 0; n < 2; ++n) { const f32x4 r = *(const f32x4*)(resid + off + bj * HALF + n * 16); *(f32x4*)(out + off + bj * HALF + n * 16) = r + acc[ai][bj][m][n]; } }
    }
};
struct EpiGU {
    static constexpr bool PERM = true;
    bf16_t* HID;
    __device__ __forceinline__ void operator()(const f32x4 (&acc)[2][2][4][2], const MUnit& u, int wr, int wc, int fr, int fq) const {
        const int r0 = wr * 64 + fr, j0 = u.pn * 128 + wc * 16 + 4 * fq;
#pragma unroll
        for (int ai = 0; ai < 2; ++ai)
#pragma unroll
            for (int m = 0; m < 4; ++m) { const int idx = u.mt * BM + r0 + ai * HALF + m * 16;
                if (idx < u.cnt) { bf16_t* rowp = HID + (size_t)(u.hoff + idx) * DE + j0;
#pragma unroll
                    for (int bj = 0; bj < 2; ++bj) { const f32x4 v0 = acc[ai][bj][m][0], v1 = acc[ai][bj][m][1];
                        const float h0 = siluf(v0[0]) * v0[1], h1 = siluf(v0[2]) * v0[3], h2 = siluf(v1[0]) * v1[1], h3 = siluf(v1[2]) * v1[3];
                        u32x2 w; w.x = cvt_pk_bf16(h0, h1); w.y = cvt_pk_bf16(h2, h3);
                        *(u32x2*)(rowp + bj * 64) = w; } } }
    }
};
struct EpiDown {
    static constexpr bool PERM = true;
    bf16_t* YS; const int* ltok; const float* lgate;
    __device__ __forceinline__ void operator()(const f32x4 (&acc)[2][2][4][2], const MUnit& u, int wr, int wc, int fr, int fq) const {
        const int r0 = wr * 64 + fr, col0 = u.pn * BM + wc * 32 + 8 * fq;
#pragma unroll
        for (int ai = 0; ai < 2; ++ai)
#pragma unroll
            for (int m = 0; m < 4; ++m) { const int idx = u.mt * BM + r0 + ai * HALF + m * 16;
                if (idx < u.cnt) { const int t2 = ltok[(size_t)u.e * M + idx]; const float g = lgate[(size_t)u.e * M + idx];
                    bf16_t* rowp = YS + (size_t)t2 * D + col0;
#pragma unroll
                    for (int bj = 0; bj < 2; ++bj) { const f32x4 v0 = acc[ai][bj][m][0] * g, v1 = acc[ai][bj][m][1] * g;
                        u32x4 w; w.x = cvt_pk_bf16(v0[0], v0[1]); w.y = cvt_pk_bf16(v0[2], v0[3]); w.z = cvt_pk_bf16(v1[0], v1[1]); w.w = cvt_pk_bf16(v1[2], v1[3]);
                        *(u32x4*)(rowp + bj * HALF) = w; } } }
    }
};
}

#define XB_TMO      128
#define XB_XCNT(j)  (256  + 64 * (j))
#define XB_XSUB(j)  (1280 + 64 * (j))
#define XB_XGEN(j)  (2304 + 64 * (j))
#define XB_TOP      3328
#define XB_TOPGEN   3392
#define XCD_BAR_WORDS 3456
#define XB_SPIN_CAP (1u << 22)
__device__ __forceinline__ unsigned xb_ld(unsigned* p)              { return __hip_atomic_load(p, __ATOMIC_RELAXED, __HIP_MEMORY_SCOPE_AGENT); }
__device__ __forceinline__ unsigned xb_add(unsigned* p, unsigned v) { return __hip_atomic_fetch_add(p, v, __ATOMIC_RELAXED, __HIP_MEMORY_SCOPE_AGENT); }
__device__ __forceinline__ unsigned xb_xcc_id() { return (unsigned)__builtin_amdgcn_s_getreg((3 << 11) | 20) & 0xFu; }
#define XB_SPIN(cond, bar) do { unsigned _sp = 0; while (cond) { __builtin_amdgcn_s_sleep(1); \
    if ((++_sp & 255u) == 0u) { if (xb_ld(&(bar)[XB_TMO])) break; if (_sp > XB_SPIN_CAP) { atomicAdd(&(bar)[XB_TMO], 1u); break; } } } } while (0)
struct XcdBarrier { unsigned* bar; unsigned x; volatile LAS unsigned* st; };
__device__ __forceinline__ XcdBarrier xcd_barrier_post(unsigned* bar, volatile LAS unsigned* st) {
    XcdBarrier b; b.bar = bar; b.x = xb_xcc_id(); b.st = st;
    if (threadIdx.x == 0) (void)xb_add(&bar[XB_XCNT(b.x)], 1u);
    return b;
}
__device__ __forceinline__ void xcd_barrier_complete(unsigned* bar, unsigned x, unsigned& nloc, unsigned& nx) {
    const unsigned G = gridDim.x * gridDim.y * gridDim.z;
    unsigned sum, cnt, mine, sp = 0u;
    for (;;) {
        sum = 0u; cnt = 0u; mine = 0u;
#pragma unroll
        for (unsigned j = 0; j < 16; ++j) { const unsigned c = xb_ld(&bar[XB_XCNT(j)]); sum += c; cnt += (c > 0u) ? 1u : 0u; mine = (j == x) ? c : mine; }
        if (sum == G) break;
        __builtin_amdgcn_s_sleep(1);
        if ((++sp & 255u) == 0u) { if (xb_ld(&bar[XB_TMO])) break; if (sp > XB_SPIN_CAP) { atomicAdd(&bar[XB_TMO], 1u); break; } }
    }
    nloc = mine > 0u ? mine : 1u; nx = cnt > 0u ? cnt : 1u;
}
__device__ __forceinline__ void xcd_barrier(const XcdBarrier& b) {
    asm volatile("s_waitcnt vmcnt(0)" ::: "memory");
    __syncthreads();
    if (threadIdx.x == 0) {
        unsigned* bar = b.bar;
        __builtin_amdgcn_s_waitcnt(0);
        unsigned nloc = b.st[0], nx = b.st[1];
        if (nloc == 0u) { xcd_barrier_complete(bar, b.x, nloc, nx); b.st[0] = nloc; b.st[1] = nx; }
        const unsigned old = xb_add(&bar[XB_XSUB(b.x)], 1u);
        const unsigned gen = old / nloc;
        if (old + 1u == (gen + 1u) * nloc) {
            __builtin_amdgcn_fence(__ATOMIC_RELEASE, "agent");
            asm volatile("s_waitcnt vmcnt(0)" ::: "memory");
            const unsigned og = xb_add(&bar[XB_TOP], 1u);
            const unsigned tg = og / nx;
            if (og + 1u == (tg + 1u) * nx) xb_add(&bar[XB_TOPGEN], 1u);
            else XB_SPIN(xb_ld(&bar[XB_TOPGEN]) == tg, bar);
            __builtin_amdgcn_fence(__ATOMIC_ACQUIRE, "agent");
            xb_add(&bar[XB_XGEN(b.x)], 1u);
            asm volatile("s_waitcnt vmcnt(0)" ::: "memory");
        } else {
            XB_SPIN(xb_ld(&bar[XB_XGEN(b.x)]) == gen, bar);
            __builtin_amdgcn_fence(__ATOMIC_ACQUIRE, "agent");
            asm volatile("s_waitcnt vmcnt(0)" ::: "memory");
        }
    }
    __syncthreads();
}

struct Args {
    const float* in[23]; float* out; unsigned char* ws; int ph_lo, ph_hi;
};
struct Frame {
    LAS unsigned char* lds; volatile LAS unsigned* MISC; unsigned* ctl;
    int tid, lane, wave, vcu, G, gw, NGW;
};
enum { I_X = 0, I_NORM_MIX, I_W_IN, I_DN_CONV, I_DN_ALOG, I_DN_DTB, I_DN_ONORM, I_AT_QN, I_AT_KN, I_RELB, I_CV_DW, I_CV_DWB, I_CV_LNG, I_CV_LNB,
       I_W_OUT, I_NORM_FFN, I_RG_W, I_RG_B, I_RE_W, I_RE_B, I_EX_GATE, I_EX_UP, I_EX_DOWN };

__device__ __forceinline__ void transpose_item(const float* W, int ldw, int src_col0, int k0, bf16_t* WT, int Kd, int dst_row0, int dst_mul, LAS float* scr, int lane) {
    const float* wp = W + (size_t)k0 * ldw + src_col0 + lane;
#pragma unroll
    for (int h2 = 0; h2 < 2; ++h2) { float v[32];
#pragma unroll
        for (int i = 0; i < 32; ++i) v[i] = wp[(size_t)(h2 * 32 + i) * ldw];
#pragma unroll
        for (int i = 0; i < 32; ++i) scr[(h2 * 32 + i) * 65 + lane] = v[i]; }
    LDS_WAIT(); asm volatile("" ::: "memory");
    const int c = lane & 7;
#pragma unroll
    for (int j = 0; j < 8; ++j) { const int n = (lane >> 3) + 8 * j; const LAS float* s = scr + (8 * c) * 65 + n;
        u32x4 o; o.x = pk2(s[0 * 65], s[1 * 65]); o.y = pk2(s[2 * 65], s[3 * 65]); o.z = pk2(s[4 * 65], s[5 * 65]); o.w = pk2(s[6 * 65], s[7 * 65]);
        *(u32x4*)(WT + (size_t)(dst_row0 + dst_mul * n) * Kd + k0 + 8 * c) = o; }
    LDS_WAIT(); asm volatile("" ::: "memory");
}
constexpr int TR_SCR = 64 * 65 * 4;

__device__ __forceinline__ void phase_p0(const Frame& F, const Args& A, int layer) {
    unsigned char* ws = A.ws;
    LAS float* scr = (LAS float*)(F.lds + F.wave * TR_SCR);
    const float* w_in = A.in[I_W_IN] + (size_t)layer * D * NIN;
    const float* w_out = A.in[I_W_OUT] + (size_t)layer * D * D;
    bf16_t* WIN = (bf16_t*)(ws + WS_WIN); bf16_t* WOUT = (bf16_t*)(ws + WS_WOUT);
    constexpr int I_IN = (D / 64) * (NPROJ / 64), I_OUT = (D / 64) * (D / 64);
    for (int it = F.gw; it < I_IN + I_OUT; it += F.NGW) {
        if (it < I_IN) { const int nblk = NPROJ / 64, kb = it / nblk, nb = it % nblk, n0 = nb * 64; const int src = n0 < 1024 ? n0 : n0 + 8;
            transpose_item(w_in, NIN, src, kb * 64, WIN, D, n0, 1, scr, F.lane); }
        else { const int r = it - I_IN, nblk = D / 64, kb = r / nblk, nb = r % nblk;
            transpose_item(w_out, D, nb * 64, kb * 64, WOUT, D, nb * 64, 1, scr, F.lane); }
    }
    const float* xin = layer == 0 ? A.in[I_X] : A.out;
    const float* gmix = A.in[I_NORM_MIX] + layer * D;
    bf16_t* H = (bf16_t*)(ws + WS_H); float* AB = (float*)(ws + WS_AB);
    const bf16_t* YS = (const bf16_t*)(ws + WS_A + 64 * MiB);
    __syncthreads();
    LAS float* wabT = (LAS float*)F.lds;
    for (int idx = F.tid; idx < 2 * D; idx += NTHREADS) { const int k = idx & (D - 1), o4 = idx >> 10; const f32x4 w = *(const f32x4*)(w_in + (size_t)k * NIN + 1024 + 4 * o4);
        wabT[(4 * o4 + 0) * D + k] = w.x; wabT[(4 * o4 + 1) * D + k] = w.y; wabT[(4 * o4 + 2) * D + k] = w.z; wabT[(4 * o4 + 3) * D + k] = w.w; }
    __syncthreads();
    f32x4 gv[4];
#pragma unroll
    for (int j = 0; j < 4; ++j) gv[j] = *((const f32x4*)gmix + F.lane + 64 * j);
    for (int m = F.gw; m < M; m += F.NGW) {
        const f32x4* xr = (const f32x4*)(xin + (size_t)m * D) + F.lane;
        f32x4 v[4]; float s = 0.f;
#pragma unroll
        for (int j = 0; j < 4; ++j) v[j] = xr[64 * j];
        if (layer > 0) {
            const u32x2* y0 = (const u32x2*)(YS + (size_t)(2 * m) * D) + F.lane; const u32x2* y1 = (const u32x2*)(YS + (size_t)(2 * m + 1) * D) + F.lane;
#pragma unroll
            for (int j = 0; j < 4; ++j) { const u32x2 a = y0[64 * j], b = y1[64 * j];
                v[j].x += bf2f(a.x & 0xffffu) + bf2f(b.x & 0xffffu); v[j].y += bf2f(a.x >> 16) + bf2f(b.x >> 16);
                v[j].z += bf2f(a.y & 0xffffu) + bf2f(b.y & 0xffffu); v[j].w += bf2f(a.y >> 16) + bf2f(b.y >> 16); }
            f32x4* xo = (f32x4*)(A.out + (size_t)m * D) + F.lane;
#pragma unroll
            for (int j = 0; j < 4; ++j) xo[64 * j] = v[j];
        }
#pragma unroll
        for (int j = 0; j < 4; ++j) s += (v[j].x * v[j].x + v[j].y * v[j].y) + (v[j].z * v[j].z + v[j].w * v[j].w);
        const float rstd = rsqrtf(wave_sum(s) * (1.f / D) + EPS);
        u32x2* ho = (u32x2*)(H + (size_t)m * D) + F.lane;
        float ab[8];
#pragma unroll
        for (int o = 0; o < 8; ++o) ab[o] = 0.f;
#pragma unroll
        for (int j = 0; j < 4; ++j) { v[j] = v[j] * rstd * gv[j];
            u32x2 w; w.x = pk2(v[j].x, v[j].y); w.y = pk2(v[j].z, v[j].w); ho[64 * j] = w;
#pragma unroll
            for (int o = 0; o < 8; ++o) { const f32x4 wv = *((const LAS f32x4*)(wabT + o * D) + F.lane + 64 * j); ab[o] += (v[j].x * wv.x + v[j].y * wv.y) + (v[j].z * wv.z + v[j].w * wv.w); } }
        float mine = 0.f;
#pragma unroll
        for (int o = 0; o < 8; ++o) { const float t = wave_sum(ab[o]); if (F.lane == o) mine = t; }
        if (F.lane < 8) AB[(size_t)m * 8 + F.lane] = mine;
    }
}

__device__ __forceinline__ void phase_dn_pre(const Frame& F, const Args& A, int layer) {
    const bf16_t* PROJ = (const bf16_t*)(A.ws + WS_A); float* SCR = (float*)(A.ws + WS_SCR); float* AB = (float*)(A.ws + WS_AB);
    const float* cw = A.in[I_DN_CONV] + (size_t)layer * 4 * 768;
    const float* alog = A.in[I_DN_ALOG] + layer * 4; const float* dtb = A.in[I_DN_DTB] + layer * 4;
    for (int m = F.gw; m < M; m += F.NGW) {
        const int s = m % SEQ;
#pragma unroll
        for (int j = 0; j < 12; ++j) { const int c = F.lane + 64 * j; float y = 0.f;
#pragma unroll
            for (int i = 0; i < 4; ++i) { if (s - 3 + i >= 0) y += cw[i * 768 + c] * bf2f(PROJ[(size_t)(m - 3 + i) * NPROJ + c]); }
            y = siluf(y);
            if (j < 8) { const float ss = wave_sum(y * y); y *= rsqrtf(ss + EPS) * (j < 4 ? 0.125f : 1.f); }
            SCR[(size_t)m * 768 + c] = y; }
        if (F.lane < 8) { const float a = AB[(size_t)m * 8 + F.lane]; float r;
            if (F.lane < 4) { const float x = a + dtb[F.lane]; const float sp = fmaxf(x, 0.f) + log1pf(expf(-fabsf(x))); r = -expf(alog[F.lane]) * sp; }
            else r = sigm(a);
            AB[(size_t)m * 8 + F.lane] = r; }
    }
}
__device__ __forceinline__ void phase_dn_scan_naive(const Frame& F, const Args& A) {
    if (blockIdx.x >= 32) return;
    const float* SCR = (const float*)(A.ws + WS_SCR); const float* AB = (const float*)(A.ws + WS_AB); float* O = (float*)(A.ws + WS_O);
    const int pair = blockIdx.x * 2 + (F.wave >> 2), b = pair >> 2, h = pair & 3;
    const int j = (F.wave & 3) * 16 + (F.lane >> 2), dg = F.lane & 3;
    float S[16];
#pragma unroll
    for (int i = 0; i < 16; ++i) S[i] = 0.f;
    for (int s = 0; s < SEQ; ++s) { const size_t m = (size_t)b * SEQ + s;
        const f32x4* kp = (const f32x4*)(SCR + m * 768 + 256 + h * 64 + dg * 16); const f32x4* qp = (const f32x4*)(SCR + m * 768 + h * 64 + dg * 16);
        const float v = SCR[m * 768 + 512 + h * 64 + j]; const float eg = expf(AB[m * 8 + h]), beta = AB[m * 8 + 4 + h];
        float k[16], q[16];
#pragma unroll
        for (int i = 0; i < 4; ++i) { const f32x4 a = kp[i], c = qp[i]; k[4 * i] = a.x; k[4 * i + 1] = a.y; k[4 * i + 2] = a.z; k[4 * i + 3] = a.w; q[4 * i] = c.x; q[4 * i + 1] = c.y; q[4 * i + 2] = c.z; q[4 * i + 3] = c.w; }
        float ks = 0.f;
#pragma unroll
        for (int i = 0; i < 16; ++i) ks += k[i] * S[i];
        ks += __shfl_xor(ks, 1); ks += __shfl_xor(ks, 2);
        const float c = beta * (v - eg * ks); float o = 0.f;
#pragma unroll
        for (int i = 0; i < 16; ++i) { S[i] = eg * S[i] + k[i] * c; o += q[i] * S[i]; }
        o += __shfl_xor(o, 1); o += __shfl_xor(o, 2);
        if (dg == 0) O[m * 256 + h * 64 + j] = o;
    }
}
__device__ __forceinline__ void phase_dn_gate(const Frame& F, const Args& A, int layer) {
    const bf16_t* PROJ = (const bf16_t*)(A.ws + WS_A); const float* O = (const float*)(A.ws + WS_O); bf16_t* MIXED = (bf16_t*)(A.ws + WS_MIXED);
    const float gn = A.in[I_DN_ONORM][layer * 64 + F.lane];
    for (int idx = F.gw; idx < M * DNH; idx += F.NGW) { const int m = idx >> 2, h = idx & 3;
        const float o = O[(size_t)m * 256 + h * 64 + F.lane]; const float ms = wave_sum(o * o) * (1.f / 64.f);
        const float z = bf2f(PROJ[(size_t)m * NPROJ + C_DZ + h * 64 + F.lane]);
        MIXED[(size_t)m * D + h * 64 + F.lane] = (bf16_t)f2bf(o * rsqrtf(ms + EPS) * gn * siluf(z)); }
}
__device__ __forceinline__ float t5_bias(const float* relb, int h, int dist) {
    int bucket;
    if (dist < 16) bucket = dist;
    else { const int lb = 16 + (int)(logf((float)dist / 16.f) / 4.852030263919617f * 16.f); bucket = lb < 31 ? lb : 31; }
    return relb[bucket * ATH + h];
}
__device__ __forceinline__ void phase_attn_naive(const Frame& F, const Args& A, int layer) {
    const bf16_t* PROJ = (const bf16_t*)(A.ws + WS_A); bf16_t* MIXED = (bf16_t*)(A.ws + WS_MIXED);
    LAS float* qk = (LAS float*)(F.lds + F.wave * 4096); LAS float* pl = qk + 64;
    const float qn = A.in[I_AT_QN][layer * 64 + F.lane], kn = A.in[I_AT_KN][layer * 64 + F.lane];
    const float* relb = A.in[I_RELB];
    const int dil[3] = {1, 4, 16};
    for (int idx = F.gw; idx < M * ATH; idx += F.NGW) { const int m = idx >> 3, h = idx & 7, s = m % SEQ;
        const float qv = bf2f(PROJ[(size_t)m * NPROJ + C_AQ + h * 64 + F.lane]);
        const float qss = wave_sum(qv * qv) * (1.f / 64.f);
        qk[F.lane] = qv * rsqrtf(qss + EPS) * qn * 0.125f * kn;
        LDS_WAIT(); asm volatile("" ::: "memory");
        float sc[9]; float mx = -1e30f;
#pragma unroll
        for (int di = 0; di < 3; ++di)
#pragma unroll
            for (int jb = 0; jb < 3; ++jb) { const int j = jb * 64 + F.lane, p = s - j * dil[di]; float v = -1e30f;
                if (j <= 128 && p >= 0) { const u32x4* kr = (const u32x4*)(PROJ + (size_t)(m - j * dil[di]) * NPROJ + C_AK + h * 64);
                    float dot = 0.f, ss = 0.f;
#pragma unroll
                    for (int c = 0; c < 8; ++c) { const u32x4 w = kr[c]; const unsigned ww[4] = {w.x, w.y, w.z, w.w};
#pragma unroll
                        for (int e = 0; e < 4; ++e) { const float k0 = bf2f(ww[e] & 0xffffu), k1 = bf2f(ww[e] >> 16);
                            dot += k0 * qk[c * 8 + 2 * e] + k1 * qk[c * 8 + 2 * e + 1]; ss += k0 * k0 + k1 * k1; } }
                    v = dot * rsqrtf(ss * (1.f / 64.f) + EPS) + t5_bias(relb, h, dil[di] * j); }
                sc[di * 3 + jb] = v; mx = fmaxf(mx, v); }
        mx = wave_max(mx);
        float sum = 0.f;
#pragma unroll
        for (int i = 0; i < 9; ++i) { const float p = sc[i] > -1e29f ? expf(sc[i] - mx) : 0.f; sum += p; pl[i * 64 + F.lane] = p; }
        sum = wave_sum(sum);
        LDS_WAIT(); asm volatile("" ::: "memory");
        float o = 0.f;
#pragma unroll 1
        for (int di = 0; di < 3; ++di) { const int jmax = (s / dil[di]) < 128 ? (s / dil[di]) : 128;
            for (int j = 0; j <= jmax; ++j) o += pl[(di * 3 + (j >> 6)) * 64 + (j & 63)] * bf2f(PROJ[(size_t)(m - j * dil[di]) * NPROJ + C_AV + h * 64 + F.lane]); }
        MIXED[(size_t)m * D + 256 + h * 64 + F.lane] = (bf16_t)f2bf(o / sum);
        LDS_WAIT(); asm volatile("" ::: "memory");
    }
}


typedef float f32x16 __attribute__((ext_vector_type(16)));
typedef short s16x4 __attribute__((ext_vector_type(4)));
#define MFMA32(a, b, c) __builtin_amdgcn_mfma_f32_32x32x16_bf16((a), (b), (c), 0, 0, 0)
__device__ __forceinline__ int crow(int i, int h) { return (i & 3) + 8 * (i >> 2) + 4 * h; }
__device__ __forceinline__ unsigned cvtpk(float lo, float hi) { return pg8::cvt_pk_bf16(lo, hi); }
__device__ __forceinline__ bf16x8 pack8(const f32x16& x, int s) {
    u32x4 w; w.x = cvtpk(x[8 * s], x[8 * s + 1]); w.y = cvtpk(x[8 * s + 2], x[8 * s + 3]); w.z = cvtpk(x[8 * s + 4], x[8 * s + 5]); w.w = cvtpk(x[8 * s + 6], x[8 * s + 7]);
    return __builtin_bit_cast(bf16x8, w);
}
__device__ __forceinline__ f32x16 zero16() { f32x16 z;
#pragma unroll
    for (int i = 0; i < 16; ++i) z[i] = 0.f;
    return z; }
__device__ __forceinline__ float fsilu(float y) { return y * __builtin_amdgcn_rcpf(1.f + __expf(-y)); }

namespace att {
constexpr int TB_STRIDE = 200, TB_PAD = 32;
constexpr int TB_OFF = RING_BYTES;
constexpr float LOG2E = 1.4426950408889634f;
struct Sub { int b, h, dil, di, res, n; };
__device__ __forceinline__ void build_table(const Frame& F, const float* relb) {
    LAS float* T = (LAS float*)(F.lds + TB_OFF);
    for (int e = F.tid; e < 3 * 8 * TB_STRIDE; e += NTHREADS) { const int di = e / (8 * TB_STRIDE), h = (e / TB_STRIDE) % 8, x = e % TB_STRIDE - TB_PAD; const int rel = 128 - x;
        float v = -1e30f;
        if (rel >= 0 && rel <= 128) { const int dist = rel * (di == 0 ? 1 : di == 1 ? 4 : 16); v = t5_bias(relb, h, dist) * LOG2E; }
        T[e] = v; }
}
template <bool COMBINE>
__device__ __forceinline__ void run_pair(const Frame& F, const Args& A, const Sub& sb) {
    const bf16_t* PROJ = (const bf16_t*)(A.ws + WS_A);
    const int sub = F.wave >> 2, wq = F.wave & 3, lane = F.lane, r = lane & 31, hh = lane >> 5;
    LAS unsigned char* Kb = F.lds + sub * 65536; LAS unsigned char* Vb = Kb + 32768;
    const size_t tok0 = (size_t)sb.b * SEQ;
    {
        const int ht = F.tid & 255, c = ht & 7; const int kstart = sb.n == 0 ? 128 : 0;
        u32x4 kr[8], vr[8];
#pragma unroll
        for (int i = 0; i < 8; ++i) { const int kj = (ht >> 3) + 32 * i;
            if (kj >= kstart) { const int p = (sb.n - 1) * 128 + kj; const bf16_t* row = PROJ + (tok0 + (size_t)p * sb.dil + sb.res) * NPROJ + sb.h * 64 + c * 8;
                kr[i] = *(const u32x4*)(row + C_AK); vr[i] = *(const u32x4*)(row + C_AV); } }
#pragma unroll
        for (int i = 0; i < 8; ++i) { const int kj = (ht >> 3) + 32 * i;
            if (kj >= kstart) { *(LAS u32x4*)(Kb + kj * 128 + ((c ^ ((kj >> 1) & 7)) << 4)) = kr[i]; *(LAS u32x4*)(Vb + kj * 128 + ((c ^ (((kj >> 1) & 1) << 2)) << 4)) = vr[i]; } }
    }
    const int qpos = sb.n * 128 + wq * 32 + r; const size_t mq = tok0 + (size_t)qpos * sb.dil + sb.res;
    bf16x8 qf[4];
#pragma unroll
    for (int s = 0; s < 4; ++s) qf[s] = *(const bf16x8*)(PROJ + mq * NPROJ + C_AQ + sb.h * 64 + 16 * s + 8 * hh);
    __syncthreads();
    const int dmin = sb.n == 0 ? 4 - wq : 0;
    const LAS float* T = (const LAS float*)(F.lds + TB_OFF) + (sb.di * 8 + sb.h) * TB_STRIDE + TB_PAD - r + 4 * hh;
    f32x16 p[5]; float mx = -1e30f;
#pragma unroll
    for (int t = 0; t < 5; ++t) {
        if (t >= dmin) { const int row = (wq + t) * 32 + r; f32x16 acc;
#pragma unroll
            for (int i = 0; i < 16; ++i) acc[i] = 0.f;
#pragma unroll
            for (int s = 0; s < 4; ++s) { const bf16x8 kf = *(const LAS bf16x8*)(Kb + row * 128 + (((2 * s + hh) ^ ((row >> 1) & 7)) << 4));
                acc = __builtin_amdgcn_mfma_f32_32x32x16_bf16(kf, qf[s], acc, 0, 0, 0); }
#pragma unroll
            for (int i = 0; i < 16; ++i) { acc[i] += T[32 * t + (i & 3) + 8 * (i >> 2)]; mx = fmaxf(mx, acc[i]); }
            p[t] = acc; }
    }
    mx = fmaxf(mx, __shfl_xor(mx, 32));
    float l = 0.f;
#pragma unroll
    for (int t = 0; t < 5; ++t) if (t >= dmin) {
#pragma unroll
        for (int i = 0; i < 16; ++i) { const float e = __builtin_amdgcn_exp2f(p[t][i] - mx); p[t][i] = e; l += e; } }
    l += __shfl_xor(l, 32);
    f32x16 o[2];
#pragma unroll
    for (int i = 0; i < 16; ++i) { o[0][i] = 0.f; o[1][i] = 0.f; }
    const int q4 = (lane & 15) >> 2, p4 = lane & 3, blk = (lane >> 4) & 1, sw = (lane >> 3) & 1;
    const int vlane = (4 * hh + q4) * 128 + ((2 * blk + (p4 >> 1)) << 4) + 8 * (p4 & 1);
    const int voff0 = vlane + sw * 64, voff1 = vlane + (1 - sw) * 64;
#pragma unroll
    for (int t = 0; t < 5; ++t) if (t >= dmin) {
#pragma unroll
        for (int s = 0; s < 2; ++s) { const bf16x8 pf = pack8(p[t], s); const int rowb = ((wq + t) * 32 + 16 * s) * 128;
            const s16x4 a0 = __builtin_amdgcn_ds_read_tr16_b64_v4i16((LAS s16x4*)(Vb + rowb + voff0)), a1 = __builtin_amdgcn_ds_read_tr16_b64_v4i16((LAS s16x4*)(Vb + rowb + 1024 + voff0));
            const s16x4 b0 = __builtin_amdgcn_ds_read_tr16_b64_v4i16((LAS s16x4*)(Vb + rowb + voff1)), b1 = __builtin_amdgcn_ds_read_tr16_b64_v4i16((LAS s16x4*)(Vb + rowb + 1024 + voff1));
            const bf16x8 v0 = __builtin_shufflevector(a0, a1, 0, 1, 2, 3, 4, 5, 6, 7), v1 = __builtin_shufflevector(b0, b1, 0, 1, 2, 3, 4, 5, 6, 7);
            o[0] = __builtin_amdgcn_mfma_f32_32x32x16_bf16(v0, pf, o[0], 0, 0, 0);
            o[1] = __builtin_amdgcn_mfma_f32_32x32x16_bf16(v1, pf, o[1], 0, 0, 0); } }
    const float inv = 1.f / l; const float lse2 = mx + __builtin_amdgcn_logf(l);
    if (COMBINE) {
        const bf16_t* O4 = (const bf16_t*)(A.ws + WS_ATTO); const bf16_t* O16 = O4 + (size_t)M * 512; const float* L4 = (const float*)(A.ws + WS_ATTL); const float* L16 = L4 + (size_t)M * 8;
        const float l4 = L4[mq * 8 + sb.h], l16 = L16[mq * 8 + sb.h]; const float mm = fmaxf(lse2, fmaxf(l4, l16));
        const float w1 = __builtin_amdgcn_exp2f(lse2 - mm), w4 = __builtin_amdgcn_exp2f(l4 - mm), w16 = __builtin_amdgcn_exp2f(l16 - mm); const float wi = 1.f / (w1 + w4 + w16);
        const float c1 = w1 * wi * inv, c4 = w4 * wi, c16 = w16 * wi;
        bf16_t* MX = (bf16_t*)(A.ws + WS_MIXED) + mq * D + 256 + sb.h * 64;
#pragma unroll
        for (int dt = 0; dt < 2; ++dt)
#pragma unroll
            for (int g = 0; g < 4; ++g) { const int d = 32 * dt + 8 * g + 4 * hh; const u32x2 a = *(const u32x2*)(O4 + mq * 512 + sb.h * 64 + d), b = *(const u32x2*)(O16 + mq * 512 + sb.h * 64 + d);
                const float y0 = c1 * o[dt][4 * g] + c4 * bf2f(a.x & 0xffffu) + c16 * bf2f(b.x & 0xffffu), y1 = c1 * o[dt][4 * g + 1] + c4 * bf2f(a.x >> 16) + c16 * bf2f(b.x >> 16);
                const float y2 = c1 * o[dt][4 * g + 2] + c4 * bf2f(a.y & 0xffffu) + c16 * bf2f(b.y & 0xffffu), y3 = c1 * o[dt][4 * g + 3] + c4 * bf2f(a.y >> 16) + c16 * bf2f(b.y >> 16);
                u32x2 w; w.x = cvtpk(y0, y1); w.y = cvtpk(y2, y3); *(u32x2*)(MX + d) = w; }
    } else {
        bf16_t* OD = (bf16_t*)(A.ws + WS_ATTO) + (size_t)(sb.di - 1) * M * 512 + mq * 512 + sb.h * 64; float* LD = (float*)(A.ws + WS_ATTL) + (size_t)(sb.di - 1) * M * 8;
#pragma unroll
        for (int dt = 0; dt < 2; ++dt)
#pragma unroll
            for (int g = 0; g < 4; ++g) { const int d = 32 * dt + 8 * g + 4 * hh;
                u32x2 w; w.x = cvtpk(o[dt][4 * g] * inv, o[dt][4 * g + 1] * inv); w.y = cvtpk(o[dt][4 * g + 2] * inv, o[dt][4 * g + 3] * inv); *(u32x2*)(OD + d) = w; }
        if (hh == 0) LD[mq * 8 + sb.h] = lse2;
    }
    __syncthreads();
}
__device__ __forceinline__ void phase_a(const Frame& F, const Args& A) {
    build_table(F, A.in[I_RELB]); __syncthreads();
    const int sub = F.wave >> 2;
    for (int bi = F.vcu; bi < 2048; bi += F.G) { const int round = bi >> 8, j = bi & 255; Sub sb;
        if (round < 4) { const int id = round * 256 + j, bh = id >> 3, k = 2 * (id & 7) + sub; sb.b = bh >> 3; sb.h = bh & 7; sb.dil = 4; sb.di = 1; sb.res = k >> 2; sb.n = k & 3; }
        else { const int id = (round - 4) * 256 + j, bh = id >> 3, k = 2 * (id & 7) + sub; sb.b = bh >> 3; sb.h = bh & 7; sb.dil = 16; sb.di = 2; sb.res = k; sb.n = 0; }
        run_pair<false>(F, A, sb); }
}
__device__ __forceinline__ void phase_b(const Frame& F, const Args& A) {
    build_table(F, A.in[I_RELB]); __syncthreads();
    const int sub = F.wave >> 2;
    for (int bi = F.vcu; bi < 1024; bi += F.G) { const int bh = bi >> 3; Sub sb; sb.b = bh >> 3; sb.h = bh & 7; sb.dil = 1; sb.di = 0; sb.res = 0; sb.n = 2 * (bi & 7) + sub;
        run_pair<true>(F, A, sb); }
}
__device__ __forceinline__ void phase_qknorm(const Frame& F, const Args& A, int layer) {
    bf16_t* PROJ = (bf16_t*)(A.ws + WS_A);
    const float qs = A.in[I_AT_QN][layer * 64 + F.lane] * A.in[I_AT_KN][layer * 64 + F.lane] * 0.125f * LOG2E;
    for (int m = F.gw; m < M; m += F.NGW) { bf16_t* row = PROJ + (size_t)m * NPROJ + C_AQ + F.lane;
#pragma unroll
        for (int j = 0; j < 16; ++j) { const float v = bf2f(row[64 * j]); const float ss = wave_sum(v * v) * (1.f / 64.f);
            row[64 * j] = (bf16_t)f2bf(v * rsqrtf(ss + EPS) * (j < 8 ? qs : 1.f)); } }
}
}


namespace dn {
constexpr int BUFB = 67 * 128, WV_SMALL = 1536, WV_BYTES = 3 * BUFB + WV_SMALL;
constexpr int IT_BYTES = 40960, F_W = 0, F_QD = 8, F_QK = 16, F_KD = 22, F_U = 30, GL_OFF = 38912;
static_assert(4 * WV_BYTES <= LDSCTL_OFF, "DN-1 LDS");
__device__ __forceinline__ int sw16(int row, int chunk) { return row * 128 + ((chunk ^ ((row >> 1) & 7)) << 4); }
__device__ __forceinline__ void stage_raw(LAS unsigned char* buf, const bf16_t* colbase  , int n, int lane) {
#pragma unroll
    for (int i = 0; i < 9; ++i) { const int e = lane + 64 * i;
        if (e < 67 * 8) { const int row = e >> 3, c = e & 7, s = n * 64 + row - 3; u32x4 v = {0u, 0u, 0u, 0u};
            if (s >= 0) v = *(const u32x4*)(colbase + (size_t)s * NPROJ + c * 8);
            *(LAS u32x4*)(buf + sw16(row, c)) = v; } }
}
template <bool ROWS, bool TR>
__device__ __forceinline__ float conv64(LAS unsigned char* buf, LAS unsigned char* bufT, const float* cw, int lane) {
    float ss = 0.f;
#pragma unroll 4
    for (int cp = 0; cp < 32; ++cp) { const int chunk = cp >> 2, off = (cp & 3) * 4; float y0 = 0.f, y1 = 0.f;
#pragma unroll
        for (int tap = 0; tap < 4; ++tap) { const unsigned x = *(const LAS unsigned*)(buf + sw16(lane + tap, chunk) + off);
            y0 += cw[tap * 768 + 2 * cp] * bf2f(x & 0xffffu); y1 += cw[tap * 768 + 2 * cp + 1] * bf2f(x >> 16); }
        y0 = fsilu(y0); y1 = fsilu(y1); ss += y0 * y0 + y1 * y1; const unsigned yp = cvtpk(y0, y1);
        if (ROWS) *(LAS unsigned*)(buf + sw16(lane, chunk) + off) = yp;
        if (TR) { *(LAS unsigned short*)(bufT + sw16(2 * cp, lane >> 3) + (lane & 7) * 2) = (unsigned short)(yp & 0xffffu);
                  *(LAS unsigned short*)(bufT + sw16(2 * cp + 1, lane >> 3) + (lane & 7) * 2) = (unsigned short)(yp >> 16); } }
    return ss;
}
__device__ __forceinline__ u32x2 rd8(const LAS unsigned char* buf, int row, int e0) { return *(const LAS u32x2*)(buf + sw16(row, e0 >> 3) + (e0 & 4) * 2); }
__device__ __forceinline__ bf16x8 frag_perm(const LAS unsigned char* buf, int row, int ebase, int s, int hh) {
    const u32x2 a = rd8(buf, row, ebase + 16 * s + 4 * hh), b = rd8(buf, row, ebase + 16 * s + 8 + 4 * hh); u32x4 w = {a.x, a.y, b.x, b.y}; return __builtin_bit_cast(bf16x8, w); }
__device__ __forceinline__ bf16x8 frag_perm_scaled(const LAS unsigned char* buf, int row, int ebase, int s, int hh, f32x4 s0, f32x4 s1) {
    const u32x2 a = rd8(buf, row, ebase + 16 * s + 4 * hh), b = rd8(buf, row, ebase + 16 * s + 8 + 4 * hh);
    u32x4 w; w.x = cvtpk(bf2f(a.x & 0xffffu) * s0.x, bf2f(a.x >> 16) * s0.y); w.y = cvtpk(bf2f(a.y & 0xffffu) * s0.z, bf2f(a.y >> 16) * s0.w);
    w.z = cvtpk(bf2f(b.x & 0xffffu) * s1.x, bf2f(b.x >> 16) * s1.y); w.w = cvtpk(bf2f(b.y & 0xffffu) * s1.z, bf2f(b.y >> 16) * s1.w); return __builtin_bit_cast(bf16x8, w); }
__device__ __forceinline__ bf16x8 frag_row(const LAS unsigned char* buf, int row, int s, int hh) { return *(const LAS bf16x8*)(buf + sw16(row, 2 * s + hh)); }
__device__ __forceinline__ void dump(unsigned char* it, int f, int lane, bf16x8 v) { *(bf16x8*)(it + f * 1024 + lane * 16) = v; }
__device__ __forceinline__ void invert32(f32x16 X, f32x16 Y, f32x16& TT, int r, int hh) {
#pragma unroll
    for (int i = 0; i < 16; ++i) { const float id = (crow(i, hh) == r) ? 1.f : 0.f; TT[i] = id + Y[i]; }
#pragma unroll
    for (int lev = 0; lev < 4; ++lev) {
        { const bf16x8 x0 = pack8(X, 0), x1 = pack8(X, 1), y0 = pack8(Y, 0), y1 = pack8(Y, 1);
          f32x16 Xn = MFMA32(y0, x0, zero16()); Xn = MFMA32(y1, x1, Xn);
          if (lev < 3) { f32x16 Yn = MFMA32(x0, y0, zero16()); Yn = MFMA32(x1, y1, Yn); Y = Yn; }
          X = Xn; }
        const bf16x8 n0 = pack8(X, 0), n1 = pack8(X, 1), t0 = pack8(TT, 0), t1 = pack8(TT, 1);
        f32x16 TTn = MFMA32(n0, t0, TT); TTn = MFMA32(n1, t1, TTn);
        TT = TTn;
    }
}
__device__ __forceinline__ f32x16 transpose32(const f32x16& X, LAS float* scr, int r, int hh) {
#pragma unroll
    for (int i = 0; i < 16; ++i) scr[r * 33 + crow(i, hh)] = X[i];
    f32x16 T;
#pragma unroll
    for (int i = 0; i < 16; ++i) T[i] = scr[crow(i, hh) * 33 + r];
    return T;
}
__device__ __forceinline__ void make_xy(const f32x16& kk, const LAS float* Gs, const LAS float* BR, const LAS float* RK, int blk, float Gc, float rkc, float brc, int r, int hh, f32x16& X, f32x16& Y) {
#pragma unroll
    for (int g4 = 0; g4 < 4; ++g4) { const f32x4 Ga = *(const LAS f32x4*)(Gs + blk * 32 + 8 * g4 + 4 * hh), bra = *(const LAS f32x4*)(BR + blk * 32 + 8 * g4 + 4 * hh), rka = *(const LAS f32x4*)(RK + blk * 32 + 8 * g4 + 4 * hh);
#pragma unroll
        for (int e = 0; e < 4; ++e) { const int i = 4 * g4 + e, a = 8 * g4 + 4 * hh + e;
            X[i] = a > r ? -(bra[e] * rkc * __expf(fminf(Ga[e] - Gc, 0.f))) * kk[i] : 0.f;
            Y[i] = r > a ? -(brc * rka[e] * __expf(fminf(Gc - Ga[e], 0.f))) * kk[i] : 0.f; } }
}
__device__ __forceinline__ void dn1_item(LAS unsigned char* wl, const Args& A, int layer, int b, int h, int n, int lane) {
    LAS unsigned char* bufX = wl; LAS unsigned char* bufY = wl + BUFB; LAS unsigned char* bufZ = wl + 2 * BUFB;
    LAS float* Gs = (LAS float*)(wl + 3 * BUFB); LAS float* RK = Gs + 64; LAS float* BR = Gs + 128; LAS float* SW = Gs + 192; LAS float* SB = Gs + 256; LAS float* SK = Gs + 320;
    const bf16_t* PROJ = (const bf16_t*)(A.ws + WS_A) + (size_t)b * SEQ * NPROJ + h * 64;
    const float* cw = A.in[I_DN_CONV] + (size_t)layer * 4 * 768 + h * 64;
    unsigned char* item = A.ws + WS_SCR + (size_t)((b * 4 + h) * 32 + n) * IT_BYTES;
    const int r = lane & 31, hh = lane >> 5;
    const size_t m = (size_t)b * SEQ + n * 64 + lane;
    stage_raw(bufX, PROJ + C_DK, n, lane);
    stage_raw(bufY, PROJ + C_DQ, n, lane);
    const float ssk = conv64<true, true>(bufX, bufZ, cw + 256, lane);
    const float rk = rsqrtf(ssk + EPS);
    const float* AB = (const float*)(A.ws + WS_AB);
    const float av = AB[m * 8 + h], bv = AB[m * 8 + 4 + h];
    float g; { const float x = av + A.in[I_DN_DTB][layer * 4 + h]; const float sp = fmaxf(x, 0.f) + log1pf(expf(-fabsf(x))); g = -expf(A.in[I_DN_ALOG][layer * 4 + h]) * sp; }
    const float beta = 1.f / (1.f + expf(-bv));
    float G = g;
#pragma unroll
    for (int o = 1; o < 64; o <<= 1) { const float t = __shfl_up(G, o); if (lane >= o) G += t; }
    const float Glast = __shfl(G, 63);
    Gs[lane] = G; RK[lane] = rk; BR[lane] = beta * rk; SW[lane] = beta * rk * expf(G); SB[lane] = beta; SK[lane] = rk * expf(Glast - G);
    const float ssq = conv64<true, false>(bufY, bufY, cw, lane);
    const float rqe = rsqrtf(ssq + EPS) * 0.125f;
    const float Gc0 = __shfl(G, r), Gc1 = __shfl(G, 32 + r), rkc0 = __shfl(rk, r), rkc1 = __shfl(rk, 32 + r);
    const float brc0 = __shfl(beta * rk, r), brc1 = __shfl(beta * rk, 32 + r), rqc0 = __shfl(rqe, r), rqc1 = __shfl(rqe, 32 + r);
    __builtin_amdgcn_sched_barrier(0);
#pragma unroll
    for (int tile = 0; tile < 3; ++tile) { const int jt = tile == 2 ? 1 : 0, it = tile == 0 ? 0 : 1;
        f32x16 acc = zero16();
#pragma unroll
        for (int s = 0; s < 4; ++s) acc = MFMA32(frag_row(bufX, jt * 32 + r, s, hh), frag_row(bufY, it * 32 + r, s, hh), acc);
        const float Gi = it ? Gc1 : Gc0, rqi = it ? rqc1 : rqc0;
#pragma unroll
        for (int g4 = 0; g4 < 4; ++g4) { const f32x4 Gj = *(const LAS f32x4*)(Gs + jt * 32 + 8 * g4 + 4 * hh), rkj = *(const LAS f32x4*)(RK + jt * 32 + 8 * g4 + 4 * hh);
#pragma unroll
            for (int e = 0; e < 4; ++e) { const int i = 4 * g4 + e; const int jrow = 8 * g4 + 4 * hh + e;
                const float v = rqi * rkj[e] * __expf(fminf(Gi - Gj[e], 0.f)) * acc[i];
                acc[i] = (tile == 1 || r >= jrow) ? v : 0.f; } }
        dump(item, F_QK + tile * 2, lane, pack8(acc, 0)); dump(item, F_QK + tile * 2 + 1, lane, pack8(acc, 1)); }
    __builtin_amdgcn_sched_barrier(0);
#pragma unroll
    for (int it = 0; it < 2; ++it) { const float sc = (it ? rqc1 : rqc0) * __expf(it ? Gc1 : Gc0); const f32x4 s4 = {sc, sc, sc, sc};
#pragma unroll
        for (int dkt = 0; dkt < 2; ++dkt)
#pragma unroll
            for (int s = 0; s < 2; ++s) dump(item, F_QD + it * 4 + dkt * 2 + s, lane, frag_perm_scaled(bufY, it * 32 + r, dkt * 32, s, hh, s4, s4)); }
    __builtin_amdgcn_sched_barrier(0);
#pragma unroll
    for (int dkt = 0; dkt < 2; ++dkt)
#pragma unroll
        for (int tt = 0; tt < 2; ++tt)
#pragma unroll
            for (int s = 0; s < 2; ++s) { const f32x4 s0 = *(const LAS f32x4*)(SK + tt * 32 + 16 * s + 4 * hh), s1 = *(const LAS f32x4*)(SK + tt * 32 + 16 * s + 8 + 4 * hh);
                dump(item, F_KD + dkt * 4 + tt * 2 + s, lane, frag_perm_scaled(bufZ, dkt * 32 + r, tt * 32, s, hh, s0, s1)); }
    __builtin_amdgcn_sched_barrier(0);
    f32x16 TT1, TT2, TT21;
    {
        { f32x16 kk = zero16();
#pragma unroll
          for (int s = 0; s < 4; ++s) { const bf16x8 f = frag_row(bufX, r, s, hh); kk = MFMA32(f, f, kk); }
          f32x16 X, Y; make_xy(kk, Gs, BR, RK, 0, Gc0, rkc0, brc0, r, hh, X, Y);
          invert32(X, Y, TT1, r, hh); }
        __builtin_amdgcn_sched_barrier(0);
        { f32x16 kk = zero16();
#pragma unroll
          for (int s = 0; s < 4; ++s) { const bf16x8 f = frag_row(bufX, 32 + r, s, hh); kk = MFMA32(f, f, kk); }
          f32x16 X, Y; make_xy(kk, Gs, BR, RK, 1, Gc1, rkc1, brc1, r, hh, X, Y);
          invert32(X, Y, TT2, r, hh); }
        __builtin_amdgcn_sched_barrier(0);
        f32x16 kk = zero16();
#pragma unroll
        for (int s = 0; s < 4; ++s) kk = MFMA32(frag_row(bufX, 32 + r, s, hh), frag_row(bufX, r, s, hh), kk);
#pragma unroll
        for (int g4 = 0; g4 < 4; ++g4) { const f32x4 Ga = *(const LAS f32x4*)(Gs + 32 + 8 * g4 + 4 * hh), bra = *(const LAS f32x4*)(BR + 32 + 8 * g4 + 4 * hh);
#pragma unroll
            for (int e = 0; e < 4; ++e) { const int i = 4 * g4 + e; kk[i] = (bra[e] * rkc0 * __expf(fminf(Ga[e] - Gc0, 0.f))) * kk[i]; } }
        f32x16 Q1 = MFMA32(pack8(kk, 0), pack8(TT2, 0), zero16()); Q1 = MFMA32(pack8(kk, 1), pack8(TT2, 1), Q1);
        const f32x16 T1 = transpose32(TT1, (LAS float*)bufY, r, hh);
        f32x16 P = MFMA32(pack8(T1, 0), pack8(Q1, 0), zero16()); P = MFMA32(pack8(T1, 1), pack8(Q1, 1), P);
#pragma unroll
        for (int i = 0; i < 16; ++i) TT21[i] = -P[i];
    }
    __builtin_amdgcn_sched_barrier(0);
    stage_raw(bufX, PROJ + C_DV, n, lane);
    (void)conv64<false, true>(bufX, bufY, cw + 512, lane);
    __builtin_amdgcn_sched_barrier(0);
    bf16x8 wB[3][2], uA[3][2];
#pragma unroll
    for (int tile = 0; tile < 3; ++tile) { const int jt = tile == 2 ? 1 : 0; const f32x16& TTx = tile == 0 ? TT1 : tile == 1 ? TT21 : TT2; f32x16 a, c;
#pragma unroll
        for (int g4 = 0; g4 < 4; ++g4) { const f32x4 sw = *(const LAS f32x4*)(SW + jt * 32 + 8 * g4 + 4 * hh), sb = *(const LAS f32x4*)(SB + jt * 32 + 8 * g4 + 4 * hh);
#pragma unroll
            for (int e = 0; e < 4; ++e) { a[4 * g4 + e] = TTx[4 * g4 + e] * sw[e]; c[4 * g4 + e] = TTx[4 * g4 + e] * sb[e]; } }
        wB[tile][0] = pack8(a, 0); wB[tile][1] = pack8(a, 1); uA[tile][0] = pack8(c, 0); uA[tile][1] = pack8(c, 1); }
#pragma unroll
    for (int dkt = 0; dkt < 2; ++dkt) {
        const bf16x8 x00 = frag_perm(bufZ, dkt * 32 + r, 0, 0, hh), x01 = frag_perm(bufZ, dkt * 32 + r, 0, 1, hh), x10 = frag_perm(bufZ, dkt * 32 + r, 32, 0, hh), x11 = frag_perm(bufZ, dkt * 32 + r, 32, 1, hh);
        f32x16 w0 = MFMA32(x00, wB[0][0], zero16()); w0 = MFMA32(x01, wB[0][1], w0);
        f32x16 w1 = MFMA32(x00, wB[1][0], zero16()); w1 = MFMA32(x01, wB[1][1], w1); w1 = MFMA32(x10, wB[2][0], w1); w1 = MFMA32(x11, wB[2][1], w1);
#pragma unroll
        for (int i = 0; i < 16; ++i) { w0[i] = -w0[i]; w1[i] = -w1[i]; }
        dump(item, F_W + 0 * 4 + dkt * 2 + 0, lane, pack8(w0, 0)); dump(item, F_W + 0 * 4 + dkt * 2 + 1, lane, pack8(w0, 1));
        dump(item, F_W + 1 * 4 + dkt * 2 + 0, lane, pack8(w1, 0)); dump(item, F_W + 1 * 4 + dkt * 2 + 1, lane, pack8(w1, 1)); }
#pragma unroll
    for (int dvt = 0; dvt < 2; ++dvt) {
        const bf16x8 v00 = frag_perm(bufY, dvt * 32 + r, 0, 0, hh), v01 = frag_perm(bufY, dvt * 32 + r, 0, 1, hh), v10 = frag_perm(bufY, dvt * 32 + r, 32, 0, hh), v11 = frag_perm(bufY, dvt * 32 + r, 32, 1, hh);
        f32x16 u0 = MFMA32(uA[0][0], v00, zero16()); u0 = MFMA32(uA[0][1], v01, u0);
        f32x16 u1 = MFMA32(uA[1][0], v00, zero16()); u1 = MFMA32(uA[1][1], v01, u1); u1 = MFMA32(uA[2][0], v10, u1); u1 = MFMA32(uA[2][1], v11, u1);
        *(bf16x8*)(item + (F_U + 2 * (0 * 2 + dvt)) * 1024 + lane * 32) = pack8(u0, 0); *(bf16x8*)(item + (F_U + 2 * (0 * 2 + dvt)) * 1024 + lane * 32 + 16) = pack8(u0, 1);
        *(bf16x8*)(item + (F_U + 2 * (1 * 2 + dvt)) * 1024 + lane * 32) = pack8(u1, 0); *(bf16x8*)(item + (F_U + 2 * (1 * 2 + dvt)) * 1024 + lane * 32 + 16) = pack8(u1, 1); }
    if (lane == 0) *(float*)(item + GL_OFF) = expf(Glast);
}
__device__ __forceinline__ void phase1(const Frame& F, const Args& A, int layer) {
    LAS unsigned char* wl = F.lds + F.wave * WV_BYTES;
    for (int it = F.vcu * 4 + F.wave; it < BATCH * 32 * DNH; it += F.G * 4) { const int h = it & 3, cg = it >> 2; dn1_item(wl, A, layer, cg >> 5, h, cg & 31, F.lane); }
}
constexpr int SC_FRAG = 0, SC_FRAGB = 39936, SC_O = 2 * SC_FRAGB, SC_OB = 64 * 68 * 4;
static_assert(SC_O + 2 * SC_OB <= LDSCTL_OFF, "scan LDS");
__device__ __forceinline__ void scan_load(LAS unsigned char* dst, const unsigned char* item, int t128) {
#pragma unroll
    for (int i = 0; i < 19; ++i) { const u32x4 v = *(const u32x4*)(item + (t128 + 128 * i) * 16); *(LAS u32x4*)(dst + (t128 + 128 * i) * 16) = v; }
    if (t128 == 0) *(LAS float*)(dst + GL_OFF) = *(const float*)(item + GL_OFF);
}
__device__ __forceinline__ void gate_rows(const LAS unsigned char* ob, const Args& A, int layer, int b, int h, int c, int gwv, int lane) {
    const int row = gwv * 16 + (lane >> 2), dq = lane & 3; const size_t m = (size_t)b * SEQ + c * 64 + row;
    const LAS f32x4* op = (const LAS f32x4*)(ob + (row * 68 + dq * 16) * 4);
    f32x4 o4[4]; float ss = 0.f;
#pragma unroll
    for (int k = 0; k < 4; ++k) { o4[k] = op[k]; ss += (o4[k].x * o4[k].x + o4[k].y * o4[k].y) + (o4[k].z * o4[k].z + o4[k].w * o4[k].w); }
    ss += __shfl_xor(ss, 1); ss += __shfl_xor(ss, 2);
    const float rs = rsqrtf(ss * (1.f / 64.f) + EPS);
    const bf16_t* zp = (const bf16_t*)(A.ws + WS_A) + m * NPROJ + C_DZ + h * 64 + dq * 16; const float* gn = A.in[I_DN_ONORM] + layer * 64 + dq * 16;
    const u32x4 z0 = *(const u32x4*)zp, z1 = *(const u32x4*)(zp + 8); const unsigned zz[8] = {z0.x, z0.y, z0.z, z0.w, z1.x, z1.y, z1.z, z1.w};
    unsigned out[8];
#pragma unroll
    for (int k = 0; k < 8; ++k) { const float a = o4[k >> 1][(k & 1) * 2] * rs * gn[2 * k] * fsilu(bf2f(zz[k] & 0xffffu)), c2 = o4[k >> 1][(k & 1) * 2 + 1] * rs * gn[2 * k + 1] * fsilu(bf2f(zz[k] >> 16)); out[k] = cvtpk(a, c2); }
    bf16_t* mp = (bf16_t*)(A.ws + WS_MIXED) + m * D + h * 64 + dq * 16;
    *(u32x4*)mp = (u32x4){out[0], out[1], out[2], out[3]}; *(u32x4*)(mp + 8) = (u32x4){out[4], out[5], out[6], out[7]};
}
__device__ __forceinline__ void scan(const Frame& F, const Args& A, int layer, int pair) {
    const int b = pair >> 2, h = pair & 3, lane = F.lane, r = lane & 31, hh = lane >> 5, wv = F.wave;
    const unsigned char* items = A.ws + WS_SCR + (size_t)(pair * 32) * IT_BYTES;
    const bool is_scan = wv < 2, is_load = (wv == 4 || wv == 5), is_gate = !is_scan && !is_load; const int gwv = wv < 4 ? wv - 2 : wv - 4;
    f32x16 st[2]; st[0] = zero16(); st[1] = zero16();
    if (is_load) scan_load(F.lds + SC_FRAG, items, (wv - 4) * 64 + lane);
    __syncthreads();
    for (int c = 0; c < 32; ++c) {
        const LAS unsigned char* fb = F.lds + SC_FRAG + (c & 1) * SC_FRAGB; LAS unsigned char* ob = F.lds + SC_O + (c & 1) * SC_OB;
        if (is_load) { if (c + 1 < 32) scan_load(F.lds + SC_FRAG + ((c + 1) & 1) * SC_FRAGB, items + (size_t)(c + 1) * IT_BYTES, (wv - 4) * 64 + lane); }
        else if (is_gate) { if (c > 0) gate_rows(F.lds + SC_O + ((c - 1) & 1) * SC_OB, A, layer, b, h, c - 1, gwv, lane); }
        else { const int dvt = wv;
            bf16x8 sB[2][2];
#pragma unroll
            for (int dkt = 0; dkt < 2; ++dkt) { sB[dkt][0] = pack8(st[dkt], 0); sB[dkt][1] = pack8(st[dkt], 1); }
            f32x16 vn[2], o[2];
#pragma unroll
            for (int it = 0; it < 2; ++it) { const LAS u32x4* up = (const LAS u32x4*)(fb + (F_U + 2 * (it * 2 + dvt)) * 1024 + lane * 32); const u32x4 a = up[0], c2 = up[1];
                const unsigned uu[8] = {a.x, a.y, a.z, a.w, c2.x, c2.y, c2.z, c2.w};
#pragma unroll
                for (int k = 0; k < 8; ++k) { vn[it][2 * k] = bf2f(uu[k] & 0xffffu); vn[it][2 * k + 1] = bf2f(uu[k] >> 16); }
                o[it] = zero16();
#pragma unroll
                for (int dkt = 0; dkt < 2; ++dkt)
#pragma unroll
                    for (int s = 0; s < 2; ++s) { vn[it] = MFMA32(*(const LAS bf16x8*)(fb + (F_W + it * 4 + dkt * 2 + s) * 1024 + lane * 16), sB[dkt][s], vn[it]);
                        o[it] = MFMA32(*(const LAS bf16x8*)(fb + (F_QD + it * 4 + dkt * 2 + s) * 1024 + lane * 16), sB[dkt][s], o[it]); } }
            bf16x8 vB[2][2];
#pragma unroll
            for (int tt = 0; tt < 2; ++tt) { vB[tt][0] = pack8(vn[tt], 0); vB[tt][1] = pack8(vn[tt], 1); }
#pragma unroll
            for (int s = 0; s < 2; ++s) { o[0] = MFMA32(*(const LAS bf16x8*)(fb + (F_QK + 0 + s) * 1024 + lane * 16), vB[0][s], o[0]);
                o[1] = MFMA32(*(const LAS bf16x8*)(fb + (F_QK + 2 + s) * 1024 + lane * 16), vB[0][s], o[1]);
                o[1] = MFMA32(*(const LAS bf16x8*)(fb + (F_QK + 4 + s) * 1024 + lane * 16), vB[1][s], o[1]); }
            const float gl = *(const LAS float*)(fb + GL_OFF);
#pragma unroll
            for (int dkt = 0; dkt < 2; ++dkt) {
#pragma unroll
                for (int i = 0; i < 16; ++i) st[dkt][i] *= gl;
#pragma unroll
                for (int tt = 0; tt < 2; ++tt)
#pragma unroll
                    for (int s = 0; s < 2; ++s) st[dkt] = MFMA32(*(const LAS bf16x8*)(fb + (F_KD + dkt * 4 + tt * 2 + s) * 1024 + lane * 16), vB[tt][s], st[dkt]); }
#pragma unroll
            for (int it = 0; it < 2; ++it)
#pragma unroll
                for (int i = 0; i < 16; ++i) *(LAS float*)(ob + ((it * 32 + crow(i, hh)) * 68 + dvt * 32 + r) * 4) = o[it][i];
        }
        __syncthreads();
    }
    if (is_gate) gate_rows(F.lds + SC_O + (31 & 1) * SC_OB, A, layer, b, h, 31, gwv, lane);
    __syncthreads();
}
}


namespace cv {
constexpr int TT = 128, ROWS = TT + 30;
__device__ __forceinline__ void tile(const Frame& F, const Args& A, int layer, int tidx) {
    const bf16_t* PROJ = (const bf16_t*)(A.ws + WS_A); bf16_t* MIXED = (bf16_t*)(A.ws + WS_MIXED);
    const int m0 = tidx * TT, s0 = m0 % SEQ, lane = F.lane;
    for (int rho = F.wave; rho < ROWS; rho += NWAVES) { u32x2 y = {0u, 0u};
        if (s0 - 30 + rho >= 0) { const bf16_t* row = PROJ + (size_t)(m0 - 30 + rho) * NPROJ; const u32x2 a = *((const u32x2*)(row + C_CU) + lane), g = *((const u32x2*)(row + C_CG) + lane);
            y.x = cvtpk(bf2f(a.x & 0xffffu) * __builtin_amdgcn_rcpf(1.f + __expf(-bf2f(g.x & 0xffffu))), bf2f(a.x >> 16) * __builtin_amdgcn_rcpf(1.f + __expf(-bf2f(g.x >> 16))));
            y.y = cvtpk(bf2f(a.y & 0xffffu) * __builtin_amdgcn_rcpf(1.f + __expf(-bf2f(g.y & 0xffffu))), bf2f(a.y >> 16) * __builtin_amdgcn_rcpf(1.f + __expf(-bf2f(g.y >> 16)))); }
        *(LAS u32x2*)(F.lds + rho * 512 + lane * 8) = y; }
    const float* dw = A.in[I_CV_DW] + (size_t)layer * CVK * CVW;
    LAS f32x4* wl = (LAS f32x4*)(F.lds + ROWS * 512);
    for (int i = F.tid; i < CVK * 64; i += NTHREADS) wl[i] = *((const f32x4*)dw + i);
    const f32x4 bias = *((const f32x4*)(A.in[I_CV_DWB] + layer * CVW) + lane), lg = *((const f32x4*)(A.in[I_CV_LNG] + layer * CVW) + lane), lb = *((const f32x4*)(A.in[I_CV_LNB] + layer * CVW) + lane);
    __syncthreads();
#pragma unroll 1
    for (int k = 0; k < TT / NWAVES; ++k) { const int tau = F.wave * (TT / NWAVES) + k; f32x4 acc = bias;
#pragma unroll
        for (int i = 0; i < CVK; ++i) { const u32x2 y = *(const LAS u32x2*)(F.lds + (tau + i) * 512 + lane * 8); const f32x4 w = wl[i * 64 + lane];
            acc.x += w.x * bf2f(y.x & 0xffffu); acc.y += w.y * bf2f(y.x >> 16); acc.z += w.z * bf2f(y.y & 0xffffu); acc.w += w.w * bf2f(y.y >> 16); }
        const float mean = wave_sum((acc.x + acc.y) + (acc.z + acc.w)) * (1.f / CVW);
        const f32x4 d = acc - mean; const float var = wave_sum((d.x * d.x + d.y * d.y) + (d.z * d.z + d.w * d.w)) * (1.f / CVW);
        const float rs = rsqrtf(var + EPS); const f32x4 yv = d * rs * lg + lb;
        u32x2 o; o.x = cvtpk(fsilu(yv.x), fsilu(yv.y)); o.y = cvtpk(fsilu(yv.z), fsilu(yv.w));
        *((u32x2*)(MIXED + (size_t)(m0 + tau) * D + 768) + lane) = o; }
    __syncthreads();
}
__device__ __forceinline__ void phase(const Frame& F, const Args& A, int layer) { for (int t = F.vcu; t < M / TT; t += F.G) tile(F, A, layer, t); }
}

__device__ __forceinline__ void phase_conf_naive(const Frame& F, const Args& A, int layer) {
    const bf16_t* PROJ = (const bf16_t*)(A.ws + WS_A); bf16_t* MIXED = (bf16_t*)(A.ws + WS_MIXED);
    const float* dw = A.in[I_CV_DW] + (size_t)layer * CVK * CVW;
    const f32x4 bias = *((const f32x4*)(A.in[I_CV_DWB] + layer * CVW) + F.lane), lg = *((const f32x4*)(A.in[I_CV_LNG] + layer * CVW) + F.lane), lb = *((const f32x4*)(A.in[I_CV_LNB] + layer * CVW) + F.lane);
    for (int m = F.gw; m < M; m += F.NGW) { const int s = m % SEQ;
        f32x4 acc = bias;
#pragma unroll 1
        for (int i = 0; i < CVK; ++i) { if (s - 30 + i < 0) continue;
            const u32x2 a = *((const u32x2*)(PROJ + (size_t)(m - 30 + i) * NPROJ + C_CU) + F.lane), g = *((const u32x2*)(PROJ + (size_t)(m - 30 + i) * NPROJ + C_CG) + F.lane);
            const f32x4 w = *((const f32x4*)(dw + i * CVW) + F.lane);
            acc.x += w.x * bf2f(a.x & 0xffffu) * sigm(bf2f(g.x & 0xffffu)); acc.y += w.y * bf2f(a.x >> 16) * sigm(bf2f(g.x >> 16));
            acc.z += w.z * bf2f(a.y & 0xffffu) * sigm(bf2f(g.y & 0xffffu)); acc.w += w.w * bf2f(a.y >> 16) * sigm(bf2f(g.y >> 16)); }
        const float mean = wave_sum((acc.x + acc.y) + (acc.z + acc.w)) * (1.f / CVW);
        const f32x4 d = acc - mean; const float var = wave_sum((d.x * d.x + d.y * d.y) + (d.z * d.z + d.w * d.w)) * (1.f / CVW);
        const float rs = rsqrtf(var + EPS); f32x4 y = d * rs * lg + lb;
        u32x2 w; w.x = pk2(siluf(y.x), siluf(y.y)); w.y = pk2(siluf(y.z), siluf(y.w));
        *((u32x2*)(MIXED + (size_t)m * D + 768) + F.lane) = w;
    }
}
__device__ __forceinline__ void phase_p4(const Frame& F, const Args& A, int layer) {
    unsigned char* ws = A.ws;
    const float* gffn = A.in[I_NORM_FFN] + layer * D;
    const float* rgw = A.in[I_RG_W] + (size_t)layer * D * NGRP; const float* rgb = A.in[I_RG_B] + layer * NGRP;
    const float* rew = A.in[I_RE_W] + (size_t)layer * D * NE; const float* reb = A.in[I_RE_B] + layer * NE;
    bf16_t* H = (bf16_t*)(ws + WS_H); int* ltok = (int*)(ws + WS_LTOK); float* lgate = (float*)(ws + WS_LGATE);
    unsigned* cnt = F.ctl + CW_CNT + layer * NE * 16;
    LAS float* wgT = (LAS float*)F.lds; LAS float* weT = wgT + 4 * D;
    for (int idx = F.tid; idx < D; idx += NTHREADS) { const f32x4 w = *(const f32x4*)(rgw + (size_t)idx * NGRP); wgT[idx] = w.x; wgT[D + idx] = w.y; wgT[2 * D + idx] = w.z; wgT[3 * D + idx] = w.w; }
    for (int idx = F.tid; idx < D * 8; idx += NTHREADS) { const int k = idx & (D - 1), o4 = idx >> 10; const f32x4 w = *(const f32x4*)(rew + (size_t)k * NE + 4 * o4);
        weT[(4 * o4 + 0) * D + k] = w.x; weT[(4 * o4 + 1) * D + k] = w.y; weT[(4 * o4 + 2) * D + k] = w.z; weT[(4 * o4 + 3) * D + k] = w.w; }
    __syncthreads();
    f32x4 gv[4];
#pragma unroll
    for (int j = 0; j < 4; ++j) gv[j] = *((const f32x4*)gffn + F.lane + 64 * j);
    for (int m = F.gw; m < M; m += F.NGW) {
        const f32x4* xr = (const f32x4*)(A.out + (size_t)m * D) + F.lane;
        f32x4 v[4]; float s = 0.f;
#pragma unroll
        for (int j = 0; j < 4; ++j) { v[j] = xr[64 * j]; s += (v[j].x * v[j].x + v[j].y * v[j].y) + (v[j].z * v[j].z + v[j].w * v[j].w); }
        const float rstd = rsqrtf(wave_sum(s) * (1.f / D) + EPS);
        u32x2* ho = (u32x2*)(H + (size_t)m * D) + F.lane;
        float gl[4] = {0.f, 0.f, 0.f, 0.f};
#pragma unroll
        for (int j = 0; j < 4; ++j) { v[j] = v[j] * rstd * gv[j];
            u32x2 w; w.x = pk2(v[j].x, v[j].y); w.y = pk2(v[j].z, v[j].w); ho[64 * j] = w;
#pragma unroll
            for (int o = 0; o < 4; ++o) { const f32x4 wv = *((const LAS f32x4*)(wgT + o * D) + F.lane + 64 * j); gl[o] += (v[j].x * wv.x + v[j].y * wv.y) + (v[j].z * wv.z + v[j].w * wv.w); } }
#pragma unroll
        for (int o = 0; o < 4; ++o) gl[o] = wave_sum(gl[o]) + rgb[o];
        int gs = 0; float gm = gl[0];
#pragma unroll
        for (int o = 1; o < 4; ++o) if (gl[o] > gm) { gm = gl[o]; gs = o; }
        float den = 0.f;
#pragma unroll
        for (int o = 0; o < 4; ++o) den += expf(gl[o] - gm);
        const float pgrp = 1.f / den;
        float el[8];
#pragma unroll
        for (int o = 0; o < 8; ++o) el[o] = 0.f;
        const LAS float* wsel = weT + gs * EPG * D;
#pragma unroll
        for (int j = 0; j < 4; ++j)
#pragma unroll
            for (int o = 0; o < 8; ++o) { const f32x4 wv = *((const LAS f32x4*)(wsel + o * D) + F.lane + 64 * j); el[o] += (v[j].x * wv.x + v[j].y * wv.y) + (v[j].z * wv.z + v[j].w * wv.w); }
#pragma unroll
        for (int o = 0; o < 8; ++o) el[o] = wave_sum(el[o]) + reb[gs * EPG + o];
        int i0 = 0; float v0 = el[0];
#pragma unroll
        for (int o = 1; o < 8; ++o) if (el[o] > v0) { v0 = el[o]; i0 = o; }
        int i1 = -1; float v1 = -3.0e38f;
#pragma unroll
        for (int o = 0; o < 8; ++o) if (o != i0 && el[o] > v1) { v1 = el[o]; i1 = o; }
        const float e1 = expf(v1 - v0), g0 = pgrp / (1.f + e1), g1 = pgrp * e1 / (1.f + e1);
        if (F.lane < 2) { const int e = gs * EPG + (F.lane == 0 ? i0 : i1); const float g = F.lane == 0 ? g0 : g1;
            const unsigned pos = atomicAdd(cnt + e * 16, 1u);
            ltok[(size_t)e * M + pos] = 2 * m + F.lane; lgate[(size_t)e * M + pos] = g; }
    }
    __syncthreads();
    REP(9) {
    LAS float* scr = (LAS float*)(F.lds + F.wave * TR_SCR);
    const float* eg = A.in[I_EX_GATE] + (size_t)layer * NE * D * DE; const float* eu = A.in[I_EX_UP] + (size_t)layer * NE * D * DE; const float* ed = A.in[I_EX_DOWN] + (size_t)layer * NE * DE * D;
    bf16_t* WGU = (bf16_t*)(ws + WS_WGU); bf16_t* WD = (bf16_t*)(ws + WS_WD);
    for (int it = F.gw; it < NE * 384; it += F.NGW) { const int e = it / 384, r = it % 384;
        if (r < 128) { const int kb = r / 8, nb = r % 8; transpose_item(eg + (size_t)e * D * DE, DE, nb * 64, kb * 64, WGU + (size_t)e * 1024 * D, D, 2 * nb * 64, 2, scr, F.lane); }
        else if (r < 256) { const int q = r - 128, kb = q / 8, nb = q % 8; transpose_item(eu + (size_t)e * D * DE, DE, nb * 64, kb * 64, WGU + (size_t)e * 1024 * D, D, 2 * nb * 64 + 1, 2, scr, F.lane); }
        else { const int q = r - 256, kb = q / 16, nb = q % 16; transpose_item(ed + (size_t)e * DE * D, D, nb * 64, kb * 64, WD + (size_t)e * 1024 * DE, DE, nb * 64, 1, scr, F.lane); }
    }
    }
}
__device__ __forceinline__ void moe_tables(const Frame& F, int layer) {
    LAS int* cntL = (LAS int*)(F.lds + MOE_OFF); LAS int* hoffL = cntL + 32; LAS int* tstartL = hoffL + 32;
    __syncthreads();
    if (F.tid < NE) cntL[F.tid] = (int)__hip_atomic_load(F.ctl + CW_CNT + (layer * NE + F.tid) * 16, RLX_AGENT);
    __syncthreads();
    if (F.tid == 0) { int h = 0, t = 0; for (int e = 0; e < NE; ++e) { hoffL[e] = h; tstartL[e] = t; h += cntL[e]; t += (cntL[e] + 255) >> 8; } tstartL[NE] = t; }
    __syncthreads();
}
__device__ __forceinline__ void phase_final(const Frame& F, const Args& A) {
    const bf16_t* YS = (const bf16_t*)(A.ws + WS_A + 64 * MiB);
    for (int m = F.gw; m < M; m += F.NGW) {
        f32x4* xr = (f32x4*)(A.out + (size_t)m * D) + F.lane;
        const u32x2* y0 = (const u32x2*)(YS + (size_t)(2 * m) * D) + F.lane; const u32x2* y1 = (const u32x2*)(YS + (size_t)(2 * m + 1) * D) + F.lane;
#pragma unroll
        for (int j = 0; j < 4; ++j) { f32x4 v = xr[64 * j]; const u32x2 a = y0[64 * j], b = y1[64 * j];
            v.x += bf2f(a.x & 0xffffu) + bf2f(b.x & 0xffffu); v.y += bf2f(a.x >> 16) + bf2f(b.x >> 16);
            v.z += bf2f(a.y & 0xffffu) + bf2f(b.y & 0xffffu); v.w += bf2f(a.y >> 16) + bf2f(b.y >> 16); xr[64 * j] = v; }
    }
}

constexpr int PH_PER_LAYER = 9, N_PHASES = NLAYER * PH_PER_LAYER + 1;
__global__ void __launch_bounds__(NTHREADS, 2) hymba_fwd(Args args) {
    extern __shared__ __attribute__((aligned(16))) unsigned char lds_raw[];
    Frame F;
    F.lds = (LAS unsigned char*)lds_raw; F.MISC = (volatile LAS unsigned*)(F.lds + MISC_OFF);
    F.tid = threadIdx.x; F.lane = F.tid & 63; F.wave = __builtin_amdgcn_readfirstlane(F.tid >> 6);
    F.G = gridDim.x; { const int bx = blockIdx.x; F.vcu = (F.G % 8 == 0) ? (bx % 8) * (F.G / 8) + bx / 8 : bx; }
    F.gw = F.vcu * NWAVES + F.wave; F.NGW = F.G * NWAVES;
    F.ctl = (unsigned*)(args.ws + WS_CTL);
    for (int u = F.tid; u < (LDS_BYTES - LDSCTL_OFF) / 4; u += NTHREADS) ((LAS unsigned*)(F.lds + LDSCTL_OFF))[u] = 0u;
    __syncthreads();
    if (F.tid < 23) ((LAS unsigned long long*)(F.lds + PTR_OFF))[F.tid] = (unsigned long long)args.in[F.tid];
    __syncthreads();
    XcdBarrier bar; bar.bar = F.ctl + CW_BAR; bar.x = 0; bar.st = nullptr;
#if MK_ONE_LAUNCH
    bar = xcd_barrier_post(F.ctl + CW_BAR, F.MISC + 8);
#define GRID_BAR() xcd_barrier(bar)
#else
#define GRID_BAR() do { } while (0)
#endif
    const int lo = args.ph_lo, hi = args.ph_hi;
    unsigned char* ws = args.ws;
    for (int ph = lo; ph < hi; ++ph) {
        Frame Fp = F; asm volatile("" : "+v"(Fp.lane), "+v"(Fp.tid));
        Args Ap; Ap.out = args.out; Ap.ws = args.ws; Ap.ph_lo = lo; Ap.ph_hi = hi;
        const LAS unsigned char* ptab = F.lds + PTR_OFF; asm volatile("" : "+v"(ptab));
#pragma unroll
        for (int i = 0; i < 23; ++i) { const unsigned long long v = ((const LAS unsigned long long*)ptab)[i];
            const unsigned plo = __builtin_amdgcn_readfirstlane((unsigned)v), phi = __builtin_amdgcn_readfirstlane((unsigned)(v >> 32)); Ap.in[i] = (const float*)(((unsigned long long)phi << 32) | plo); }
        const int layer = ph / PH_PER_LAYER, p = ph % PH_PER_LAYER;
        if (ph == N_PHASES - 1) { phase_final(Fp, Ap); }
        else if (p == 0) { phase_p0(Fp, Ap, layer); if ((((PROBE_REP) >> 8) & 1) && layer == 0) phase_p0(Fp, Ap, layer); }
        else if (p == 1) {
            pg8::DenseSched<M / 256, NPROJ / 256> S{Fp.G, (int)blockIdx.x, D, (const bf16_t*)(ws + WS_WIN)};
            pg8::EpiProj E{(bf16_t*)(ws + WS_A), NPROJ};
            REP(0) pg8::gemm_phase<pg8::EpiProj, pg8::DenseSched<M / 256, NPROJ / 256>>(Fp.lds, (const bf16_t*)(ws + WS_H), D, S, E);
        }
        else if (p == 2) { REP(3) cv::phase(Fp, Ap, layer); if (Fp.wave < 4) { REP(4) dn::phase1(Fp, Ap, layer); } else { Frame F2 = Fp; F2.gw = Fp.vcu * 4 + (Fp.wave - 4); F2.NGW = Fp.G * 4; att::phase_qknorm(F2, args, layer); } }
        else if (p == 3) { if (blockIdx.x < 64) { REP(1) dn::scan(Fp, Ap, layer, (int)blockIdx.x); } REP(2) att::phase_a(Fp, Ap); }
        else if (p == 4) { REP(5) att::phase_b(Fp, Ap); }
        else if (p == 5) {
            pg8::DenseSched<M / 256, D / 256> S{Fp.G, (int)blockIdx.x, D, (const bf16_t*)(ws + WS_WOUT)};
            pg8::EpiResid E{layer == 0 ? Ap.in[I_X] : Ap.out, Ap.out, D};
            pg8::gemm_phase<pg8::EpiResid, pg8::DenseSched<M / 256, D / 256>>(Fp.lds, (const bf16_t*)(ws + WS_MIXED), D, S, E);
        }
        else if (p == 6) { phase_p4(Fp, Ap, layer); }
        else if (p == 7) {
            moe_tables(Fp, layer);
            pg8::MoeSched<false> S; S.cntL = (const LAS int*)(Fp.lds + MOE_OFF); S.hoffL = S.cntL + 32; S.tstartL = S.hoffL + 32; S.G = Fp.G; S.vc = Fp.vcu;
            S.ltok = (const int*)(ws + WS_LTOK); S.Bt = (const bf16_t*)(ws + WS_WGU);
            pg8::EpiGU E{(bf16_t*)(ws + WS_A)};
            REP(6) pg8::gemm_phase<pg8::EpiGU, pg8::MoeSched<false>>(Fp.lds, (const bf16_t*)(ws + WS_H), D, S, E);
        }
        else {
            moe_tables(Fp, layer);
            pg8::MoeSched<true> S; S.cntL = (const LAS int*)(Fp.lds + MOE_OFF); S.hoffL = S.cntL + 32; S.tstartL = S.hoffL + 32; S.G = Fp.G; S.vc = Fp.vcu;
            S.ltok = (const int*)(ws + WS_LTOK); S.Bt = (const bf16_t*)(ws + WS_WD);
            pg8::EpiDown E{(bf16_t*)(ws + WS_A + 64 * MiB), (const int*)(ws + WS_LTOK), (const float*)(ws + WS_LGATE)};
            REP(7) pg8::gemm_phase<pg8::EpiDown, pg8::MoeSched<true>>(Fp.lds, (const bf16_t*)(ws + WS_A), DE, S, E);
        }
        if (ph + 1 < hi) GRID_BAR();
    }
}

extern "C" void kernel_launch(void* const* d_in, const int* in_sizes, int n_in, void* d_out, int out_size, void* d_ws, size_t ws_size, hipStream_t stream) {
    static int grid = 0;
    if (grid == 0) {
        if (n_in != 23 || out_size != M * D || ws_size < WS_END) { fprintf(stderr, "kernel_launch: unexpected shapes (n_in %d out %d ws %zu)\n", n_in, out_size, ws_size); grid = -1; return; }
        int dev = 0, cus = 0, per_cu = 0;
        if (hipGetDevice(&dev) != hipSuccess || hipDeviceGetAttribute(&cus, hipDeviceAttributeMultiprocessorCount, dev) != hipSuccess) { grid = -1; return; }
        if (hipFuncSetAttribute((const void*)hymba_fwd, hipFuncAttributeMaxDynamicSharedMemorySize, LDS_BYTES) != hipSuccess) { fprintf(stderr, "kernel_launch: hipFuncSetAttribute failed\n"); grid = -1; return; }
        if (hipOccupancyMaxActiveBlocksPerMultiprocessor(&per_cu, (const void*)hymba_fwd, NTHREADS, LDS_BYTES) != hipSuccess || per_cu < 1) { fprintf(stderr, "kernel_launch: occupancy query says %d\n", per_cu); per_cu = 1; }
        (void)hipGetLastError();
        grid = cus;
    }
    if (grid < 0) return;
    (void)hipMemsetAsync((char*)d_ws + WS_CTL, 0, CTL_ZERO_BYTES, stream);
    Args a{};
    for (int i = 0; i < 23; ++i) a.in[i] = (const float*)d_in[i];
    a.out = (float*)d_out; a.ws = (unsigned char*)d_ws;
#if MK_ONE_LAUNCH
    a.ph_lo = 0; a.ph_hi = N_PHASES;
    void* kargs[] = {&a};
    hipError_t e = hipLaunchCooperativeKernel((const void*)hymba_fwd, dim3(grid), dim3(NTHREADS), kargs, LDS_BYTES, stream);
    if (e != hipSuccess) fprintf(stderr, "kernel_launch: cooperative launch failed: %s (grid %d)\n", hipGetErrorString(e), grid);
#else
    for (int ph = 0; ph < N_PHASES; ++ph) { a.ph_lo = ph; a.ph_hi = ph + 1;
        hipLaunchKernelGGL(hymba_fwd, dim3(grid), dim3(NTHREADS), LDS_BYTES, stream, a); }
#endif
}
```

```cpp
#include <hip/hip_runtime.h>
#include <cstdio>
#include <cstdint>

#ifndef PROBE_REP
#define PROBE_REP 0
#endif
#define REP(bit) for (int rep_ = 0; rep_ < (((PROBE_REP) >> (bit)) & 1) + 1; ++rep_)
#ifndef MK_ONE_LAUNCH
#define MK_ONE_LAUNCH 1
#endif

#define LAS __attribute__((address_space(3)))
#define GAS __attribute__((address_space(1)))
typedef unsigned short bf16_t;
typedef short bf16x8 __attribute__((ext_vector_type(8)));
typedef float f32x4 __attribute__((ext_vector_type(4)));
typedef float f32x2 __attribute__((ext_vector_type(2)));
typedef unsigned u32x4 __attribute__((ext_vector_type(4)));
typedef unsigned u32x2 __attribute__((ext_vector_type(2)));
typedef GAS unsigned gu32;
#define RLX_AGENT __ATOMIC_RELAXED, __HIP_MEMORY_SCOPE_AGENT
#define LDS_WAIT() asm volatile("s_waitcnt lgkmcnt(0)" ::: "memory")
#define VM_WAIT() asm volatile("s_waitcnt vmcnt(0)" ::: "memory")

constexpr int D = 1024, BATCH = 16, SEQ = 2048, M = BATCH * SEQ, NLAYER = 2;
constexpr int NIN = 3080, NPROJ = 3072;
constexpr int HD = 64, DNH = 4, ATH = 8, CVW = 256, CVK = 31;
constexpr int NGRP = 4, EPG = 8, NE = 32, DE = 512;
constexpr float EPS = 1e-6f;
constexpr int C_DQ = 0, C_DK = 256, C_DV = 512, C_DZ = 768, C_AQ = 1024, C_AK = 1536, C_AV = 2048, C_CU = 2560, C_CG = 2816;
constexpr int NWAVES = 8, NTHREADS = 512;

constexpr size_t MiB = 1u << 20;
constexpr size_t WS_CTL = 0, CTL_ZERO_BYTES = 1 * MiB;
constexpr size_t WS_WIN = 1 * MiB;
constexpr size_t WS_WOUT = 7 * MiB;
constexpr size_t WS_AB = 9 * MiB;
constexpr size_t WS_LTOK = 10 * MiB;
constexpr size_t WS_LGATE = 14 * MiB;
constexpr size_t WS_WGU = 18 * MiB;
constexpr size_t WS_WD = 82 * MiB;
constexpr size_t WS_H = 114 * MiB;
constexpr size_t WS_MIXED = 178 * MiB;
constexpr size_t WS_A = 242 * MiB;
constexpr size_t WS_ATTO = 434 * MiB;
constexpr size_t WS_ATTL = 498 * MiB;
constexpr size_t WS_END = 500 * MiB;
constexpr size_t WS_SCR = WS_WGU;
constexpr size_t WS_O = WS_H;
constexpr int CW_BAR = 4096;
constexpr int CW_CNT = 8192;
constexpr int CW_Q = 12288;

constexpr int RING_BYTES = 131072;
constexpr int LDS_BYTES = 155648;
constexpr int LDSCTL_OFF = 154624;
constexpr int MISC_OFF = LDSCTL_OFF;
constexpr int MOE_OFF = LDSCTL_OFF + 256;
constexpr int PTR_OFF = LDSCTL_OFF + 768;

__device__ __forceinline__ float bf2f(unsigned v) { return __uint_as_float(v << 16); }
__device__ __forceinline__ unsigned f2bf(float f) { unsigned u = __float_as_uint(f); return (u + 0x7fffu + ((u >> 16) & 1u)) >> 16; }
__device__ __forceinline__ unsigned pk2(float lo, float hi) { return f2bf(lo) | (f2bf(hi) << 16); }
__device__ __forceinline__ float wave_sum(float v) {
#pragma unroll
    for (int o = 1; o < 64; o <<= 1) v += __shfl_xor(v, o);
    return v;
}
__device__ __forceinline__ float wave_max(float v) {
#pragma unroll
    for (int o = 1; o < 64; o <<= 1) v = fmaxf(v, __shfl_xor(v, o));
    return v;
}
__device__ __forceinline__ float sigm(float x) { return 1.f / (1.f + expf(-x)); }
__device__ __forceinline__ float siluf(float x) { return x * sigm(x); }


__device__ __forceinline__ void fold4(const float (&a)[4], float (&out)[4], int lane) {
    const bool p = lane & 1, p2 = (lane >> 1) & 1;
    float k0 = (p ? a[2] : a[0]) + __shfl_xor(p ? a[0] : a[2], 1), k1 = (p ? a[3] : a[1]) + __shfl_xor(p ? a[1] : a[3], 1);
    float k = (p2 ? k1 : k0) + __shfl_xor(p2 ? k0 : k1, 2);
#pragma unroll
    for (int o = 4; o < 64; o <<= 1) k += __shfl_xor(k, o);
    out[0] = __builtin_bit_cast(float, __builtin_amdgcn_readlane(__builtin_bit_cast(int, k), 0)); out[2] = __builtin_bit_cast(float, __builtin_amdgcn_readlane(__builtin_bit_cast(int, k), 1));
    out[1] = __builtin_bit_cast(float, __builtin_amdgcn_readlane(__builtin_bit_cast(int, k), 2)); out[3] = __builtin_bit_cast(float, __builtin_amdgcn_readlane(__builtin_bit_cast(int, k), 3));
}
__device__ __forceinline__ void fold8(const float (&a)[8], float (&out)[8], int lane) {
    const bool p = lane & 1, p2 = (lane >> 1) & 1, p4 = (lane >> 2) & 1;
    float b[4];
#pragma unroll
    for (int i = 0; i < 4; ++i) b[i] = (p ? a[4 + i] : a[i]) + __shfl_xor(p ? a[i] : a[4 + i], 1);
    float c[2];
#pragma unroll
    for (int i = 0; i < 2; ++i) c[i] = (p2 ? b[2 + i] : b[i]) + __shfl_xor(p2 ? b[i] : b[2 + i], 2);
    float k = (p4 ? c[1] : c[0]) + __shfl_xor(p4 ? c[0] : c[1], 4);
#pragma unroll
    for (int o = 8; o < 64; o <<= 1) k += __shfl_xor(k, o);
#pragma unroll
    for (int l = 0; l < 8; ++l) { const int o = 4 * (l & 1) + 2 * ((l >> 1) & 1) + ((l >> 2) & 1); out[o] = __builtin_bit_cast(float, __builtin_amdgcn_readlane(__builtin_bit_cast(int, k), l)); }
}

namespace pg8 {
constexpr int BM = 256, BK = 64, HALF = 128, HTB = HALF * BK * 2, STAGE_BYTES = 8 * HTB, NXCD = 8, WGM = 8;
__host__ __device__ __forceinline__ int lds_byte(int r, int c) { const int st = (r >> 4) * 2 + (c >> 5), rr = r & 15, cc = c & 31, ob = rr * 64 + cc * 2; return st * 1024 + (ob ^ (((ob >> 9) & 1) << 5)); }
__host__ __device__ __forceinline__ void stage_rc(int b, int& R, int& C) { const int st = b / 1024, sb = b % 1024, swz = sb ^ (((sb >> 9) & 1) << 5); R = (st >> 1) * 16 + swz / 64; C = (st & 1) * 32 + (swz % 64) / 2; }
__host__ __device__ __forceinline__ int perm32(int rho) { const int n = rho >> 4, i = rho & 15; return 8 * (i >> 2) + 4 * n + (i & 3); }
typedef __bf16 bf16x2_t __attribute__((ext_vector_type(2)));
__device__ __forceinline__ unsigned cvt_pk_bf16(float lo, float hi) { f32x2 v = {lo, hi}; bf16x2_t b = __builtin_convertvector(v, bf16x2_t); return __builtin_bit_cast(unsigned, b); }

template <class Epi, class Sched>
__device__ __forceinline__ void gemm_phase(LAS unsigned char* lds, const bf16_t* Abase, const int K, const Sched& S, const Epi& E) {
    int tid_ = threadIdx.x; asm volatile("" : "+v"(tid_));
    const int tid = tid_, wid = __builtin_amdgcn_readfirstlane(tid >> 6), lane = tid & 63, wr = wid >> 2, wc = wid & 3, fr = lane & 15, fq = lane >> 4;
    const int nt = K / BK;
    int Rr[2], Cc2[2]; unsigned voffB[2];
#pragma unroll
    for (int i = 0; i < 2; ++i) { int R, C; stage_rc(tid * 16 + i * 8192, R, C); const int Rb = Epi::PERM ? ((R & ~31) + perm32(R & 31)) : R;
        Rr[i] = R; Cc2[i] = C * 2; voffB[i] = (unsigned)(Rb * K + C) * 2u; }
    const size_t kstep = (size_t)(BK * 2);
    const size_t hstep = (size_t)HALF * K * 2;
    const unsigned ldsw = (unsigned)wid * 1024u;
    const int aoff = lds_byte(wr * 64 + fr, fq * 8), boff = lds_byte(wc * 32 + fr, fq * 8);
    const char* Ab = (const char*)Abase;
#define PG8_SA(b, h) (((b) * 2 + (h)) * HTB)
#define PG8_SB(b, h) ((4 + (b) * 2 + (h)) * HTB)
#define PG8_STAGE(bufoff, gbase, voff) do { _Pragma("unroll") for (int _i = 0; _i < 2; ++_i) \
        __builtin_amdgcn_global_load_lds((const unsigned*)((const char*)(gbase) + (voff)[_i]), (LAS unsigned*)(lds + (bufoff) + ldsw + _i * 8192), 16, 0, 0); } while (0)
#define PG8_LDA(dst, b, h) do { _Pragma("unroll") for (int m = 0; m < 4; ++m) _Pragma("unroll") for (int k = 0; k < 2; ++k) dst[m][k] = *(const LAS bf16x8*)(lds + PG8_SA(b, h) + aoff + m * 2048 + k * 1024); } while (0)
#define PG8_LDB(dst, b, h) do { _Pragma("unroll") for (int n = 0; n < 2; ++n) _Pragma("unroll") for (int k = 0; k < 2; ++k) dst[n][k] = *(const LAS bf16x8*)(lds + PG8_SB(b, h) + boff + n * 2048 + k * 1024); } while (0)
#define PG8_MMA(ai, bj, At, Bt) do { __builtin_amdgcn_s_setprio(1); _Pragma("unroll") for (int m = 0; m < 4; ++m) _Pragma("unroll") for (int n = 0; n < 2; ++n) _Pragma("unroll") for (int k = 0; k < 2; ++k) \
        acc[ai][bj][m][n] = __builtin_amdgcn_mfma_f32_16x16x32_bf16(Bt[n][k], At[m][k], acc[ai][bj][m][n], 0, 0, 0); __builtin_amdgcn_s_setprio(0); } while (0)
#define PG8_WAIT_V(n) asm volatile("s_waitcnt vmcnt(" #n ")" ::: "memory")
#define PG8_WAIT_L(n) asm volatile("s_waitcnt lgkmcnt(" #n ")" ::: "memory")
#define PG8_BAR __builtin_amdgcn_s_barrier()
#define PG8_SCHED __builtin_amdgcn_sched_barrier(0)
    typename Sched::Unit cur, nxt; int ui = 0;
    if (!S.next(0, cur)) return;
    unsigned va0[2], va1[2], vn0[2], vn1[2];
    const char* cA = Ab; const char* nA = Ab;
    if constexpr (Sched::GATHER) {
#pragma unroll
        for (int i = 0; i < 2; ++i) { va0[i] = S.a_off(cur, Rr[i]) + (unsigned)Cc2[i]; va1[i] = S.a_off(cur, HALF + Rr[i]) + (unsigned)Cc2[i]; }
    } else {
#pragma unroll
        for (int i = 0; i < 2; ++i) { va0[i] = (unsigned)(Rr[i] * K * 2 + Cc2[i]); va1[i] = va0[i] + (unsigned)hstep; vn0[i] = va0[i]; vn1[i] = va1[i]; }
        cA = Ab + S.a_base(cur);
    }
    f32x4 acc[2][2][4][2];
#pragma unroll
    for (int a = 0; a < 2; ++a)
#pragma unroll
        for (int b = 0; b < 2; ++b)
#pragma unroll
            for (int m = 0; m < 4; ++m)
#pragma unroll
                for (int n = 0; n < 2; ++n) acc[a][b][m][n] = (f32x4){0.f, 0.f, 0.f, 0.f};
    bf16x8 At[4][2], B0[2][2], B1[2][2];
    const char* cB = S.b_base(cur);
    PG8_STAGE(PG8_SB(0, 0), cB, voffB); PG8_STAGE(PG8_SB(0, 1), cB + hstep, voffB); PG8_STAGE(PG8_SA(0, 0), cA, va0); PG8_STAGE(PG8_SA(0, 1), cA, va1);
    if (wr == 1) PG8_BAR;
    PG8_WAIT_V(2); PG8_BAR;
    PG8_STAGE(PG8_SB(1, 0), cB + kstep, voffB); PG8_STAGE(PG8_SA(1, 0), cA + kstep, va0); PG8_STAGE(PG8_SB(1, 1), cB + hstep + kstep, voffB);
    PG8_WAIT_V(6); PG8_BAR;
    for (;;) {
        const bool has_next = S.next(ui + 1, nxt);
        const char* nB = cB; nA = cA;
        if (has_next) { nB = S.b_base(nxt);
            if constexpr (Sched::GATHER) {
#pragma unroll
                for (int i = 0; i < 2; ++i) { vn0[i] = S.a_off(nxt, Rr[i]) + (unsigned)Cc2[i]; vn1[i] = S.a_off(nxt, HALF + Rr[i]) + (unsigned)Cc2[i]; }
            } else nA = Ab + S.a_base(nxt);
        } else if constexpr (Sched::GATHER) {
#pragma unroll
            for (int i = 0; i < 2; ++i) { vn0[i] = va0[i]; vn1[i] = va1[i]; } }
        for (int t = 0; t < nt; t += 2) {
            const bool last = (t == nt - 2);
            const char* a1 = cA + (size_t)(t + 1) * kstep;
            const char* a2 = last ? nA : cA + (size_t)(t + 2) * kstep; const char* b2 = last ? nB : cB + (size_t)(t + 2) * kstep;
            const char* a3 = a2 + kstep; const char* b3 = b2 + kstep;
            unsigned w0[2], w1[2];
#pragma unroll
            for (int i = 0; i < 2; ++i) { if constexpr (Sched::GATHER) { w0[i] = last ? vn0[i] : va0[i]; w1[i] = last ? vn1[i] : va1[i]; } else { w0[i] = va0[i]; w1[i] = va1[i]; } }
            PG8_LDB(B0, 0, 0); PG8_LDB(B1, 0, 1); PG8_SCHED; PG8_LDA(At, 0, 0); PG8_STAGE(PG8_SA(1, 1), a1, va1);
            PG8_WAIT_V(8); PG8_WAIT_L(0); PG8_BAR; PG8_MMA(0, 0, At, B0); PG8_MMA(0, 1, At, B1); PG8_BAR; PG8_SCHED;
            PG8_LDA(At, 0, 1); PG8_STAGE(PG8_SB(0, 0), b2, voffB); PG8_STAGE(PG8_SB(0, 1), b2 + hstep, voffB); PG8_STAGE(PG8_SA(0, 0), a2, w0);
            PG8_WAIT_V(8); PG8_WAIT_L(0); PG8_BAR; PG8_MMA(1, 0, At, B0); PG8_MMA(1, 1, At, B1); PG8_BAR; PG8_SCHED;
            PG8_LDB(B0, 1, 0); PG8_LDB(B1, 1, 1); PG8_SCHED; PG8_LDA(At, 1, 0); PG8_STAGE(PG8_SA(0, 1), a2, w1);
            PG8_WAIT_V(8); PG8_WAIT_L(0); PG8_BAR; PG8_MMA(0, 0, At, B0); PG8_MMA(0, 1, At, B1); PG8_BAR; PG8_SCHED;
            PG8_LDA(At, 1, 1); PG8_STAGE(PG8_SB(1, 0), b3, voffB); PG8_STAGE(PG8_SB(1, 1), b3 + hstep, voffB); PG8_STAGE(PG8_SA(1, 0), a3, w0);
            PG8_WAIT_V(8); PG8_WAIT_L(0); PG8_BAR; PG8_MMA(1, 0, At, B0); PG8_MMA(1, 1, At, B1); PG8_BAR; PG8_SCHED;
        }
        if (wr == 0) PG8_BAR;
        E(acc, cur, wr, wc, fr, fq);
        if (!has_next) break;
#pragma unroll
        for (int a = 0; a < 2; ++a)
#pragma unroll
            for (int b = 0; b < 2; ++b)
#pragma unroll
                for (int m = 0; m < 4; ++m)
#pragma unroll
                    for (int n = 0; n < 2; ++n) acc[a][b][m][n] = (f32x4){0.f, 0.f, 0.f, 0.f};
        cur = nxt; cB = nB; cA = nA; ++ui;
        if constexpr (Sched::GATHER) {
#pragma unroll
            for (int i = 0; i < 2; ++i) { va0[i] = vn0[i]; va1[i] = vn1[i]; } }
        if (wr == 1) PG8_BAR;
    }
    PG8_WAIT_V(0);
    PG8_BAR;
#undef PG8_SA
#undef PG8_SB
#undef PG8_STAGE
#undef PG8_LDA
#undef PG8_LDB
#undef PG8_MMA
#undef PG8_WAIT_V
#undef PG8_WAIT_L
#undef PG8_BAR
#undef PG8_SCHED
}

struct DUnit { int pm, pn; };
template <int NM, int NN>
struct DenseSched {
    typedef DUnit Unit; static constexpr bool GATHER = false;
    int G, c, K; const bf16_t* Bt;
    __device__ __forceinline__ bool next(int i, Unit& u) const {
        constexpr int nwg = NM * NN, q = nwg / NXCD; static_assert(nwg % NXCD == 0 && NM % WGM == 0, "tile counts");
        const int L = i * G + c; if (L >= nwg) return false;
        const int wgid = (L % NXCD) * q + L / NXCD;
        constexpr int nig = WGM * NN; const int gid = wgid / nig, fm = gid * WGM;
        u.pm = fm + ((wgid % nig) % WGM); u.pn = (wgid % nig) / WGM; return true;
    }
    __device__ __forceinline__ size_t a_base(const Unit& u) const { return (size_t)u.pm * BM * K * 2; }
    __device__ __forceinline__ unsigned a_off(const Unit&, int) const { return 0u; }
    __device__ __forceinline__ const char* b_base(const Unit& u) const { return (const char*)(Bt + (size_t)u.pn * BM * K); }
};
struct MUnit { int e, mt, pn, cnt, hoff; };
template <bool DOWN>
struct MoeSched {
    typedef MUnit Unit; static constexpr bool GATHER = true;
    __device__ __forceinline__ size_t a_base(const Unit&) const { return 0; }
    const LAS int* cntL; const LAS int* hoffL; const LAS int* tstartL;
    int G, vc; const int* ltok; const bf16_t* Bt;
    __device__ __forceinline__ bool next(int i, Unit& u) const {
        const int total = tstartL[NE] * 4; const long L = (long)i * G + vc; if (L >= total) return false;
        const int mtg = (int)L >> 2; u.pn = (int)L & 3;
        int e = 0;
#pragma unroll 1
        for (int k = 1; k < NE; ++k) if (tstartL[k] <= mtg) e = k;
        u.e = e; u.mt = mtg - tstartL[e]; u.cnt = cntL[e]; u.hoff = hoffL[e]; return true;
    }
    __device__ __forceinline__ unsigned a_off(const Unit& u, int row) const {
        int idx = u.mt * BM + row; idx = idx < u.cnt ? idx : u.cnt - 1;
        if (DOWN) return (unsigned)(u.hoff + idx) * (unsigned)(DE * 2);
        const int t2 = ltok[(size_t)u.e * M + idx]; return (unsigned)(t2 >> 1) * (unsigned)(D * 2);
    }
    __device__ __forceinline__ const char* b_base(const Unit& u) const { return (const char*)(Bt + ((size_t)u.e * 1024 + (size_t)u.pn * BM) * (DOWN ? DE : D)); }
};

struct EpiProj {
    static constexpr bool PERM = true;
    bf16_t* O; int ldc;
    __device__ __forceinline__ void operator()(const f32x4 (&acc)[2][2][4][2], const DUnit& u, int wr, int wc, int fr, int fq) const {
        const int row0 = u.pm * BM + wr * 64 + fr, col0 = u.pn * BM + wc * 32 + 8 * fq;
#pragma unroll
        for (int ai = 0; ai < 2; ++ai)
#pragma unroll
            for (int m = 0; m < 4; ++m) { bf16_t* rowp = O + (size_t)(row0 + ai * HALF + m * 16) * ldc + col0;
#pragma unroll
                for (int bj = 0; bj < 2; ++bj) { const f32x4 v0 = acc[ai][bj][m][0], v1 = acc[ai][bj][m][1];
                    u32x4 w; w.x = cvt_pk_bf16(v0[0], v0[1]); w.y = cvt_pk_bf16(v0[2], v0[3]); w.z = cvt_pk_bf16(v1[0], v1[1]); w.w = cvt_pk_bf16(v1[2], v1[3]);
                    *(u32x4*)(rowp + bj * HALF) = w; } }
    }
};
struct EpiResid {
    static constexpr bool PERM = false;
    const float* resid; float* out; int ldc;
    __device__ __forceinline__ void operator()(const f32x4 (&acc)[2][2][4][2], const DUnit& u, int wr, int wc, int fr, int fq) const {
        const int row0 = u.pm * BM + wr * 64 + fr, col0 = u.pn * BM + wc * 32 + 4 * fq;
#pragma unroll
        for (int ai = 0; ai < 2; ++ai)
#pragma unroll
            for (int m = 0; m < 4; ++m) { const size_t off = (size_t)(row0 + ai * HALF + m * 16) * ldc + col0;
#pragma unroll
                for (int bj = 0; bj < 2; ++bj)
#pragma unroll
                    for (int n = 0; n < 2; ++n) { const f32x4 r = *(const f32x4*)(resid + off + bj * HALF + n * 16); *(f32x4*)(out + off + bj * HALF + n * 16) = r + acc[ai][bj][m][n]; } }
    }
};
struct EpiGU {
    static constexpr bool PERM = true;
    bf16_t* HID;
    __device__ __forceinline__ void operator()(const f32x4 (&acc)[2][2][4][2], const MUnit& u, int wr, int wc, int fr, int fq) const {
        const int r0 = wr * 64 + fr, j0 = u.pn * 128 + wc * 16 + 4 * fq;
#pragma unroll
        for (int ai = 0; ai < 2; ++ai)
#pragma unroll
            for (int m = 0; m < 4; ++m) { const int idx = u.mt * BM + r0 + ai * HALF + m * 16;
                if (idx < u.cnt) { bf16_t* rowp = HID + (size_t)(u.hoff + idx) * DE + j0;
#pragma unroll
                    for (int bj = 0; bj < 2; ++bj) { const f32x4 v0 = acc[ai][bj][m][0], v1 = acc[ai][bj][m][1];
                        const float h0 = siluf(v0[0]) * v0[1], h1 = siluf(v0[2]) * v0[3], h2 = siluf(v1[0]) * v1[1], h3 = siluf(v1[2]) * v1[3];
                        u32x2 w; w.x = cvt_pk_bf16(h0, h1); w.y = cvt_pk_bf16(h2, h3);
                        *(u32x2*)(rowp + bj * 64) = w; } } }
    }
};
struct EpiDown {
    static constexpr bool PERM = true;
    bf16_t* YS; const int* ltok; const float* lgate;
    __device__ __forceinline__ void operator()(const f32x4 (&acc)[2][2][4][2], const MUnit& u, int wr, int wc, int fr, int fq) const {
        const int r0 = wr * 64 + fr, col0 = u.pn * BM + wc * 32 + 8 * fq;
#pragma unroll
        for (int ai = 0; ai < 2; ++ai)
#pragma unroll
            for (int m = 0; m < 4; ++m) { const int idx = u.mt * BM + r0 + ai * HALF + m * 16;
                if (idx < u.cnt) { const int t2 = ltok[(size_t)u.e * M + idx]; const float g = lgate[(size_t)u.e * M + idx];
                    bf16_t* rowp = YS + (size_t)t2 * D + col0;
#pragma unroll
                    for (int bj = 0; bj < 2; ++bj) { const f32x4 v0 = acc[ai][bj][m][0] * g, v1 = acc[ai][bj][m][1] * g;
                        u32x4 w; w.x = cvt_pk_bf16(v0[0], v0[1]); w.y = cvt_pk_bf16(v0[2], v0[3]); w.z = cvt_pk_bf16(v1[0], v1[1]); w.w = cvt_pk_bf16(v1[2], v1[3]);
                        *(u32x4*)(rowp + bj * HALF) = w; } } }
    }
};
}

#define XB_TMO      128
#define XB_XCNT(j)  (256  + 64 * (j))
#define XB_XSUB(j)  (1280 + 64 * (j))
#define XB_XGEN(j)  (2304 + 64 * (j))
#define XB_TOP      3328
#define XB_TOPGEN   3392
#define XCD_BAR_WORDS 3456
#define XB_SPIN_CAP (1u << 22)
__device__ __forceinline__ unsigned xb_ld(unsigned* p)              { return __hip_atomic_load(p, __ATOMIC_RELAXED, __HIP_MEMORY_SCOPE_AGENT); }
__device__ __forceinline__ unsigned xb_add(unsigned* p, unsigned v) { return __hip_atomic_fetch_add(p, v, __ATOMIC_RELAXED, __HIP_MEMORY_SCOPE_AGENT); }
__device__ __forceinline__ unsigned xb_xcc_id() { return (unsigned)__builtin_amdgcn_s_getreg((3 << 11) | 20) & 0xFu; }
#define XB_SPIN(cond, bar) do { unsigned _sp = 0; while (cond) { __builtin_amdgcn_s_sleep(1); \
    if ((++_sp & 255u) == 0u) { if (xb_ld(&(bar)[XB_TMO])) break; if (_sp > XB_SPIN_CAP) { atomicAdd(&(bar)[XB_TMO], 1u); break; } } } } while (0)
struct XcdBarrier { unsigned* bar; unsigned x; volatile LAS unsigned* st; };
__device__ __forceinline__ XcdBarrier xcd_barrier_post(unsigned* bar, volatile LAS unsigned* st) {
    XcdBarrier b; b.bar = bar; b.x = xb_xcc_id(); b.st = st;
    if (threadIdx.x == 0) (void)xb_add(&bar[XB_XCNT(b.x)], 1u);
    return b;
}
__device__ __forceinline__ void xcd_barrier_complete(unsigned* bar, unsigned x, unsigned& nloc, unsigned& nx) {
    const unsigned G = gridDim.x * gridDim.y * gridDim.z;
    unsigned sum, cnt, mine, sp = 0u;
    for (;;) {
        sum = 0u; cnt = 0u; mine = 0u;
#pragma unroll
        for (unsigned j = 0; j < 16; ++j) { const unsigned c = xb_ld(&bar[XB_XCNT(j)]); sum += c; cnt += (c > 0u) ? 1u : 0u; mine = (j == x) ? c : mine; }
        if (sum == G) break;
        __builtin_amdgcn_s_sleep(1);
        if ((++sp & 255u) == 0u) { if (xb_ld(&bar[XB_TMO])) break; if (sp > XB_SPIN_CAP) { atomicAdd(&bar[XB_TMO], 1u); break; } }
    }
    nloc = mine > 0u ? mine : 1u; nx = cnt > 0u ? cnt : 1u;
}
__device__ __forceinline__ void xcd_barrier(const XcdBarrier& b) {
    asm volatile("s_waitcnt vmcnt(0)" ::: "memory");
    __syncthreads();
    if (threadIdx.x == 0) {
        unsigned* bar = b.bar;
        __builtin_amdgcn_s_waitcnt(0);
        unsigned nloc = b.st[0], nx = b.st[1];
        if (nloc == 0u) { xcd_barrier_complete(bar, b.x, nloc, nx); b.st[0] = nloc; b.st[1] = nx; }
        const unsigned old = xb_add(&bar[XB_XSUB(b.x)], 1u);
        const unsigned gen = old / nloc;
        if (old + 1u == (gen + 1u) * nloc) {
            __builtin_amdgcn_fence(__ATOMIC_RELEASE, "agent");
            asm volatile("s_waitcnt vmcnt(0)" ::: "memory");
            const unsigned og = xb_add(&bar[XB_TOP], 1u);
            const unsigned tg = og / nx;
            if (og + 1u == (tg + 1u) * nx) xb_add(&bar[XB_TOPGEN], 1u);
            else XB_SPIN(xb_ld(&bar[XB_TOPGEN]) == tg, bar);
            __builtin_amdgcn_fence(__ATOMIC_ACQUIRE, "agent");
            xb_add(&bar[XB_XGEN(b.x)], 1u);
            asm volatile("s_waitcnt vmcnt(0)" ::: "memory");
        } else {
            XB_SPIN(xb_ld(&bar[XB_XGEN(b.x)]) == gen, bar);
            __builtin_amdgcn_fence(__ATOMIC_ACQUIRE, "agent");
            asm volatile("s_waitcnt vmcnt(0)" ::: "memory");
        }
    }
    __syncthreads();
}

struct Args {
    const float* in[23]; float* out; unsigned char* ws; int ph_lo, ph_hi;
};
struct Frame {
    LAS unsigned char* lds; volatile LAS unsigned* MISC; unsigned* ctl;
    int tid, lane, wave, vcu, G, gw, NGW;
};
enum { I_X = 0, I_NORM_MIX, I_W_IN, I_DN_CONV, I_DN_ALOG, I_DN_DTB, I_DN_ONORM, I_AT_QN, I_AT_KN, I_RELB, I_CV_DW, I_CV_DWB, I_CV_LNG, I_CV_LNB,
       I_W_OUT, I_NORM_FFN, I_RG_W, I_RG_B, I_RE_W, I_RE_B, I_EX_GATE, I_EX_UP, I_EX_DOWN };

__device__ __forceinline__ void transpose_item(const float* W, int ldw, int src_col0, int k0, bf16_t* WT, int Kd, int dst_row0, int dst_mul, LAS float* scr, int lane) {
    const float* wp = W + (size_t)k0 * ldw + src_col0 + lane;
#pragma unroll
    for (int h2 = 0; h2 < 2; ++h2) { float v[32];
#pragma unroll
        for (int i = 0; i < 32; ++i) v[i] = wp[(size_t)(h2 * 32 + i) * ldw];
#pragma unroll
        for (int i = 0; i < 32; ++i) scr[(h2 * 32 + i) * 65 + lane] = v[i]; }
    LDS_WAIT(); asm volatile("" ::: "memory");
    const int c = lane & 7;
#pragma unroll
    for (int j = 0; j < 8; ++j) { const int n = (lane >> 3) + 8 * j; const LAS float* s = scr + (8 * c) * 65 + n;
        u32x4 o; o.x = pk2(s[0 * 65], s[1 * 65]); o.y = pk2(s[2 * 65], s[3 * 65]); o.z = pk2(s[4 * 65], s[5 * 65]); o.w = pk2(s[6 * 65], s[7 * 65]);
        *(u32x4*)(WT + (size_t)(dst_row0 + dst_mul * n) * Kd + k0 + 8 * c) = o; }
    LDS_WAIT(); asm volatile("" ::: "memory");
}
constexpr int TR_SCR = 64 * 65 * 4;

__device__ __forceinline__ void phase_p0(const Frame& F, const Args& A, int layer) {
    unsigned char* ws = A.ws;
    LAS float* scr = (LAS float*)(F.lds + F.wave * TR_SCR);
    const float* w_in = A.in[I_W_IN] + (size_t)layer * D * NIN;
    const float* w_out = A.in[I_W_OUT] + (size_t)layer * D * D;
    bf16_t* WIN = (bf16_t*)(ws + WS_WIN); bf16_t* WOUT = (bf16_t*)(ws + WS_WOUT);
    constexpr int I_IN = (D / 64) * (NPROJ / 64), I_OUT = (D / 64) * (D / 64);
    for (int it = F.gw; it < I_IN + I_OUT; it += F.NGW) {
        if (it < I_IN) { const int nblk = NPROJ / 64, kb = it / nblk, nb = it % nblk, n0 = nb * 64; const int src = n0 < 1024 ? n0 : n0 + 8;
            transpose_item(w_in, NIN, src, kb * 64, WIN, D, n0, 1, scr, F.lane); }
        else { const int r = it - I_IN, nblk = D / 64, kb = r / nblk, nb = r % nblk;
            transpose_item(w_out, D, nb * 64, kb * 64, WOUT, D, nb * 64, 1, scr, F.lane); }
    }
    const float* xin = layer == 0 ? A.in[I_X] : A.out;
    const float* gmix = A.in[I_NORM_MIX] + layer * D;
    bf16_t* H = (bf16_t*)(ws + WS_H); float* AB = (float*)(ws + WS_AB);
    const bf16_t* YS = (const bf16_t*)(ws + WS_A + 64 * MiB);
    __syncthreads();
    LAS float* wabT = (LAS float*)F.lds;
    for (int idx = F.tid; idx < 2 * D; idx += NTHREADS) { const int k = idx & (D - 1), o4 = idx >> 10; const f32x4 w = *(const f32x4*)(w_in + (size_t)k * NIN + 1024 + 4 * o4);
        wabT[(4 * o4 + 0) * D + k] = w.x; wabT[(4 * o4 + 1) * D + k] = w.y; wabT[(4 * o4 + 2) * D + k] = w.z; wabT[(4 * o4 + 3) * D + k] = w.w; }
    __syncthreads();
    f32x4 gv[4];
#pragma unroll
    for (int j = 0; j < 4; ++j) gv[j] = *((const f32x4*)gmix + F.lane + 64 * j);
    f32x4 nv[4]; u32x2 na[4], nb[4];
    if (F.gw < M) { const f32x4* xr = (const f32x4*)(xin + (size_t)F.gw * D) + F.lane;
#pragma unroll
        for (int j = 0; j < 4; ++j) nv[j] = xr[64 * j];
        if (layer > 0) { const u32x2* y0 = (const u32x2*)(YS + (size_t)(2 * F.gw) * D) + F.lane; const u32x2* y1 = (const u32x2*)(YS + (size_t)(2 * F.gw + 1) * D) + F.lane;
#pragma unroll
            for (int j = 0; j < 4; ++j) { na[j] = y0[64 * j]; nb[j] = y1[64 * j]; } } }
    for (int m = F.gw; m < M; m += F.NGW) {
        f32x4 v[4]; float s = 0.f; u32x2 ya[4], yb[4];
#pragma unroll
        for (int j = 0; j < 4; ++j) { v[j] = nv[j]; ya[j] = na[j]; yb[j] = nb[j]; }
        if (m + F.NGW < M) { const int mn = m + F.NGW; const f32x4* xr = (const f32x4*)(xin + (size_t)mn * D) + F.lane;
#pragma unroll
            for (int j = 0; j < 4; ++j) nv[j] = xr[64 * j];
            if (layer > 0) { const u32x2* y0 = (const u32x2*)(YS + (size_t)(2 * mn) * D) + F.lane; const u32x2* y1 = (const u32x2*)(YS + (size_t)(2 * mn + 1) * D) + F.lane;
#pragma unroll
                for (int j = 0; j < 4; ++j) { na[j] = y0[64 * j]; nb[j] = y1[64 * j]; } } }
        if (layer > 0) {
#pragma unroll
            for (int j = 0; j < 4; ++j) { const u32x2 a = ya[j], b = yb[j];
                v[j].x += bf2f(a.x & 0xffffu) + bf2f(b.x & 0xffffu); v[j].y += bf2f(a.x >> 16) + bf2f(b.x >> 16);
                v[j].z += bf2f(a.y & 0xffffu) + bf2f(b.y & 0xffffu); v[j].w += bf2f(a.y >> 16) + bf2f(b.y >> 16); }
            f32x4* xo = (f32x4*)(A.out + (size_t)m * D) + F.lane;
#pragma unroll
            for (int j = 0; j < 4; ++j) xo[64 * j] = v[j];
        }
#pragma unroll
        for (int j = 0; j < 4; ++j) s += (v[j].x * v[j].x + v[j].y * v[j].y) + (v[j].z * v[j].z + v[j].w * v[j].w);
        const float rstd = rsqrtf(wave_sum(s) * (1.f / D) + EPS);
        u32x2* ho = (u32x2*)(H + (size_t)m * D) + F.lane;
        float ab[8]; f32x2 ab2[8];
#pragma unroll
        for (int o = 0; o < 8; ++o) ab2[o] = (f32x2){0.f, 0.f};
#pragma unroll
        for (int j = 0; j < 4; ++j) { v[j] = v[j] * rstd * gv[j];
            u32x2 w; w.x = pk2(v[j].x, v[j].y); w.y = pk2(v[j].z, v[j].w); ho[64 * j] = w;
#pragma unroll
            for (int o = 0; o < 8; ++o) { const f32x4 wv = *((const LAS f32x4*)(wabT + o * D) + F.lane + 64 * j); ab2[o] = __builtin_elementwise_fma((f32x2){v[j].x, v[j].y}, (f32x2){wv.x, wv.y}, ab2[o]); ab2[o] = __builtin_elementwise_fma((f32x2){v[j].z, v[j].w}, (f32x2){wv.z, wv.w}, ab2[o]); } }
#pragma unroll
        for (int o = 0; o < 8; ++o) ab[o] = ab2[o].x + ab2[o].y;
        float t8[8]; fold8(ab, t8, F.lane);
        float mine = 0.f;
#pragma unroll
        for (int o = 0; o < 8; ++o) if (F.lane == o) mine = t8[o];
        if (F.lane < 8) AB[(size_t)m * 8 + F.lane] = mine;
    }
}

__device__ __forceinline__ void phase_dn_pre(const Frame& F, const Args& A, int layer) {
    const bf16_t* PROJ = (const bf16_t*)(A.ws + WS_A); float* SCR = (float*)(A.ws + WS_SCR); float* AB = (float*)(A.ws + WS_AB);
    const float* cw = A.in[I_DN_CONV] + (size_t)layer * 4 * 768;
    const float* alog = A.in[I_DN_ALOG] + layer * 4; const float* dtb = A.in[I_DN_DTB] + layer * 4;
    for (int m = F.gw; m < M; m += F.NGW) {
        const int s = m % SEQ;
#pragma unroll
        for (int j = 0; j < 12; ++j) { const int c = F.lane + 64 * j; float y = 0.f;
#pragma unroll
            for (int i = 0; i < 4; ++i) { if (s - 3 + i >= 0) y += cw[i * 768 + c] * bf2f(PROJ[(size_t)(m - 3 + i) * NPROJ + c]); }
            y = siluf(y);
            if (j < 8) { const float ss = wave_sum(y * y); y *= rsqrtf(ss + EPS) * (j < 4 ? 0.125f : 1.f); }
            SCR[(size_t)m * 768 + c] = y; }
        if (F.lane < 8) { const float a = AB[(size_t)m * 8 + F.lane]; float r;
            if (F.lane < 4) { const float x = a + dtb[F.lane]; const float sp = fmaxf(x, 0.f) + log1pf(expf(-fabsf(x))); r = -expf(alog[F.lane]) * sp; }
            else r = sigm(a);
            AB[(size_t)m * 8 + F.lane] = r; }
    }
}
__device__ __forceinline__ void phase_dn_scan_naive(const Frame& F, const Args& A) {
    if (blockIdx.x >= 32) return;
    const float* SCR = (const float*)(A.ws + WS_SCR); const float* AB = (const float*)(A.ws + WS_AB); float* O = (float*)(A.ws + WS_O);
    const int pair = blockIdx.x * 2 + (F.wave >> 2), b = pair >> 2, h = pair & 3;
    const int j = (F.wave & 3) * 16 + (F.lane >> 2), dg = F.lane & 3;
    float S[16];
#pragma unroll
    for (int i = 0; i < 16; ++i) S[i] = 0.f;
    for (int s = 0; s < SEQ; ++s) { const size_t m = (size_t)b * SEQ + s;
        const f32x4* kp = (const f32x4*)(SCR + m * 768 + 256 + h * 64 + dg * 16); const f32x4* qp = (const f32x4*)(SCR + m * 768 + h * 64 + dg * 16);
        const float v = SCR[m * 768 + 512 + h * 64 + j]; const float eg = expf(AB[m * 8 + h]), beta = AB[m * 8 + 4 + h];
        float k[16], q[16];
#pragma unroll
        for (int i = 0; i < 4; ++i) { const f32x4 a = kp[i], c = qp[i]; k[4 * i] = a.x; k[4 * i + 1] = a.y; k[4 * i + 2] = a.z; k[4 * i + 3] = a.w; q[4 * i] = c.x; q[4 * i + 1] = c.y; q[4 * i + 2] = c.z; q[4 * i + 3] = c.w; }
        float ks = 0.f;
#pragma unroll
        for (int i = 0; i < 16; ++i) ks += k[i] * S[i];
        ks += __shfl_xor(ks, 1); ks += __shfl_xor(ks, 2);
        const float c = beta * (v - eg * ks); float o = 0.f;
#pragma unroll
        for (int i = 0; i < 16; ++i) { S[i] = eg * S[i] + k[i] * c; o += q[i] * S[i]; }
        o += __shfl_xor(o, 1); o += __shfl_xor(o, 2);
        if (dg == 0) O[m * 256 + h * 64 + j] = o;
    }
}
__device__ __forceinline__ void phase_dn_gate(const Frame& F, const Args& A, int layer) {
    const bf16_t* PROJ = (const bf16_t*)(A.ws + WS_A); const float* O = (const float*)(A.ws + WS_O); bf16_t* MIXED = (bf16_t*)(A.ws + WS_MIXED);
    const float gn = A.in[I_DN_ONORM][layer * 64 + F.lane];
    for (int idx = F.gw; idx < M * DNH; idx += F.NGW) { const int m = idx >> 2, h = idx & 3;
        const float o = O[(size_t)m * 256 + h * 64 + F.lane]; const float ms = wave_sum(o * o) * (1.f / 64.f);
        const float z = bf2f(PROJ[(size_t)m * NPROJ + C_DZ + h * 64 + F.lane]);
        MIXED[(size_t)m * D + h * 64 + F.lane] = (bf16_t)f2bf(o * rsqrtf(ms + EPS) * gn * siluf(z)); }
}
__device__ __forceinline__ float t5_bias(const float* relb, int h, int dist) {
    int bucket;
    if (dist < 16) bucket = dist;
    else { const int lb = 16 + (int)(logf((float)dist / 16.f) / 4.852030263919617f * 16.f); bucket = lb < 31 ? lb : 31; }
    return relb[bucket * ATH + h];
}
__device__ __forceinline__ void phase_attn_naive(const Frame& F, const Args& A, int layer) {
    const bf16_t* PROJ = (const bf16_t*)(A.ws + WS_A); bf16_t* MIXED = (bf16_t*)(A.ws + WS_MIXED);
    LAS float* qk = (LAS float*)(F.lds + F.wave * 4096); LAS float* pl = qk + 64;
    const float qn = A.in[I_AT_QN][layer * 64 + F.lane], kn = A.in[I_AT_KN][layer * 64 + F.lane];
    const float* relb = A.in[I_RELB];
    const int dil[3] = {1, 4, 16};
    for (int idx = F.gw; idx < M * ATH; idx += F.NGW) { const int m = idx >> 3, h = idx & 7, s = m % SEQ;
        const float qv = bf2f(PROJ[(size_t)m * NPROJ + C_AQ + h * 64 + F.lane]);
        const float qss = wave_sum(qv * qv) * (1.f / 64.f);
        qk[F.lane] = qv * rsqrtf(qss + EPS) * qn * 0.125f * kn;
        LDS_WAIT(); asm volatile("" ::: "memory");
        float sc[9]; float mx = -1e30f;
#pragma unroll
        for (int di = 0; di < 3; ++di)
#pragma unroll
            for (int jb = 0; jb < 3; ++jb) { const int j = jb * 64 + F.lane, p = s - j * dil[di]; float v = -1e30f;
                if (j <= 128 && p >= 0) { const u32x4* kr = (const u32x4*)(PROJ + (size_t)(m - j * dil[di]) * NPROJ + C_AK + h * 64);
                    float dot = 0.f, ss = 0.f;
#pragma unroll
                    for (int c = 0; c < 8; ++c) { const u32x4 w = kr[c]; const unsigned ww[4] = {w.x, w.y, w.z, w.w};
#pragma unroll
                        for (int e = 0; e < 4; ++e) { const float k0 = bf2f(ww[e] & 0xffffu), k1 = bf2f(ww[e] >> 16);
                            dot += k0 * qk[c * 8 + 2 * e] + k1 * qk[c * 8 + 2 * e + 1]; ss += k0 * k0 + k1 * k1; } }
                    v = dot * rsqrtf(ss * (1.f / 64.f) + EPS) + t5_bias(relb, h, dil[di] * j); }
                sc[di * 3 + jb] = v; mx = fmaxf(mx, v); }
        mx = wave_max(mx);
        float sum = 0.f;
#pragma unroll
        for (int i = 0; i < 9; ++i) { const float p = sc[i] > -1e29f ? expf(sc[i] - mx) : 0.f; sum += p; pl[i * 64 + F.lane] = p; }
        sum = wave_sum(sum);
        LDS_WAIT(); asm volatile("" ::: "memory");
        float o = 0.f;
#pragma unroll 1
        for (int di = 0; di < 3; ++di) { const int jmax = (s / dil[di]) < 128 ? (s / dil[di]) : 128;
            for (int j = 0; j <= jmax; ++j) o += pl[(di * 3 + (j >> 6)) * 64 + (j & 63)] * bf2f(PROJ[(size_t)(m - j * dil[di]) * NPROJ + C_AV + h * 64 + F.lane]); }
        MIXED[(size_t)m * D + 256 + h * 64 + F.lane] = (bf16_t)f2bf(o / sum);
        LDS_WAIT(); asm volatile("" ::: "memory");
    }
}


typedef float f32x16 __attribute__((ext_vector_type(16)));
typedef short s16x4 __attribute__((ext_vector_type(4)));
#define MFMA32(a, b, c) __builtin_amdgcn_mfma_f32_32x32x16_bf16((a), (b), (c), 0, 0, 0)
__device__ __forceinline__ int crow(int i, int h) { return (i & 3) + 8 * (i >> 2) + 4 * h; }
__device__ __forceinline__ unsigned cvtpk(float lo, float hi) { return pg8::cvt_pk_bf16(lo, hi); }
__device__ __forceinline__ bf16x8 pack8(const f32x16& x, int s) {
    u32x4 w; w.x = cvtpk(x[8 * s], x[8 * s + 1]); w.y = cvtpk(x[8 * s + 2], x[8 * s + 3]); w.z = cvtpk(x[8 * s + 4], x[8 * s + 5]); w.w = cvtpk(x[8 * s + 6], x[8 * s + 7]);
    return __builtin_bit_cast(bf16x8, w);
}
__device__ __forceinline__ f32x16 zero16() { f32x16 z;
#pragma unroll
    for (int i = 0; i < 16; ++i) z[i] = 0.f;
    return z; }
__device__ __forceinline__ float fsilu(float y) { return y * __builtin_amdgcn_rcpf(1.f + __expf(-y)); }

namespace att {
constexpr int TB_STRIDE = 200, TB_PAD = 32;
constexpr int TB_OFF = RING_BYTES;
constexpr float LOG2E = 1.4426950408889634f;
struct Sub { int b, h, dil, di, res, n; };
__device__ __forceinline__ void build_table(const Frame& F, const float* relb) {
    LAS float* T = (LAS float*)(F.lds + TB_OFF);
    for (int e = F.tid; e < 3 * 8 * TB_STRIDE; e += NTHREADS) { const int di = e / (8 * TB_STRIDE), h = (e / TB_STRIDE) % 8, x = e % TB_STRIDE - TB_PAD; const int rel = 128 - x;
        float v = -1e30f;
        if (rel >= 0 && rel <= 128) { const int dist = rel * (di == 0 ? 1 : di == 1 ? 4 : 16); v = t5_bias(relb, h, dist) * LOG2E; }
        T[e] = v; }
}
struct KV { u32x4 kr[8], vr[8]; bf16x8 qf[4]; };
__device__ __forceinline__ void fetch(const Frame& F, const Args& A, const Sub& sb, KV& R) {
    const bf16_t* PROJ = (const bf16_t*)(A.ws + WS_A);
    const int wq = F.wave & 3, r = F.lane & 31, hh = F.lane >> 5; const size_t tok0 = (size_t)sb.b * SEQ;
    const int ht = F.tid & 255, c = ht & 7; const int kstart = sb.n == 0 ? 128 : 0;
#pragma unroll
    for (int i = 0; i < 8; ++i) { const int kj = (ht >> 3) + 32 * i;
        if (kj >= kstart) { const int p = (sb.n - 1) * 128 + kj; const bf16_t* row = PROJ + (tok0 + (size_t)p * sb.dil + sb.res) * NPROJ + sb.h * 64 + c * 8;
            R.kr[i] = *(const u32x4*)(row + C_AK); R.vr[i] = *(const u32x4*)(row + C_AV); } }
    const int qpos = sb.n * 128 + wq * 32 + r; const size_t mq = tok0 + (size_t)qpos * sb.dil + sb.res;
#pragma unroll
    for (int s = 0; s < 4; ++s) R.qf[s] = *(const bf16x8*)(PROJ + mq * NPROJ + C_AQ + sb.h * 64 + 16 * s + 8 * hh);
}
__device__ __forceinline__ void commit(const Frame& F, const Sub& sb, const KV& R) {
    const int sub = F.wave >> 2; LAS unsigned char* Kb = F.lds + sub * 65536; LAS unsigned char* Vb = Kb + 32768;
    const int ht = F.tid & 255, c = ht & 7; const int kstart = sb.n == 0 ? 128 : 0;
#pragma unroll
    for (int i = 0; i < 8; ++i) { const int kj = (ht >> 3) + 32 * i;
        if (kj >= kstart) { *(LAS u32x4*)(Kb + kj * 128 + ((c ^ ((kj >> 1) & 7)) << 4)) = R.kr[i]; *(LAS u32x4*)(Vb + kj * 128 + ((c ^ (((kj >> 1) & 1) << 2)) << 4)) = R.vr[i]; } }
}
template <bool COMBINE>
__device__ __forceinline__ void compute(const Frame& F, const Args& A, const Sub& sb, const bf16x8 (&qf)[4]) {
    const int sub = F.wave >> 2, wq = F.wave & 3, lane = F.lane, r = lane & 31, hh = lane >> 5;
    LAS unsigned char* Kb = F.lds + sub * 65536; LAS unsigned char* Vb = Kb + 32768;
    const size_t tok0 = (size_t)sb.b * SEQ;
    const int qpos = sb.n * 128 + wq * 32 + r; const size_t mq = tok0 + (size_t)qpos * sb.dil + sb.res;
    const int dmin = sb.n == 0 ? 4 - wq : 0;
    const LAS float* T = (const LAS float*)(F.lds + TB_OFF) + (sb.di * 8 + sb.h) * TB_STRIDE + TB_PAD - r + 4 * hh;
    f32x16 p[5]; float mx = -1e30f;
#pragma unroll
    for (int t = 0; t < 5; ++t) {
        if (t >= dmin) { const int row = (wq + t) * 32 + r; f32x16 acc;
#pragma unroll
            for (int i = 0; i < 16; ++i) acc[i] = 0.f;
#pragma unroll
            for (int s = 0; s < 4; ++s) { const bf16x8 kf = *(const LAS bf16x8*)(Kb + row * 128 + (((2 * s + hh) ^ ((row >> 1) & 7)) << 4));
                acc = __builtin_amdgcn_mfma_f32_32x32x16_bf16(kf, qf[s], acc, 0, 0, 0); }
#pragma unroll
            for (int i = 0; i < 16; ++i) { acc[i] += T[32 * t + (i & 3) + 8 * (i >> 2)]; mx = fmaxf(mx, acc[i]); }
            p[t] = acc; }
    }
    mx = fmaxf(mx, __shfl_xor(mx, 32));
    float l = 0.f;
#pragma unroll
    for (int t = 0; t < 5; ++t) if (t >= dmin) {
#pragma unroll
        for (int i = 0; i < 16; ++i) { const float e = __builtin_amdgcn_exp2f(p[t][i] - mx); p[t][i] = e; l += e; } }
    l += __shfl_xor(l, 32);
    f32x16 o[2];
#pragma unroll
    for (int i = 0; i < 16; ++i) { o[0][i] = 0.f; o[1][i] = 0.f; }
    const int q4 = (lane & 15) >> 2, p4 = lane & 3, blk = (lane >> 4) & 1, sw = (lane >> 3) & 1;
    const int vlane = (4 * hh + q4) * 128 + ((2 * blk + (p4 >> 1)) << 4) + 8 * (p4 & 1);
    const int voff0 = vlane + sw * 64, voff1 = vlane + (1 - sw) * 64;
#pragma unroll
    for (int t = 0; t < 5; ++t) if (t >= dmin) {
#pragma unroll
        for (int s = 0; s < 2; ++s) { const bf16x8 pf = pack8(p[t], s); const int rowb = ((wq + t) * 32 + 16 * s) * 128;
            const s16x4 a0 = __builtin_amdgcn_ds_read_tr16_b64_v4i16((LAS s16x4*)(Vb + rowb + voff0)), a1 = __builtin_amdgcn_ds_read_tr16_b64_v4i16((LAS s16x4*)(Vb + rowb + 1024 + voff0));
            const s16x4 b0 = __builtin_amdgcn_ds_read_tr16_b64_v4i16((LAS s16x4*)(Vb + rowb + voff1)), b1 = __builtin_amdgcn_ds_read_tr16_b64_v4i16((LAS s16x4*)(Vb + rowb + 1024 + voff1));
            const bf16x8 v0 = __builtin_shufflevector(a0, a1, 0, 1, 2, 3, 4, 5, 6, 7), v1 = __builtin_shufflevector(b0, b1, 0, 1, 2, 3, 4, 5, 6, 7);
            o[0] = __builtin_amdgcn_mfma_f32_32x32x16_bf16(v0, pf, o[0], 0, 0, 0);
            o[1] = __builtin_amdgcn_mfma_f32_32x32x16_bf16(v1, pf, o[1], 0, 0, 0); } }
    const float inv = 1.f / l; const float lse2 = mx + __builtin_amdgcn_logf(l);
    if (COMBINE) {
        const bf16_t* O4 = (const bf16_t*)(A.ws + WS_ATTO); const bf16_t* O16 = O4 + (size_t)M * 512; const float* L4 = (const float*)(A.ws + WS_ATTL); const float* L16 = L4 + (size_t)M * 8;
        const float l4 = L4[mq * 8 + sb.h], l16 = L16[mq * 8 + sb.h]; const float mm = fmaxf(lse2, fmaxf(l4, l16));
        const float w1 = __builtin_amdgcn_exp2f(lse2 - mm), w4 = __builtin_amdgcn_exp2f(l4 - mm), w16 = __builtin_amdgcn_exp2f(l16 - mm); const float wi = 1.f / (w1 + w4 + w16);
        const float c1 = w1 * wi * inv, c4 = w4 * wi, c16 = w16 * wi;
        bf16_t* MX = (bf16_t*)(A.ws + WS_MIXED) + mq * D + 256 + sb.h * 64;
#pragma unroll
        for (int dt = 0; dt < 2; ++dt)
#pragma unroll
            for (int g = 0; g < 4; ++g) { const int d = 32 * dt + 8 * g + 4 * hh; const u32x2 a = *(const u32x2*)(O4 + mq * 512 + sb.h * 64 + d), b = *(const u32x2*)(O16 + mq * 512 + sb.h * 64 + d);
                const float y0 = c1 * o[dt][4 * g] + c4 * bf2f(a.x & 0xffffu) + c16 * bf2f(b.x & 0xffffu), y1 = c1 * o[dt][4 * g + 1] + c4 * bf2f(a.x >> 16) + c16 * bf2f(b.x >> 16);
                const float y2 = c1 * o[dt][4 * g + 2] + c4 * bf2f(a.y & 0xffffu) + c16 * bf2f(b.y & 0xffffu), y3 = c1 * o[dt][4 * g + 3] + c4 * bf2f(a.y >> 16) + c16 * bf2f(b.y >> 16);
                u32x2 w; w.x = cvtpk(y0, y1); w.y = cvtpk(y2, y3); *(u32x2*)(MX + d) = w; }
    } else {
        bf16_t* OD = (bf16_t*)(A.ws + WS_ATTO) + (size_t)(sb.di - 1) * M * 512 + mq * 512 + sb.h * 64; float* LD = (float*)(A.ws + WS_ATTL) + (size_t)(sb.di - 1) * M * 8;
#pragma unroll
        for (int dt = 0; dt < 2; ++dt)
#pragma unroll
            for (int g = 0; g < 4; ++g) { const int d = 32 * dt + 8 * g + 4 * hh;
                u32x2 w; w.x = cvtpk(o[dt][4 * g] * inv, o[dt][4 * g + 1] * inv); w.y = cvtpk(o[dt][4 * g + 2] * inv, o[dt][4 * g + 3] * inv); *(u32x2*)(OD + d) = w; }
        if (hh == 0) LD[mq * 8 + sb.h] = lse2;
    }
}
__device__ __forceinline__ Sub decode_a(int bi, int sub) { const int round = bi >> 8, j = bi & 255; Sub sb;
    if (round < 4) { const int id = round * 256 + j, bh = id >> 3, kk = 2 * (id & 7) + sub; sb.b = bh >> 3; sb.h = bh & 7; sb.dil = 4; sb.di = 1; sb.res = kk >> 2; sb.n = kk & 3; }
    else { const int id = (round - 4) * 256 + j, bh = id >> 3, kk = 2 * (id & 7) + sub; sb.b = bh >> 3; sb.h = bh & 7; sb.dil = 16; sb.di = 2; sb.res = kk; sb.n = 0; }
    return sb; }
__device__ __forceinline__ Sub decode_b(int bi, int sub) { const int bh = bi >> 3; Sub sb; sb.b = bh >> 3; sb.h = bh & 7; sb.dil = 1; sb.di = 0; sb.res = 0; sb.n = 2 * (bi & 7) + sub; return sb; }
__device__ __forceinline__ void phase_a(const Frame& F, const Args& A, unsigned* qhead) {
    build_table(F, A.in[I_RELB]);
    volatile LAS unsigned* slot = F.MISC + 16;
    if (F.tid == 0) { slot[0] = __hip_atomic_fetch_add(qhead, 1u, RLX_AGENT); slot[1] = __hip_atomic_fetch_add(qhead, 1u, RLX_AGENT); }
    __syncthreads();
    const int sub = F.wave >> 2;
    int bi = (int)slot[0]; if (bi >= 2048) return;
    Sub cur = decode_a(bi, sub); KV R; fetch(F, A, cur, R); commit(F, cur, R);
    bf16x8 qf[4];
#pragma unroll
    for (int s = 0; s < 4; ++s) qf[s] = R.qf[s];
    __syncthreads();
    for (int k = 0;; ++k) {
        const int nb = (int)slot[(k + 1) & 1]; const bool has_next = nb < 2048; Sub nxt = cur;
        if (has_next) { nxt = decode_a(nb, sub); fetch(F, A, nxt, R); }
        compute<false>(F, A, cur, qf);
        __syncthreads();
        if (F.tid == 0) slot[k & 1] = __hip_atomic_fetch_add(qhead, 1u, RLX_AGENT);
        if (!has_next) break;
        commit(F, nxt, R);
#pragma unroll
        for (int s = 0; s < 4; ++s) qf[s] = R.qf[s];
        __syncthreads();
        cur = nxt;
    }
}
__device__ __forceinline__ void phase_b(const Frame& F, const Args& A) {
    build_table(F, A.in[I_RELB]); __syncthreads();
    const int sub = F.wave >> 2;
    int bi = F.vcu; if (bi >= 1024) return;
    Sub cur = decode_b(bi, sub); KV R; fetch(F, A, cur, R); commit(F, cur, R);
    bf16x8 qf[4];
#pragma unroll
    for (int s = 0; s < 4; ++s) qf[s] = R.qf[s];
    __syncthreads();
    for (;;) {
        const int nb = bi + F.G; const bool has_next = nb < 1024; Sub nxt = cur;
        if (has_next) { nxt = decode_b(nb, sub); fetch(F, A, nxt, R); }
        compute<true>(F, A, cur, qf);
        __syncthreads();
        if (!has_next) break;
        commit(F, nxt, R);
#pragma unroll
        for (int s = 0; s < 4; ++s) qf[s] = R.qf[s];
        __syncthreads();
        cur = nxt; bi = nb;
    }
}
__device__ __forceinline__ void phase_qknorm(const Frame& F, const Args& A, int layer) {
    bf16_t* PROJ = (bf16_t*)(A.ws + WS_A);
    const int d0 = (F.lane & 7) * 8; float qs[8];
#pragma unroll
    for (int e = 0; e < 8; ++e) qs[e] = A.in[I_AT_QN][layer * 64 + d0 + e] * A.in[I_AT_KN][layer * 64 + d0 + e] * 0.125f * LOG2E;
    for (int m = F.gw; m < M; m += F.NGW) { bf16_t* row = PROJ + (size_t)m * NPROJ + C_AQ + F.lane * 8;
#pragma unroll
        for (int part = 0; part < 2; ++part) { u32x4* p = (u32x4*)(row + part * 512); const u32x4 w = *p; const unsigned ww[4] = {w.x, w.y, w.z, w.w}; float v[8]; float ss = 0.f;
#pragma unroll
            for (int e = 0; e < 4; ++e) { v[2 * e] = bf2f(ww[e] & 0xffffu); v[2 * e + 1] = bf2f(ww[e] >> 16); ss += v[2 * e] * v[2 * e] + v[2 * e + 1] * v[2 * e + 1]; }
            ss += __shfl_xor(ss, 1); ss += __shfl_xor(ss, 2); ss += __shfl_xor(ss, 4);
            const float rs = rsqrtf(ss * (1.f / 64.f) + EPS); u32x4 o;
            if (part == 0) { o.x = cvtpk(v[0] * rs * qs[0], v[1] * rs * qs[1]); o.y = cvtpk(v[2] * rs * qs[2], v[3] * rs * qs[3]); o.z = cvtpk(v[4] * rs * qs[4], v[5] * rs * qs[5]); o.w = cvtpk(v[6] * rs * qs[6], v[7] * rs * qs[7]); }
            else { o.x = cvtpk(v[0] * rs, v[1] * rs); o.y = cvtpk(v[2] * rs, v[3] * rs); o.z = cvtpk(v[4] * rs, v[5] * rs); o.w = cvtpk(v[6] * rs, v[7] * rs); }
            *p = o; } }
}
}


namespace dn {
constexpr int BUFB = 67 * 128, WV_SMALL = 1536, WV_BYTES = 2 * BUFB + WV_SMALL;
constexpr int IT_BYTES = 40960, F_W = 0, F_QD = 8, F_QK = 16, F_KD = 22, F_U = 30, GL_OFF = 38912;
static_assert(8 * WV_BYTES <= LDSCTL_OFF, "DN-1 LDS");
__device__ __forceinline__ int sw16(int row, int chunk) { return row * 128 + ((chunk ^ ((row >> 1) & 7)) << 4); }
__device__ __forceinline__ void stage_raw(LAS unsigned char* buf, const bf16_t* colbase  , int n, int lane) {
#pragma unroll
    for (int i = 0; i < 9; ++i) { const int e = lane + 64 * i;
        if (e < 67 * 8) { const int row = e >> 3, c = e & 7, s = n * 64 + row - 3; u32x4 v = {0u, 0u, 0u, 0u};
            if (s >= 0) v = *(const u32x4*)(colbase + (size_t)s * NPROJ + c * 8);
            *(LAS u32x4*)(buf + sw16(row, c)) = v; } }
}
template <bool ROWS, bool TR>
__device__ __forceinline__ float conv64(LAS unsigned char* buf, LAS unsigned char* bufT, const float* cw, int lane) {
    float ss = 0.f;
#pragma unroll 2
    for (int c8 = 0; c8 < 8; ++c8) {
        u32x4 x[4];
#pragma unroll
        for (int tap = 0; tap < 4; ++tap) x[tap] = *(const LAS u32x4*)(buf + sw16(lane + tap, c8));
        unsigned yp[4];
#pragma unroll
        for (int e = 0; e < 4; ++e) { float y0 = 0.f, y1 = 0.f;
#pragma unroll
            for (int tap = 0; tap < 4; ++tap) { const unsigned w = x[tap][e]; y0 += cw[tap * 768 + 8 * c8 + 2 * e] * bf2f(w & 0xffffu); y1 += cw[tap * 768 + 8 * c8 + 2 * e + 1] * bf2f(w >> 16); }
            y0 = fsilu(y0); y1 = fsilu(y1); ss += y0 * y0 + y1 * y1; yp[e] = cvtpk(y0, y1); }
        if (ROWS) *(LAS u32x4*)(buf + sw16(lane, c8)) = (u32x4){yp[0], yp[1], yp[2], yp[3]};
        if (TR) {
#pragma unroll
            for (int e = 0; e < 4; ++e) { *(LAS unsigned short*)(bufT + sw16(8 * c8 + 2 * e, lane >> 3) + (lane & 7) * 2) = (unsigned short)(yp[e] & 0xffffu);
                *(LAS unsigned short*)(bufT + sw16(8 * c8 + 2 * e + 1, lane >> 3) + (lane & 7) * 2) = (unsigned short)(yp[e] >> 16); } } }
    return ss;
}
__device__ __forceinline__ u32x2 rd8(const LAS unsigned char* buf, int row, int e0) { return *(const LAS u32x2*)(buf + sw16(row, e0 >> 3) + (e0 & 4) * 2); }
__device__ __forceinline__ bf16x8 frag_perm(const LAS unsigned char* buf, int row, int ebase, int s, int hh) {
    const u32x2 a = rd8(buf, row, ebase + 16 * s + 4 * hh), b = rd8(buf, row, ebase + 16 * s + 8 + 4 * hh); u32x4 w = {a.x, a.y, b.x, b.y}; return __builtin_bit_cast(bf16x8, w); }
__device__ __forceinline__ bf16x8 frag_perm_scaled(const LAS unsigned char* buf, int row, int ebase, int s, int hh, f32x4 s0, f32x4 s1) {
    const u32x2 a = rd8(buf, row, ebase + 16 * s + 4 * hh), b = rd8(buf, row, ebase + 16 * s + 8 + 4 * hh);
    u32x4 w; w.x = cvtpk(bf2f(a.x & 0xffffu) * s0.x, bf2f(a.x >> 16) * s0.y); w.y = cvtpk(bf2f(a.y & 0xffffu) * s0.z, bf2f(a.y >> 16) * s0.w);
    w.z = cvtpk(bf2f(b.x & 0xffffu) * s1.x, bf2f(b.x >> 16) * s1.y); w.w = cvtpk(bf2f(b.y & 0xffffu) * s1.z, bf2f(b.y >> 16) * s1.w); return __builtin_bit_cast(bf16x8, w); }
__device__ __forceinline__ bf16x8 frag_row(const LAS unsigned char* buf, int row, int s, int hh) { return *(const LAS bf16x8*)(buf + sw16(row, 2 * s + hh)); }
__device__ __forceinline__ void dump(unsigned char* it, int f, int lane, bf16x8 v) { *(bf16x8*)(it + f * 1024 + lane * 16) = v; }
__device__ __forceinline__ void invert32(f32x16 X, f32x16 Y, f32x16& TT, int r, int hh) {
#pragma unroll
    for (int i = 0; i < 16; ++i) { const float id = (crow(i, hh) == r) ? 1.f : 0.f; TT[i] = id + Y[i]; }
#pragma unroll
    for (int lev = 0; lev < 4; ++lev) {
        { const bf16x8 x0 = pack8(X, 0), x1 = pack8(X, 1), y0 = pack8(Y, 0), y1 = pack8(Y, 1);
          f32x16 Xn = MFMA32(y0, x0, zero16()); Xn = MFMA32(y1, x1, Xn);
          if (lev < 3) { f32x16 Yn = MFMA32(x0, y0, zero16()); Yn = MFMA32(x1, y1, Yn); Y = Yn; }
          X = Xn; }
        const bf16x8 n0 = pack8(X, 0), n1 = pack8(X, 1), t0 = pack8(TT, 0), t1 = pack8(TT, 1);
        f32x16 TTn = MFMA32(n0, t0, TT); TTn = MFMA32(n1, t1, TTn);
        TT = TTn;
    }
}
__device__ __forceinline__ f32x16 transpose32(const f32x16& X, LAS float* scr, int r, int hh) {
#pragma unroll
    for (int i = 0; i < 16; ++i) scr[r * 33 + crow(i, hh)] = X[i];
    f32x16 T;
#pragma unroll
    for (int i = 0; i < 16; ++i) T[i] = scr[crow(i, hh) * 33 + r];
    return T;
}
__device__ __forceinline__ void make_xy(const f32x16& kk, const LAS float* Gs, const LAS float* BR, const LAS float* RK, int blk, float Gc, float rkc, float brc, int r, int hh, f32x16& X, f32x16& Y) {
#pragma unroll
    for (int g4 = 0; g4 < 4; ++g4) { const f32x4 Ga = *(const LAS f32x4*)(Gs + blk * 32 + 8 * g4 + 4 * hh), bra = *(const LAS f32x4*)(BR + blk * 32 + 8 * g4 + 4 * hh), rka = *(const LAS f32x4*)(RK + blk * 32 + 8 * g4 + 4 * hh);
#pragma unroll
        for (int e = 0; e < 4; ++e) { const int i = 4 * g4 + e, a = 8 * g4 + 4 * hh + e;
            X[i] = a > r ? -(bra[e] * rkc * __expf(fminf(Ga[e] - Gc, 0.f))) * kk[i] : 0.f;
            Y[i] = r > a ? -(brc * rka[e] * __expf(fminf(Gc - Ga[e], 0.f))) * kk[i] : 0.f; } }
}
__device__ __forceinline__ void dn1_item(LAS unsigned char* wl, const Args& A, int layer, int b, int h, int n, int lane_in) {
    int lane = lane_in; asm volatile("" : "+v"(lane));
    LAS unsigned char* bufX = wl; LAS unsigned char* bufY = wl + BUFB;
    LAS float* Gs = (LAS float*)(wl + 2 * BUFB); LAS float* RK = Gs + 64; LAS float* BR = Gs + 128; LAS float* SW = Gs + 192; LAS float* SB = Gs + 256; LAS float* SK = Gs + 320;
    const bf16_t* PROJ = (const bf16_t*)(A.ws + WS_A) + (size_t)b * SEQ * NPROJ + h * 64;
    const float* cw = A.in[I_DN_CONV] + (size_t)layer * 4 * 768 + h * 64;
    unsigned char* item = A.ws + WS_SCR + (size_t)((b * 4 + h) * 32 + n) * IT_BYTES;
    int r = lane & 31, hh = lane >> 5;
    const size_t m = (size_t)b * SEQ + n * 64 + lane;
    stage_raw(bufX, PROJ + C_DK, n, lane);
    stage_raw(bufY, PROJ + C_DQ, n, lane);
    const float ssk = conv64<true, false>(bufX, bufX, cw + 256, lane);
    const float rk = rsqrtf(ssk + EPS);
    const float* AB = (const float*)(A.ws + WS_AB);
    const float av = AB[m * 8 + h], bv = AB[m * 8 + 4 + h];
    float g; { const float x = av + A.in[I_DN_DTB][layer * 4 + h]; const float sp = fmaxf(x, 0.f) + log1pf(expf(-fabsf(x))); g = -expf(A.in[I_DN_ALOG][layer * 4 + h]) * sp; }
    const float beta = 1.f / (1.f + expf(-bv));
    float G = g;
#pragma unroll
    for (int o = 1; o < 64; o <<= 1) { const float t = __shfl_up(G, o); if (lane >= o) G += t; }
    const float Glast = __shfl(G, 63);
    Gs[lane] = G; RK[lane] = rk; BR[lane] = beta * rk; SW[lane] = beta * rk * expf(G); SB[lane] = beta; SK[lane] = rk * expf(Glast - G);
    const float ssq = conv64<true, false>(bufY, bufY, cw, lane);
    const float rqe = rsqrtf(ssq + EPS) * 0.125f;
    const float Gc0 = __shfl(G, r), Gc1 = __shfl(G, 32 + r), rkc0 = __shfl(rk, r), rkc1 = __shfl(rk, 32 + r);
    const float brc0 = __shfl(beta * rk, r), brc1 = __shfl(beta * rk, 32 + r), rqc0 = __shfl(rqe, r), rqc1 = __shfl(rqe, 32 + r);
    __builtin_amdgcn_sched_barrier(0); asm volatile("" : "+v"(lane)); r = lane & 31; hh = lane >> 5;
#pragma unroll
    for (int tile = 0; tile < 3; ++tile) { const int jt = tile == 2 ? 1 : 0, it = tile == 0 ? 0 : 1;
        f32x16 acc = zero16();
#pragma unroll
        for (int s = 0; s < 4; ++s) acc = MFMA32(frag_row(bufX, jt * 32 + r, s, hh), frag_row(bufY, it * 32 + r, s, hh), acc);
        const float Gi = it ? Gc1 : Gc0, rqi = it ? rqc1 : rqc0;
#pragma unroll
        for (int g4 = 0; g4 < 4; ++g4) { const f32x4 Gj = *(const LAS f32x4*)(Gs + jt * 32 + 8 * g4 + 4 * hh), rkj = *(const LAS f32x4*)(RK + jt * 32 + 8 * g4 + 4 * hh);
#pragma unroll
            for (int e = 0; e < 4; ++e) { const int i = 4 * g4 + e; const int jrow = 8 * g4 + 4 * hh + e;
                const float v = rqi * rkj[e] * __expf(fminf(Gi - Gj[e], 0.f)) * acc[i];
                acc[i] = (tile == 1 || r >= jrow) ? v : 0.f; } }
        dump(item, F_QK + tile * 2, lane, pack8(acc, 0)); dump(item, F_QK + tile * 2 + 1, lane, pack8(acc, 1)); }
    __builtin_amdgcn_sched_barrier(0); asm volatile("" : "+v"(lane)); r = lane & 31; hh = lane >> 5;
#pragma unroll
    for (int it = 0; it < 2; ++it) { const float sc = (it ? rqc1 : rqc0) * __expf(it ? Gc1 : Gc0); const f32x4 s4 = {sc, sc, sc, sc};
#pragma unroll
        for (int dkt = 0; dkt < 2; ++dkt)
#pragma unroll
            for (int s = 0; s < 2; ++s) dump(item, F_QD + it * 4 + dkt * 2 + s, lane, frag_perm_scaled(bufY, it * 32 + r, dkt * 32, s, hh, s4, s4)); }
    __builtin_amdgcn_sched_barrier(0); asm volatile("" : "+v"(lane)); r = lane & 31; hh = lane >> 5;
    f32x16 TT1, TT2, TT21;
    {
        { f32x16 kk = zero16();
#pragma unroll
          for (int s = 0; s < 4; ++s) { const bf16x8 f = frag_row(bufX, r, s, hh); kk = MFMA32(f, f, kk); }
          f32x16 X, Y; make_xy(kk, Gs, BR, RK, 0, Gc0, rkc0, brc0, r, hh, X, Y);
          invert32(X, Y, TT1, r, hh); }
        __builtin_amdgcn_sched_barrier(0); asm volatile("" : "+v"(lane)); r = lane & 31; hh = lane >> 5;
        { f32x16 kk = zero16();
#pragma unroll
          for (int s = 0; s < 4; ++s) { const bf16x8 f = frag_row(bufX, 32 + r, s, hh); kk = MFMA32(f, f, kk); }
          f32x16 X, Y; make_xy(kk, Gs, BR, RK, 1, Gc1, rkc1, brc1, r, hh, X, Y);
          invert32(X, Y, TT2, r, hh); }
        __builtin_amdgcn_sched_barrier(0); asm volatile("" : "+v"(lane)); r = lane & 31; hh = lane >> 5;
        f32x16 kk = zero16();
#pragma unroll
        for (int s = 0; s < 4; ++s) kk = MFMA32(frag_row(bufX, 32 + r, s, hh), frag_row(bufX, r, s, hh), kk);
#pragma unroll
        for (int g4 = 0; g4 < 4; ++g4) { const f32x4 Ga = *(const LAS f32x4*)(Gs + 32 + 8 * g4 + 4 * hh), bra = *(const LAS f32x4*)(BR + 32 + 8 * g4 + 4 * hh);
#pragma unroll
            for (int e = 0; e < 4; ++e) { const int i = 4 * g4 + e; kk[i] = (bra[e] * rkc0 * __expf(fminf(Ga[e] - Gc0, 0.f))) * kk[i]; } }
        f32x16 Q1 = MFMA32(pack8(kk, 0), pack8(TT2, 0), zero16()); Q1 = MFMA32(pack8(kk, 1), pack8(TT2, 1), Q1);
        const f32x16 T1 = transpose32(TT1, (LAS float*)bufY, r, hh);
        f32x16 P = MFMA32(pack8(T1, 0), pack8(Q1, 0), zero16()); P = MFMA32(pack8(T1, 1), pack8(Q1, 1), P);
#pragma unroll
        for (int i = 0; i < 16; ++i) TT21[i] = -P[i];
    }
    __builtin_amdgcn_sched_barrier(0); asm volatile("" : "+v"(lane)); r = lane & 31; hh = lane >> 5;
    stage_raw(bufX, PROJ + C_DK, n, lane);
    (void)conv64<false, true>(bufX, bufY, cw + 256, lane);
    __builtin_amdgcn_sched_barrier(0); asm volatile("" : "+v"(lane)); r = lane & 31; hh = lane >> 5;
#pragma unroll
    for (int dkt = 0; dkt < 2; ++dkt)
#pragma unroll
        for (int tt = 0; tt < 2; ++tt)
#pragma unroll
            for (int s = 0; s < 2; ++s) { const f32x4 s0 = *(const LAS f32x4*)(SK + tt * 32 + 16 * s + 4 * hh), s1 = *(const LAS f32x4*)(SK + tt * 32 + 16 * s + 8 + 4 * hh);
                dump(item, F_KD + dkt * 4 + tt * 2 + s, lane, frag_perm_scaled(bufY, dkt * 32 + r, tt * 32, s, hh, s0, s1)); }

    __builtin_amdgcn_sched_barrier(0); asm volatile("" : "+v"(lane)); r = lane & 31; hh = lane >> 5;
    {
        bf16x8 wB[3][2];
#pragma unroll
        for (int tile = 0; tile < 3; ++tile) { const int jt = tile == 2 ? 1 : 0; const f32x16& TTx = tile == 0 ? TT1 : tile == 1 ? TT21 : TT2; f32x16 a;
#pragma unroll
            for (int g4 = 0; g4 < 4; ++g4) { const f32x4 sw = *(const LAS f32x4*)(SW + jt * 32 + 8 * g4 + 4 * hh);
#pragma unroll
                for (int e = 0; e < 4; ++e) a[4 * g4 + e] = TTx[4 * g4 + e] * sw[e]; }
            wB[tile][0] = pack8(a, 0); wB[tile][1] = pack8(a, 1); }
#pragma unroll
        for (int dkt = 0; dkt < 2; ++dkt) {
            const bf16x8 x00 = frag_perm(bufY, dkt * 32 + r, 0, 0, hh), x01 = frag_perm(bufY, dkt * 32 + r, 0, 1, hh), x10 = frag_perm(bufY, dkt * 32 + r, 32, 0, hh), x11 = frag_perm(bufY, dkt * 32 + r, 32, 1, hh);
            f32x16 w0 = MFMA32(x00, wB[0][0], zero16()); w0 = MFMA32(x01, wB[0][1], w0);
            f32x16 w1 = MFMA32(x00, wB[1][0], zero16()); w1 = MFMA32(x01, wB[1][1], w1); w1 = MFMA32(x10, wB[2][0], w1); w1 = MFMA32(x11, wB[2][1], w1);
#pragma unroll
            for (int i = 0; i < 16; ++i) { w0[i] = -w0[i]; w1[i] = -w1[i]; }
            dump(item, F_W + 0 * 4 + dkt * 2 + 0, lane, pack8(w0, 0)); dump(item, F_W + 0 * 4 + dkt * 2 + 1, lane, pack8(w0, 1));
            dump(item, F_W + 1 * 4 + dkt * 2 + 0, lane, pack8(w1, 0)); dump(item, F_W + 1 * 4 + dkt * 2 + 1, lane, pack8(w1, 1)); }
    }
    __builtin_amdgcn_sched_barrier(0); asm volatile("" : "+v"(lane)); r = lane & 31; hh = lane >> 5;
    stage_raw(bufX, PROJ + C_DV, n, lane);
    (void)conv64<false, true>(bufX, bufY, cw + 512, lane);
    __builtin_amdgcn_sched_barrier(0); asm volatile("" : "+v"(lane)); r = lane & 31; hh = lane >> 5;
    {
        bf16x8 uA[3][2];
#pragma unroll
        for (int tile = 0; tile < 3; ++tile) { const int jt = tile == 2 ? 1 : 0; const f32x16& TTx = tile == 0 ? TT1 : tile == 1 ? TT21 : TT2; f32x16 c;
#pragma unroll
            for (int g4 = 0; g4 < 4; ++g4) { const f32x4 sb = *(const LAS f32x4*)(SB + jt * 32 + 8 * g4 + 4 * hh);
#pragma unroll
                for (int e = 0; e < 4; ++e) c[4 * g4 + e] = TTx[4 * g4 + e] * sb[e]; }
            uA[tile][0] = pack8(c, 0); uA[tile][1] = pack8(c, 1); }
#pragma unroll
        for (int dvt = 0; dvt < 2; ++dvt) {
            const bf16x8 v00 = frag_perm(bufY, dvt * 32 + r, 0, 0, hh), v01 = frag_perm(bufY, dvt * 32 + r, 0, 1, hh), v10 = frag_perm(bufY, dvt * 32 + r, 32, 0, hh), v11 = frag_perm(bufY, dvt * 32 + r, 32, 1, hh);
            f32x16 u0 = MFMA32(uA[0][0], v00, zero16()); u0 = MFMA32(uA[0][1], v01, u0);
            f32x16 u1 = MFMA32(uA[1][0], v00, zero16()); u1 = MFMA32(uA[1][1], v01, u1); u1 = MFMA32(uA[2][0], v10, u1); u1 = MFMA32(uA[2][1], v11, u1);
            *(bf16x8*)(item + (F_U + 2 * (0 * 2 + dvt)) * 1024 + lane * 32) = pack8(u0, 0); *(bf16x8*)(item + (F_U + 2 * (0 * 2 + dvt)) * 1024 + lane * 32 + 16) = pack8(u0, 1);
            *(bf16x8*)(item + (F_U + 2 * (1 * 2 + dvt)) * 1024 + lane * 32) = pack8(u1, 0); *(bf16x8*)(item + (F_U + 2 * (1 * 2 + dvt)) * 1024 + lane * 32 + 16) = pack8(u1, 1); }
    }
    if (lane == 0) *(float*)(item + GL_OFF) = expf(Glast);
}
__device__ __forceinline__ void phase1(const Frame& F, const Args& A, int layer) {
    LAS unsigned char* wl = F.lds + F.wave * WV_BYTES;
    for (int it = F.gw; it < BATCH * 32 * DNH; it += F.NGW) { const int h = it & 3, cg = it >> 2; dn1_item(wl, A, layer, cg >> 5, h, cg & 31, F.lane); }
}
constexpr int SC_FRAG = 0, SC_FRAGB = 39936, SC_O = 2 * SC_FRAGB, SC_OB = 64 * 68 * 4;
static_assert(SC_O + 2 * SC_OB <= LDSCTL_OFF, "scan LDS");
struct ScanRegs { u32x4 v[19]; float gl; };
__device__ __forceinline__ void scan_fetch(ScanRegs& R, const unsigned char* item, int t128) {
#pragma unroll
    for (int i = 0; i < 19; ++i) R.v[i] = *(const u32x4*)(item + (t128 + 128 * i) * 16);
    R.gl = *(const float*)(item + GL_OFF);
}
__device__ __forceinline__ void scan_put(const ScanRegs& R, LAS unsigned char* dst, int t128) {
#pragma unroll
    for (int i = 0; i < 19; ++i) *(LAS u32x4*)(dst + (t128 + 128 * i) * 16) = R.v[i];
    if (t128 == 0) *(LAS float*)(dst + GL_OFF) = R.gl;
}
struct GateZ { u32x4 z0, z1; };
__device__ __forceinline__ void gate_fetch(GateZ& Z, const Args& A, int b, int h, int c, int gwv, int lane) {
    const int row = gwv * 16 + (lane >> 2), dq = lane & 3; const size_t m = (size_t)b * SEQ + c * 64 + row;
    const bf16_t* zp = (const bf16_t*)(A.ws + WS_A) + m * NPROJ + C_DZ + h * 64 + dq * 16; Z.z0 = *(const u32x4*)zp; Z.z1 = *(const u32x4*)(zp + 8);
}
__device__ __forceinline__ void gate_rows(const LAS unsigned char* ob, const Args& A, int layer, int b, int h, int c, int gwv, int lane, const GateZ& Z) {
    const int row = gwv * 16 + (lane >> 2), dq = lane & 3; const size_t m = (size_t)b * SEQ + c * 64 + row;
    const LAS f32x4* op = (const LAS f32x4*)(ob + (row * 68 + dq * 16) * 4);
    f32x4 o4[4]; float ss = 0.f;
#pragma unroll
    for (int k = 0; k < 4; ++k) { o4[k] = op[k]; ss += (o4[k].x * o4[k].x + o4[k].y * o4[k].y) + (o4[k].z * o4[k].z + o4[k].w * o4[k].w); }
    ss += __shfl_xor(ss, 1); ss += __shfl_xor(ss, 2);
    const float rs = rsqrtf(ss * (1.f / 64.f) + EPS);
    const float* gn = A.in[I_DN_ONORM] + layer * 64 + dq * 16;
    const unsigned zz[8] = {Z.z0.x, Z.z0.y, Z.z0.z, Z.z0.w, Z.z1.x, Z.z1.y, Z.z1.z, Z.z1.w};
    unsigned out[8];
#pragma unroll
    for (int k = 0; k < 8; ++k) { const float a = o4[k >> 1][(k & 1) * 2] * rs * gn[2 * k] * fsilu(bf2f(zz[k] & 0xffffu)), c2 = o4[k >> 1][(k & 1) * 2 + 1] * rs * gn[2 * k + 1] * fsilu(bf2f(zz[k] >> 16)); out[k] = cvtpk(a, c2); }
    bf16_t* mp = (bf16_t*)(A.ws + WS_MIXED) + m * D + h * 64 + dq * 16;
    *(u32x4*)mp = (u32x4){out[0], out[1], out[2], out[3]}; *(u32x4*)(mp + 8) = (u32x4){out[4], out[5], out[6], out[7]};
}
__device__ __forceinline__ void scan(const Frame& F, const Args& A, int layer, int pair) {
    const int b = pair >> 2, h = pair & 3, lane = F.lane, r = lane & 31, hh = lane >> 5, wv = F.wave;
    const unsigned char* items = A.ws + WS_SCR + (size_t)(pair * 32) * IT_BYTES;
    if (wv == 4 || wv == 5) {
        ScanRegs SR; const int t128 = (wv - 4) * 64 + lane;
        scan_fetch(SR, items, t128); scan_put(SR, F.lds + SC_FRAG, t128); scan_fetch(SR, items + IT_BYTES, t128);
        __syncthreads();
        for (int c = 0; c < 32; ++c) {
            if (c + 1 < 32) { scan_put(SR, F.lds + SC_FRAG + ((c + 1) & 1) * SC_FRAGB, t128); if (c + 2 < 32) scan_fetch(SR, items + (size_t)(c + 2) * IT_BYTES, t128); }
            __syncthreads(); }
        __syncthreads();
    } else if (wv >= 2) {
        const int gwv = wv < 4 ? wv - 2 : wv - 4;
        GateZ Z; gate_fetch(Z, A, b, h, 0, gwv, lane);
        __syncthreads();
        for (int c = 0; c < 32; ++c) { if (c > 0) { const GateZ Zc = Z; gate_fetch(Z, A, b, h, c, gwv, lane); gate_rows(F.lds + SC_O + ((c - 1) & 1) * SC_OB, A, layer, b, h, c - 1, gwv, lane, Zc); } __syncthreads(); }
        gate_rows(F.lds + SC_O + (31 & 1) * SC_OB, A, layer, b, h, 31, gwv, lane, Z);
        __syncthreads();
    } else {
        const int dvt = wv;
        f32x16 st[2]; st[0] = zero16(); st[1] = zero16();
        __syncthreads();
        for (int c = 0; c < 32; ++c) {
            const LAS unsigned char* fb = F.lds + SC_FRAG + (c & 1) * SC_FRAGB; LAS unsigned char* ob = F.lds + SC_O + (c & 1) * SC_OB;
            bf16x8 sB[2][2];
#pragma unroll
            for (int dkt = 0; dkt < 2; ++dkt) { sB[dkt][0] = pack8(st[dkt], 0); sB[dkt][1] = pack8(st[dkt], 1); }
            f32x16 vn[2], o[2];
#pragma unroll
            for (int it = 0; it < 2; ++it) { const LAS u32x4* up = (const LAS u32x4*)(fb + (F_U + 2 * (it * 2 + dvt)) * 1024 + lane * 32); const u32x4 a = up[0], c2 = up[1];
                const unsigned uu[8] = {a.x, a.y, a.z, a.w, c2.x, c2.y, c2.z, c2.w};
#pragma unroll
                for (int k = 0; k < 8; ++k) { vn[it][2 * k] = bf2f(uu[k] & 0xffffu); vn[it][2 * k + 1] = bf2f(uu[k] >> 16); }
                o[it] = zero16();
#pragma unroll
                for (int dkt = 0; dkt < 2; ++dkt)
#pragma unroll
                    for (int s = 0; s < 2; ++s) { vn[it] = MFMA32(*(const LAS bf16x8*)(fb + (F_W + it * 4 + dkt * 2 + s) * 1024 + lane * 16), sB[dkt][s], vn[it]);
                        o[it] = MFMA32(*(const LAS bf16x8*)(fb + (F_QD + it * 4 + dkt * 2 + s) * 1024 + lane * 16), sB[dkt][s], o[it]); } }
            bf16x8 vB[2][2];
#pragma unroll
            for (int tt = 0; tt < 2; ++tt) { vB[tt][0] = pack8(vn[tt], 0); vB[tt][1] = pack8(vn[tt], 1); }
#pragma unroll
            for (int s = 0; s < 2; ++s) { o[0] = MFMA32(*(const LAS bf16x8*)(fb + (F_QK + 0 + s) * 1024 + lane * 16), vB[0][s], o[0]);
                o[1] = MFMA32(*(const LAS bf16x8*)(fb + (F_QK + 2 + s) * 1024 + lane * 16), vB[0][s], o[1]);
                o[1] = MFMA32(*(const LAS bf16x8*)(fb + (F_QK + 4 + s) * 1024 + lane * 16), vB[1][s], o[1]); }
            const float gl = *(const LAS float*)(fb + GL_OFF);
#pragma unroll
            for (int dkt = 0; dkt < 2; ++dkt) {
#pragma unroll
                for (int i = 0; i < 16; ++i) st[dkt][i] *= gl;
#pragma unroll
                for (int tt = 0; tt < 2; ++tt)
#pragma unroll
                    for (int s = 0; s < 2; ++s) st[dkt] = MFMA32(*(const LAS bf16x8*)(fb + (F_KD + dkt * 4 + tt * 2 + s) * 1024 + lane * 16), vB[tt][s], st[dkt]); }
#pragma unroll
            for (int it = 0; it < 2; ++it)
#pragma unroll
                for (int i = 0; i < 16; ++i) *(LAS float*)(ob + ((it * 32 + crow(i, hh)) * 68 + dvt * 32 + r) * 4) = o[it][i];
            __syncthreads();
        }
        __syncthreads();
    }
}
}


namespace cv {
constexpr int TT = 128, ROWS = TT + 30;
__device__ __forceinline__ void tile(const Frame& F, const Args& A, int layer, int tidx) {
    const bf16_t* PROJ = (const bf16_t*)(A.ws + WS_A); bf16_t* MIXED = (bf16_t*)(A.ws + WS_MIXED);
    const int m0 = tidx * TT, s0 = m0 % SEQ, lane = F.lane;
    for (int rho = F.wave; rho < ROWS; rho += NWAVES) { u32x2 y = {0u, 0u};
        if (s0 - 30 + rho >= 0) { const bf16_t* row = PROJ + (size_t)(m0 - 30 + rho) * NPROJ; const u32x2 a = *((const u32x2*)(row + C_CU) + lane), g = *((const u32x2*)(row + C_CG) + lane);
            y.x = cvtpk(bf2f(a.x & 0xffffu) * __builtin_amdgcn_rcpf(1.f + __expf(-bf2f(g.x & 0xffffu))), bf2f(a.x >> 16) * __builtin_amdgcn_rcpf(1.f + __expf(-bf2f(g.x >> 16))));
            y.y = cvtpk(bf2f(a.y & 0xffffu) * __builtin_amdgcn_rcpf(1.f + __expf(-bf2f(g.y & 0xffffu))), bf2f(a.y >> 16) * __builtin_amdgcn_rcpf(1.f + __expf(-bf2f(g.y >> 16)))); }
        *(LAS u32x2*)(F.lds + rho * 512 + lane * 8) = y; }
    const float* dw = A.in[I_CV_DW] + (size_t)layer * CVK * CVW;
    LAS f32x4* wl = (LAS f32x4*)(F.lds + ROWS * 512);
    for (int i = F.tid; i < CVK * 64; i += NTHREADS) wl[i] = *((const f32x4*)dw + i);
    const f32x4 bias = *((const f32x4*)(A.in[I_CV_DWB] + layer * CVW) + lane), lg = *((const f32x4*)(A.in[I_CV_LNG] + layer * CVW) + lane), lb = *((const f32x4*)(A.in[I_CV_LNB] + layer * CVW) + lane);
    __syncthreads();
#pragma unroll 1
    for (int k = 0; k < TT / NWAVES; ++k) { const int tau = F.wave * (TT / NWAVES) + k; f32x4 acc = bias;
#pragma unroll
        for (int i = 0; i < CVK; ++i) { const u32x2 y = *(const LAS u32x2*)(F.lds + (tau + i) * 512 + lane * 8); const f32x4 w = wl[i * 64 + lane];
            acc.x += w.x * bf2f(y.x & 0xffffu); acc.y += w.y * bf2f(y.x >> 16); acc.z += w.z * bf2f(y.y & 0xffffu); acc.w += w.w * bf2f(y.y >> 16); }
        const float mean = wave_sum((acc.x + acc.y) + (acc.z + acc.w)) * (1.f / CVW);
        const f32x4 d = acc - mean; const float var = wave_sum((d.x * d.x + d.y * d.y) + (d.z * d.z + d.w * d.w)) * (1.f / CVW);
        const float rs = rsqrtf(var + EPS); const f32x4 yv = d * rs * lg + lb;
        u32x2 o; o.x = cvtpk(fsilu(yv.x), fsilu(yv.y)); o.y = cvtpk(fsilu(yv.z), fsilu(yv.w));
        *((u32x2*)(MIXED + (size_t)(m0 + tau) * D + 768) + lane) = o; }
    __syncthreads();
}
__device__ __forceinline__ void phase(const Frame& F, const Args& A, int layer) { for (int t = F.vcu; t < M / TT; t += F.G) tile(F, A, layer, t); }
}

__device__ __forceinline__ void phase_conf_naive(const Frame& F, const Args& A, int layer) {
    const bf16_t* PROJ = (const bf16_t*)(A.ws + WS_A); bf16_t* MIXED = (bf16_t*)(A.ws + WS_MIXED);
    const float* dw = A.in[I_CV_DW] + (size_t)layer * CVK * CVW;
    const f32x4 bias = *((const f32x4*)(A.in[I_CV_DWB] + layer * CVW) + F.lane), lg = *((const f32x4*)(A.in[I_CV_LNG] + layer * CVW) + F.lane), lb = *((const f32x4*)(A.in[I_CV_LNB] + layer * CVW) + F.lane);
    for (int m = F.gw; m < M; m += F.NGW) { const int s = m % SEQ;
        f32x4 acc = bias;
#pragma unroll 1
        for (int i = 0; i < CVK; ++i) { if (s - 30 + i < 0) continue;
            const u32x2 a = *((const u32x2*)(PROJ + (size_t)(m - 30 + i) * NPROJ + C_CU) + F.lane), g = *((const u32x2*)(PROJ + (size_t)(m - 30 + i) * NPROJ + C_CG) + F.lane);
            const f32x4 w = *((const f32x4*)(dw + i * CVW) + F.lane);
            acc.x += w.x * bf2f(a.x & 0xffffu) * sigm(bf2f(g.x & 0xffffu)); acc.y += w.y * bf2f(a.x >> 16) * sigm(bf2f(g.x >> 16));
            acc.z += w.z * bf2f(a.y & 0xffffu) * sigm(bf2f(g.y & 0xffffu)); acc.w += w.w * bf2f(a.y >> 16) * sigm(bf2f(g.y >> 16)); }
        const float mean = wave_sum((acc.x + acc.y) + (acc.z + acc.w)) * (1.f / CVW);
        const f32x4 d = acc - mean; const float var = wave_sum((d.x * d.x + d.y * d.y) + (d.z * d.z + d.w * d.w)) * (1.f / CVW);
        const float rs = rsqrtf(var + EPS); f32x4 y = d * rs * lg + lb;
        u32x2 w; w.x = pk2(siluf(y.x), siluf(y.y)); w.y = pk2(siluf(y.z), siluf(y.w));
        *((u32x2*)(MIXED + (size_t)m * D + 768) + F.lane) = w;
    }
}
__device__ __forceinline__ void phase_p4(const Frame& F, const Args& A, int layer) {
    unsigned char* ws = A.ws;
    const float* gffn = A.in[I_NORM_FFN] + layer * D;
    const float* rgw = A.in[I_RG_W] + (size_t)layer * D * NGRP; const float* rgb = A.in[I_RG_B] + layer * NGRP;
    const float* rew = A.in[I_RE_W] + (size_t)layer * D * NE; const float* reb = A.in[I_RE_B] + layer * NE;
    bf16_t* H = (bf16_t*)(ws + WS_H); int* ltok = (int*)(ws + WS_LTOK); float* lgate = (float*)(ws + WS_LGATE);
    unsigned* cnt = F.ctl + CW_CNT + layer * NE * 16;
    LAS float* wgT = (LAS float*)F.lds; LAS float* weT = wgT + 4 * D;
    for (int idx = F.tid; idx < D; idx += NTHREADS) { const f32x4 w = *(const f32x4*)(rgw + (size_t)idx * NGRP); wgT[idx] = w.x; wgT[D + idx] = w.y; wgT[2 * D + idx] = w.z; wgT[3 * D + idx] = w.w; }
    for (int idx = F.tid; idx < D * 8; idx += NTHREADS) { const int k = idx & (D - 1), o4 = idx >> 10; const f32x4 w = *(const f32x4*)(rew + (size_t)k * NE + 4 * o4);
        weT[(4 * o4 + 0) * D + k] = w.x; weT[(4 * o4 + 1) * D + k] = w.y; weT[(4 * o4 + 2) * D + k] = w.z; weT[(4 * o4 + 3) * D + k] = w.w; }
    __syncthreads();
    f32x4 gv[4];
#pragma unroll
    for (int j = 0; j < 4; ++j) gv[j] = *((const f32x4*)gffn + F.lane + 64 * j);
    bool have_prev = false; int pe = 0, ptok = 0; unsigned ppos = 0u; float pg = 0.f;
    const float* xres = layer == 0 ? A.in[I_X] : A.out;
    f32x4 nv[4]; u32x2 nd[4];
    if (F.gw < M) { const f32x4* xr = (const f32x4*)(xres + (size_t)F.gw * D) + F.lane; const u32x2* dr = (const u32x2*)(H + (size_t)F.gw * D) + F.lane;
#pragma unroll
        for (int j = 0; j < 4; ++j) { nv[j] = xr[64 * j]; nd[j] = dr[64 * j]; } }
    for (int m = F.gw; m < M; m += F.NGW) {
        f32x4 v[4]; float s = 0.f;
#pragma unroll
        for (int j = 0; j < 4; ++j) { v[j] = nv[j]; v[j].x += bf2f(nd[j].x & 0xffffu); v[j].y += bf2f(nd[j].x >> 16); v[j].z += bf2f(nd[j].y & 0xffffu); v[j].w += bf2f(nd[j].y >> 16);
            s += (v[j].x * v[j].x + v[j].y * v[j].y) + (v[j].z * v[j].z + v[j].w * v[j].w); }
        { f32x4* xo = (f32x4*)(A.out + (size_t)m * D) + F.lane;
#pragma unroll
          for (int j = 0; j < 4; ++j) xo[64 * j] = v[j]; }
        { const int mn = (m + F.NGW < M) ? m + F.NGW : m; const f32x4* xr = (const f32x4*)(xres + (size_t)mn * D) + F.lane; const u32x2* dr = (const u32x2*)(H + (size_t)mn * D) + F.lane;
#pragma unroll
          for (int j = 0; j < 4; ++j) { nv[j] = xr[64 * j]; nd[j] = dr[64 * j]; } }
        const float rstd = rsqrtf(wave_sum(s) * (1.f / D) + EPS);
        u32x2* ho = (u32x2*)(H + (size_t)m * D) + F.lane;
        float gl[4]; f32x2 gl2[4] = {{0.f, 0.f}, {0.f, 0.f}, {0.f, 0.f}, {0.f, 0.f}};
#pragma unroll
        for (int j = 0; j < 4; ++j) { v[j] = v[j] * rstd * gv[j];
            u32x2 w; w.x = pk2(v[j].x, v[j].y); w.y = pk2(v[j].z, v[j].w); ho[64 * j] = w;
#pragma unroll
            for (int o = 0; o < 4; ++o) { const f32x4 wv = *((const LAS f32x4*)(wgT + o * D) + F.lane + 64 * j); gl2[o] = __builtin_elementwise_fma((f32x2){v[j].x, v[j].y}, (f32x2){wv.x, wv.y}, gl2[o]); gl2[o] = __builtin_elementwise_fma((f32x2){v[j].z, v[j].w}, (f32x2){wv.z, wv.w}, gl2[o]); } }
#pragma unroll
        for (int o = 0; o < 4; ++o) gl[o] = gl2[o].x + gl2[o].y;
        { float t[4]; fold4(gl, t, F.lane);
#pragma unroll
          for (int o = 0; o < 4; ++o) gl[o] = t[o] + rgb[o]; }
        int gs = 0; float gm = gl[0];
#pragma unroll
        for (int o = 1; o < 4; ++o) if (gl[o] > gm) { gm = gl[o]; gs = o; }
        float den = 0.f;
#pragma unroll
        for (int o = 0; o < 4; ++o) den += __expf(gl[o] - gm);
        const float pgrp = 1.f / den;
        float el[8]; f32x2 el2[8];
#pragma unroll
        for (int o = 0; o < 8; ++o) el2[o] = (f32x2){0.f, 0.f};
        const LAS float* wsel = weT + gs * EPG * D;
#pragma unroll
        for (int j = 0; j < 4; ++j)
#pragma unroll
            for (int o = 0; o < 8; ++o) { const f32x4 wv = *((const LAS f32x4*)(wsel + o * D) + F.lane + 64 * j); el2[o] = __builtin_elementwise_fma((f32x2){v[j].x, v[j].y}, (f32x2){wv.x, wv.y}, el2[o]); el2[o] = __builtin_elementwise_fma((f32x2){v[j].z, v[j].w}, (f32x2){wv.z, wv.w}, el2[o]); }
#pragma unroll
        for (int o = 0; o < 8; ++o) el[o] = el2[o].x + el2[o].y;
        { float t[8]; fold8(el, t, F.lane);
#pragma unroll
          for (int o = 0; o < 8; ++o) el[o] = t[o] + reb[gs * EPG + o]; }
        int i0 = 0; float v0 = el[0];
#pragma unroll
        for (int o = 1; o < 8; ++o) if (el[o] > v0) { v0 = el[o]; i0 = o; }
        int i1 = -1; float v1 = -3.0e38f;
#pragma unroll
        for (int o = 0; o < 8; ++o) if (o != i0 && el[o] > v1) { v1 = el[o]; i1 = o; }
        const float e1 = __expf(v1 - v0), g0 = pgrp / (1.f + e1), g1 = pgrp * e1 / (1.f + e1);
        {
            if (have_prev && F.lane < 2) { ltok[(size_t)pe * M + ppos] = ptok; lgate[(size_t)pe * M + ppos] = pg; }
            if (F.lane < 2) { pe = gs * EPG + (F.lane == 0 ? i0 : i1); pg = F.lane == 0 ? g0 : g1; ptok = 2 * m + F.lane; ppos = atomicAdd(cnt + pe * 16, 1u); }
            have_prev = true;
        }
    }
    if (have_prev && F.lane < 2) { ltok[(size_t)pe * M + ppos] = ptok; lgate[(size_t)pe * M + ppos] = pg; }
    __syncthreads();
    REP(9) {
    LAS float* scr = (LAS float*)(F.lds + F.wave * TR_SCR);
    const float* eg = A.in[I_EX_GATE] + (size_t)layer * NE * D * DE; const float* eu = A.in[I_EX_UP] + (size_t)layer * NE * D * DE; const float* ed = A.in[I_EX_DOWN] + (size_t)layer * NE * DE * D;
    bf16_t* WGU = (bf16_t*)(ws + WS_WGU); bf16_t* WD = (bf16_t*)(ws + WS_WD);
    for (int it = F.gw; it < NE * 384; it += F.NGW) { const int e = it / 384, r = it % 384;
        if (r < 128) { const int kb = r / 8, nb = r % 8; transpose_item(eg + (size_t)e * D * DE, DE, nb * 64, kb * 64, WGU + (size_t)e * 1024 * D, D, 2 * nb * 64, 2, scr, F.lane); }
        else if (r < 256) { const int q = r - 128, kb = q / 8, nb = q % 8; transpose_item(eu + (size_t)e * D * DE, DE, nb * 64, kb * 64, WGU + (size_t)e * 1024 * D, D, 2 * nb * 64 + 1, 2, scr, F.lane); }
        else { const int q = r - 256, kb = q / 16, nb = q % 16; transpose_item(ed + (size_t)e * DE * D, D, nb * 64, kb * 64, WD + (size_t)e * 1024 * DE, DE, nb * 64, 1, scr, F.lane); }
    }
    }
}
__device__ __forceinline__ void moe_tables(const Frame& F, int layer) {
    LAS int* cntL = (LAS int*)(F.lds + MOE_OFF); LAS int* hoffL = cntL + 32; LAS int* tstartL = hoffL + 32;
    __syncthreads();
    if (F.tid < NE) cntL[F.tid] = (int)__hip_atomic_load(F.ctl + CW_CNT + (layer * NE + F.tid) * 16, RLX_AGENT);
    __syncthreads();
    if (F.tid == 0) { int h = 0, t = 0; for (int e = 0; e < NE; ++e) { hoffL[e] = h; tstartL[e] = t; h += cntL[e]; t += (cntL[e] + 255) >> 8; } tstartL[NE] = t; }
    __syncthreads();
}
__device__ __forceinline__ void phase_final(const Frame& F, const Args& A) {
    const bf16_t* YS = (const bf16_t*)(A.ws + WS_A + 64 * MiB);
    for (int m0 = F.gw; m0 < M; m0 += 2 * F.NGW) {
        f32x4 v[2][4]; u32x2 a[2][4], b[2][4];
#pragma unroll
        for (int q = 0; q < 2; ++q) { const int m = m0 + q * F.NGW; if (m < M) { const f32x4* xr = (const f32x4*)(A.out + (size_t)m * D) + F.lane;
            const u32x2* y0 = (const u32x2*)(YS + (size_t)(2 * m) * D) + F.lane; const u32x2* y1 = (const u32x2*)(YS + (size_t)(2 * m + 1) * D) + F.lane;
#pragma unroll
            for (int j = 0; j < 4; ++j) { v[q][j] = xr[64 * j]; a[q][j] = y0[64 * j]; b[q][j] = y1[64 * j]; } } }
#pragma unroll
        for (int q = 0; q < 2; ++q) { const int m = m0 + q * F.NGW; if (m < M) { f32x4* xr = (f32x4*)(A.out + (size_t)m * D) + F.lane;
#pragma unroll
            for (int j = 0; j < 4; ++j) { f32x4 w = v[q][j];
                w.x += bf2f(a[q][j].x & 0xffffu) + bf2f(b[q][j].x & 0xffffu); w.y += bf2f(a[q][j].x >> 16) + bf2f(b[q][j].x >> 16);
                w.z += bf2f(a[q][j].y & 0xffffu) + bf2f(b[q][j].y & 0xffffu); w.w += bf2f(a[q][j].y >> 16) + bf2f(b[q][j].y >> 16); xr[64 * j] = w; } } }
    }
}

constexpr int PH_PER_LAYER = 9, N_PHASES = NLAYER * PH_PER_LAYER + 1;
__global__ void __launch_bounds__(NTHREADS, 2) hymba_fwd(Args args) {
    extern __shared__ __attribute__((aligned(16))) unsigned char lds_raw[];
    Frame F;
    F.lds = (LAS unsigned char*)lds_raw; F.MISC = (volatile LAS unsigned*)(F.lds + MISC_OFF);
    F.tid = threadIdx.x; F.lane = F.tid & 63; F.wave = __builtin_amdgcn_readfirstlane(F.tid >> 6);
    F.G = gridDim.x; { const int bx = blockIdx.x; F.vcu = (F.G % 8 == 0) ? (bx % 8) * (F.G / 8) + bx / 8 : bx; }
    F.gw = F.vcu * NWAVES + F.wave; F.NGW = F.G * NWAVES;
    F.ctl = (unsigned*)(args.ws + WS_CTL);
    for (int u = F.tid; u < (LDS_BYTES - LDSCTL_OFF) / 4; u += NTHREADS) ((LAS unsigned*)(F.lds + LDSCTL_OFF))[u] = 0u;
    __syncthreads();
    if (F.tid < 23) ((LAS unsigned long long*)(F.lds + PTR_OFF))[F.tid] = (unsigned long long)args.in[F.tid];
    __syncthreads();
    XcdBarrier bar; bar.bar = F.ctl + CW_BAR; bar.x = 0; bar.st = nullptr;
#if MK_ONE_LAUNCH
    bar = xcd_barrier_post(F.ctl + CW_BAR, F.MISC + 8);
#define GRID_BAR() xcd_barrier(bar)
#else
#define GRID_BAR() do { } while (0)
#endif
    const int lo = args.ph_lo, hi = args.ph_hi;
    unsigned char* ws = args.ws;
    for (int ph = lo; ph < hi; ++ph) {
        Frame Fp = F; asm volatile("" : "+v"(Fp.lane), "+v"(Fp.tid));
        Args Ap; Ap.out = args.out; Ap.ws = args.ws; Ap.ph_lo = lo; Ap.ph_hi = hi;
        const LAS unsigned char* ptab = F.lds + PTR_OFF; asm volatile("" : "+v"(ptab));
#pragma unroll
        for (int i = 0; i < 23; ++i) { const unsigned long long v = ((const LAS unsigned long long*)ptab)[i];
            const unsigned plo = __builtin_amdgcn_readfirstlane((unsigned)v), phi = __builtin_amdgcn_readfirstlane((unsigned)(v >> 32)); Ap.in[i] = (const float*)(((unsigned long long)phi << 32) | plo); }
        const int layer = ph / PH_PER_LAYER, p = ph % PH_PER_LAYER;
        if (ph == N_PHASES - 1) { phase_final(Fp, Ap); }
        else if (p == 0) { phase_p0(Fp, Ap, layer); if ((((PROBE_REP) >> 8) & 1) && layer == 0) phase_p0(Fp, Ap, layer); }
        else if (p == 1) {
            pg8::DenseSched<M / 256, NPROJ / 256> S{Fp.G, (int)blockIdx.x, D, (const bf16_t*)(ws + WS_WIN)};
            pg8::EpiProj E{(bf16_t*)(ws + WS_A), NPROJ};
            REP(0) pg8::gemm_phase<pg8::EpiProj, pg8::DenseSched<M / 256, NPROJ / 256>>(Fp.lds, (const bf16_t*)(ws + WS_H), D, S, E);
        }
        else if (p == 2) { REP(3) cv::phase(Fp, Ap, layer); att::phase_qknorm(Fp, Ap, layer); REP(4) dn::phase1(Fp, Ap, layer); }
        else if (p == 3) { if (blockIdx.x < 64) { dn::scan(Fp, Ap, layer, (int)blockIdx.x); if (((PROBE_REP) >> 1) & 1) dn::scan(Fp, Ap, layer, (int)blockIdx.x); } att::phase_a(Fp, Ap, Fp.ctl + CW_Q + layer * 16); }
        else if (p == 4) { REP(5) att::phase_b(Fp, Ap); }
        else if (p == 5) {
            pg8::DenseSched<M / 256, D / 256> S{Fp.G, (int)blockIdx.x, D, (const bf16_t*)(ws + WS_WOUT)};
            pg8::EpiProj E{(bf16_t*)(ws + WS_H), D};
            REP(10) pg8::gemm_phase<pg8::EpiProj, pg8::DenseSched<M / 256, D / 256>>(Fp.lds, (const bf16_t*)(ws + WS_MIXED), D, S, E);
        }
        else if (p == 6) { phase_p4(Fp, Ap, layer); }
        else if (p == 7) {
            moe_tables(Fp, layer);
            pg8::MoeSched<false> S; S.cntL = (const LAS int*)(Fp.lds + MOE_OFF); S.hoffL = S.cntL + 32; S.tstartL = S.hoffL + 32; S.G = Fp.G; S.vc = Fp.vcu;
            S.ltok = (const int*)(ws + WS_LTOK); S.Bt = (const bf16_t*)(ws + WS_WGU);
            pg8::EpiGU E{(bf16_t*)(ws + WS_A)};
            REP(6) pg8::gemm_phase<pg8::EpiGU, pg8::MoeSched<false>>(Fp.lds, (const bf16_t*)(ws + WS_H), D, S, E);
        }
        else {
            moe_tables(Fp, layer);
            pg8::MoeSched<true> S; S.cntL = (const LAS int*)(Fp.lds + MOE_OFF); S.hoffL = S.cntL + 32; S.tstartL = S.hoffL + 32; S.G = Fp.G; S.vc = Fp.vcu;
            S.ltok = (const int*)(ws + WS_LTOK); S.Bt = (const bf16_t*)(ws + WS_WD);
            pg8::EpiDown E{(bf16_t*)(ws + WS_A + 64 * MiB), (const int*)(ws + WS_LTOK), (const float*)(ws + WS_LGATE)};
            REP(7) pg8::gemm_phase<pg8::EpiDown, pg8::MoeSched<true>>(Fp.lds, (const bf16_t*)(ws + WS_A), DE, S, E);
        }
        if (ph + 1 < hi) GRID_BAR();
    }
}

extern "C" void kernel_launch(void* const* d_in, const int* in_sizes, int n_in, void* d_out, int out_size, void* d_ws, size_t ws_size, hipStream_t stream) {
    static int grid = 0;
    if (grid == 0) {
        if (n_in != 23 || out_size != M * D || ws_size < WS_END) { fprintf(stderr, "kernel_launch: unexpected shapes (n_in %d out %d ws %zu)\n", n_in, out_size, ws_size); grid = -1; return; }
        int dev = 0, cus = 0, per_cu = 0;
        if (hipGetDevice(&dev) != hipSuccess || hipDeviceGetAttribute(&cus, hipDeviceAttributeMultiprocessorCount, dev) != hipSuccess) { grid = -1; return; }
        if (hipFuncSetAttribute((const void*)hymba_fwd, hipFuncAttributeMaxDynamicSharedMemorySize, LDS_BYTES) != hipSuccess) { fprintf(stderr, "kernel_launch: hipFuncSetAttribute failed\n"); grid = -1; return; }
        if (hipOccupancyMaxActiveBlocksPerMultiprocessor(&per_cu, (const void*)hymba_fwd, NTHREADS, LDS_BYTES) != hipSuccess || per_cu < 1) { fprintf(stderr, "kernel_launch: occupancy query says %d\n", per_cu); per_cu = 1; }
        (void)hipGetLastError();
        grid = cus;
    }
    if (grid < 0) return;
    (void)hipMemsetAsync((char*)d_ws + WS_CTL, 0, CTL_ZERO_BYTES, stream);
    Args a{};
    for (int i = 0; i < 23; ++i) a.in[i] = (const float*)d_in[i];
    a.out = (float*)d_out; a.ws = (unsigned char*)d_ws;
#if MK_ONE_LAUNCH
    a.ph_lo = 0; a.ph_hi = N_PHASES;
    void* kargs[] = {&a};
    hipError_t e = hipLaunchCooperativeKernel((const void*)hymba_fwd, dim3(grid), dim3(NTHREADS), kargs, LDS_BYTES, stream);
    if (e != hipSuccess) fprintf(stderr, "kernel_launch: cooperative launch failed: %s (grid %d)\n", hipGetErrorString(e), grid);
#else
    for (int ph = 0; ph < N_PHASES; ++ph) { a.ph_lo = ph; a.ph_hi = ph + 1;
        hipLaunchKernelGGL(hymba_fwd, dim3(grid), dim3(NTHREADS), LDS_BYTES, stream, a); }
#endif
}
```

```cpp
#include <hip/hip_runtime.h>
#include <cstdio>
#include <cstdint>

#ifndef PROBE_REP
#define PROBE_REP 0
#endif
#define REP(bit) for (int rep_ = 0; rep_ < (((PROBE_REP) >> (bit)) & 1) + 1; ++rep_)
#ifndef MK_ONE_LAUNCH
#define MK_ONE_LAUNCH 1
#endif

#define LAS __attribute__((address_space(3)))
#define GAS __attribute__((address_space(1)))
typedef unsigned short bf16_t;
typedef short bf16x8 __attribute__((ext_vector_type(8)));
typedef float f32x4 __attribute__((ext_vector_type(4)));
typedef float f32x2 __attribute__((ext_vector_type(2)));
typedef unsigned u32x4 __attribute__((ext_vector_type(4)));
typedef unsigned u32x2 __attribute__((ext_vector_type(2)));
typedef GAS unsigned gu32;
#define RLX_AGENT __ATOMIC_RELAXED, __HIP_MEMORY_SCOPE_AGENT
#define LDS_WAIT() asm volatile("s_waitcnt lgkmcnt(0)" ::: "memory")
#define VM_WAIT() asm volatile("s_waitcnt vmcnt(0)" ::: "memory")

constexpr int D = 1024, BATCH = 16, SEQ = 2048, M = BATCH * SEQ, NLAYER = 2;
constexpr int NIN = 3080, NPROJ = 3072;
constexpr int HD = 64, DNH = 4, ATH = 8, CVW = 256, CVK = 31;
constexpr int NGRP = 4, EPG = 8, NE = 32, DE = 512;
constexpr float EPS = 1e-6f;
constexpr int C_DQ = 0, C_DK = 256, C_DV = 512, C_DZ = 768, C_AQ = 1024, C_AK = 1536, C_AV = 2048, C_CU = 2560, C_CG = 2816;
constexpr int NWAVES = 8, NTHREADS = 512;

constexpr size_t MiB = 1u << 20;
constexpr size_t WS_CTL = 0, CTL_ZERO_BYTES = 1 * MiB;
constexpr size_t WS_WIN = 1 * MiB;
constexpr size_t WS_WOUT = 7 * MiB;
constexpr size_t WS_AB = 9 * MiB;
constexpr size_t WS_LTOK = 10 * MiB;
constexpr size_t WS_LGATE = 14 * MiB;
constexpr size_t WS_WGU = 18 * MiB;
constexpr size_t WS_WD = 82 * MiB;
constexpr size_t WS_H = 114 * MiB;
constexpr size_t WS_MIXED = 178 * MiB;
constexpr size_t WS_A = 242 * MiB;
constexpr size_t WS_ATTO = 434 * MiB;
constexpr size_t WS_ATTL = 498 * MiB;
constexpr size_t WS_END = 500 * MiB;
constexpr size_t WS_SCR = WS_WGU;
constexpr size_t WS_O = WS_H;
constexpr int CW_BAR = 4096;
constexpr int CW_CNT = 8192;
constexpr int CW_Q = 12288;

constexpr int RING_BYTES = 131072;
constexpr int LDS_BYTES = 155648;
constexpr int LDSCTL_OFF = 154624;
constexpr int MISC_OFF = LDSCTL_OFF;
constexpr int MOE_OFF = LDSCTL_OFF + 256;
constexpr int PTR_OFF = LDSCTL_OFF + 768;

__device__ __forceinline__ int lane_id() { return (int)__builtin_amdgcn_mbcnt_hi(~0u, __builtin_amdgcn_mbcnt_lo(~0u, 0u)); }
__device__ __forceinline__ float bf2f(unsigned v) { return __uint_as_float(v << 16); }
__device__ __forceinline__ unsigned f2bf(float f) { unsigned u = __float_as_uint(f); return (u + 0x7fffu + ((u >> 16) & 1u)) >> 16; }
__device__ __forceinline__ unsigned pk2(float lo, float hi) { return f2bf(lo) | (f2bf(hi) << 16); }
__device__ __forceinline__ float wave_sum(float v) {
#pragma unroll
    for (int o = 1; o < 64; o <<= 1) v += __shfl_xor(v, o);
    return v;
}
__device__ __forceinline__ float wave_max(float v) {
#pragma unroll
    for (int o = 1; o < 64; o <<= 1) v = fmaxf(v, __shfl_xor(v, o));
    return v;
}
__device__ __forceinline__ float sigm(float x) { return 1.f / (1.f + expf(-x)); }
__device__ __forceinline__ float siluf(float x) { return x * sigm(x); }


__device__ __forceinline__ void fold4(const float (&a)[4], float (&out)[4], int lane) {
    const bool p = lane & 1, p2 = (lane >> 1) & 1;
    float k0 = (p ? a[2] : a[0]) + __shfl_xor(p ? a[0] : a[2], 1), k1 = (p ? a[3] : a[1]) + __shfl_xor(p ? a[1] : a[3], 1);
    float k = (p2 ? k1 : k0) + __shfl_xor(p2 ? k0 : k1, 2);
#pragma unroll
    for (int o = 4; o < 64; o <<= 1) k += __shfl_xor(k, o);
    out[0] = __builtin_bit_cast(float, __builtin_amdgcn_readlane(__builtin_bit_cast(int, k), 0)); out[2] = __builtin_bit_cast(float, __builtin_amdgcn_readlane(__builtin_bit_cast(int, k), 1));
    out[1] = __builtin_bit_cast(float, __builtin_amdgcn_readlane(__builtin_bit_cast(int, k), 2)); out[3] = __builtin_bit_cast(float, __builtin_amdgcn_readlane(__builtin_bit_cast(int, k), 3));
}
__device__ __forceinline__ void fold8(const float (&a)[8], float (&out)[8], int lane) {
    const bool p = lane & 1, p2 = (lane >> 1) & 1, p4 = (lane >> 2) & 1;
    float b[4];
#pragma unroll
    for (int i = 0; i < 4; ++i) b[i] = (p ? a[4 + i] : a[i]) + __shfl_xor(p ? a[i] : a[4 + i], 1);
    float c[2];
#pragma unroll
    for (int i = 0; i < 2; ++i) c[i] = (p2 ? b[2 + i] : b[i]) + __shfl_xor(p2 ? b[i] : b[2 + i], 2);
    float k = (p4 ? c[1] : c[0]) + __shfl_xor(p4 ? c[0] : c[1], 4);
#pragma unroll
    for (int o = 8; o < 64; o <<= 1) k += __shfl_xor(k, o);
#pragma unroll
    for (int l = 0; l < 8; ++l) { const int o = 4 * (l & 1) + 2 * ((l >> 1) & 1) + ((l >> 2) & 1); out[o] = __builtin_bit_cast(float, __builtin_amdgcn_readlane(__builtin_bit_cast(int, k), l)); }
}

namespace pg8 {
constexpr int BM = 256, BK = 64, HALF = 128, HTB = HALF * BK * 2, STAGE_BYTES = 8 * HTB, NXCD = 8, WGM = 8;
__host__ __device__ __forceinline__ int lds_byte(int r, int c) { const int st = (r >> 4) * 2 + (c >> 5), rr = r & 15, cc = c & 31, ob = rr * 64 + cc * 2; return st * 1024 + (ob ^ (((ob >> 9) & 1) << 5)); }
__host__ __device__ __forceinline__ void stage_rc(int b, int& R, int& C) { const int st = b / 1024, sb = b % 1024, swz = sb ^ (((sb >> 9) & 1) << 5); R = (st >> 1) * 16 + swz / 64; C = (st & 1) * 32 + (swz % 64) / 2; }
__host__ __device__ __forceinline__ int perm32(int rho) { const int n = rho >> 4, i = rho & 15; return 8 * (i >> 2) + 4 * n + (i & 3); }
typedef __bf16 bf16x2_t __attribute__((ext_vector_type(2)));
__device__ __forceinline__ unsigned cvt_pk_bf16(float lo, float hi) { f32x2 v = {lo, hi}; bf16x2_t b = __builtin_convertvector(v, bf16x2_t); return __builtin_bit_cast(unsigned, b); }

typedef int i32x8 __attribute__((ext_vector_type(8)));
typedef int i32x4_t __attribute__((ext_vector_type(4)));
constexpr int SC_ONE = 0x7f7f7f7f, SC_W8 = 0x79797979;
__device__ __forceinline__ void mma8_fp8(f32x4 (&acc)[4][2], const i32x8 (&Bw)[2], const i32x8 (&Ax)[4], int scw, int sca) {
    asm volatile(
        "v_mfma_scale_f32_16x16x128_f8f6f4 %0, %8, %10, %0, %14, %15 op_sel_hi:[0,0,0]\n\t"
        "v_mfma_scale_f32_16x16x128_f8f6f4 %1, %9, %10, %1, %14, %15 op_sel_hi:[0,0,0]\n\t"
        "v_mfma_scale_f32_16x16x128_f8f6f4 %2, %8, %11, %2, %14, %15 op_sel_hi:[0,0,0]\n\t"
        "v_mfma_scale_f32_16x16x128_f8f6f4 %3, %9, %11, %3, %14, %15 op_sel_hi:[0,0,0]\n\t"
        "v_mfma_scale_f32_16x16x128_f8f6f4 %4, %8, %12, %4, %14, %15 op_sel_hi:[0,0,0]\n\t"
        "v_mfma_scale_f32_16x16x128_f8f6f4 %5, %9, %12, %5, %14, %15 op_sel_hi:[0,0,0]\n\t"
        "v_mfma_scale_f32_16x16x128_f8f6f4 %6, %8, %13, %6, %14, %15 op_sel_hi:[0,0,0]\n\t"
        "v_mfma_scale_f32_16x16x128_f8f6f4 %7, %9, %13, %7, %14, %15 op_sel_hi:[0,0,0]"
        : "+v"(acc[0][0]), "+v"(acc[0][1]), "+v"(acc[1][0]), "+v"(acc[1][1]), "+v"(acc[2][0]), "+v"(acc[2][1]), "+v"(acc[3][0]), "+v"(acc[3][1])
        : "v"(Bw[0]), "v"(Bw[1]), "v"(Ax[0]), "v"(Ax[1]), "v"(Ax[2]), "v"(Ax[3]), "v"(scw), "v"(sca));
}
template <class Epi, class Sched, bool FP8 = false>
__device__ __forceinline__ void gemm_phase(LAS unsigned char* lds, const void* Abase, const int RB_  , const Sched& S, const Epi& E, int wave_) {
    int RB = RB_; asm volatile("" : "+s"(RB));
    int tid_ = wave_ * 64 + lane_id(); asm volatile("" : "+v"(tid_));
    const int tid = tid_, wid = __builtin_amdgcn_readfirstlane(tid >> 6), lane = tid & 63, wr = wid >> 2, wc = wid & 3, fr = lane & 15, fq = lane >> 4;
    const int nt = RB / 128;
    int Rr[2], Cc2[2]; unsigned voffB[2];
#pragma unroll
    for (int i = 0; i < 2; ++i) { int R, C; stage_rc(tid * 16 + i * 8192, R, C); const int Rb = Epi::PERM ? ((R & ~31) + perm32(R & 31)) : R;
        Rr[i] = R; Cc2[i] = C * 2; voffB[i] = (unsigned)(Rb * RB + C * 2); }
    const size_t kstep = (size_t)(BK * 2);
    const size_t hstep = (size_t)HALF * RB;
    const unsigned ldsw = (unsigned)wid * 1024u;
    const int aoff = lds_byte(wr * 64 + fr, fq * 8), boff = lds_byte(wc * 32 + fr, fq * 8);
    const int aoff0 = lds_byte(wr * 64 + fr, fq * 16), aoff1 = lds_byte(wr * 64 + fr, fq * 16 + 8), boff0 = lds_byte(wc * 32 + fr, fq * 16), boff1 = lds_byte(wc * 32 + fr, fq * 16 + 8);
    const char* Ab = (const char*)Abase;
#define PG8_SA(b, h) (((b) * 2 + (h)) * HTB)
#define PG8_SB(b, h) ((4 + (b) * 2 + (h)) * HTB)
#define PG8_STAGE(bufoff, gbase, voff) do { _Pragma("unroll") for (int _i = 0; _i < 2; ++_i) \
        __builtin_amdgcn_global_load_lds((const unsigned*)((const char*)(gbase) + (voff)[_i]), (LAS unsigned*)(lds + (bufoff) + ldsw + _i * 8192), 16, 0, 0); } while (0)
#define PG8_LD8(p0, p1) __builtin_shufflevector(__builtin_bit_cast(i32x4_t, *(const LAS u32x4*)(p0)), __builtin_bit_cast(i32x4_t, *(const LAS u32x4*)(p1)), 0, 1, 2, 3, 4, 5, 6, 7)
#define PG8_LDA(dst, b, h) do { if constexpr (FP8) { _Pragma("unroll") for (int m = 0; m < 4; ++m) dst##8[m] = PG8_LD8(lds + PG8_SA(b, h) + aoff0 + m * 2048, lds + PG8_SA(b, h) + aoff1 + m * 2048); } \
        else { _Pragma("unroll") for (int m = 0; m < 4; ++m) _Pragma("unroll") for (int k = 0; k < 2; ++k) dst[m][k] = *(const LAS bf16x8*)(lds + PG8_SA(b, h) + aoff + m * 2048 + k * 1024); } } while (0)
#define PG8_LDB(dst, b, h) do { if constexpr (FP8) { _Pragma("unroll") for (int n = 0; n < 2; ++n) dst##8[n] = PG8_LD8(lds + PG8_SB(b, h) + boff0 + n * 2048, lds + PG8_SB(b, h) + boff1 + n * 2048); } \
        else { _Pragma("unroll") for (int n = 0; n < 2; ++n) _Pragma("unroll") for (int k = 0; k < 2; ++k) dst[n][k] = *(const LAS bf16x8*)(lds + PG8_SB(b, h) + boff + n * 2048 + k * 1024); } } while (0)
#define PG8_MMA(ai, bj, At, Bt) do { __builtin_amdgcn_s_setprio(1); if constexpr (FP8) { mma8_fp8(acc[ai][bj], Bt##8, At##8, scw_, sca_); } \
        else { _Pragma("unroll") for (int m = 0; m < 4; ++m) _Pragma("unroll") for (int n = 0; n < 2; ++n) _Pragma("unroll") for (int k = 0; k < 2; ++k) \
        acc[ai][bj][m][n] = __builtin_amdgcn_mfma_f32_16x16x32_bf16(Bt[n][k], At[m][k], acc[ai][bj][m][n], 0, 0, 0); } __builtin_amdgcn_s_setprio(0); } while (0)
#define PG8_WAIT_V(n) asm volatile("s_waitcnt vmcnt(" #n ")" ::: "memory")
#define PG8_WAIT_L(n) asm volatile("s_waitcnt lgkmcnt(" #n ")" ::: "memory")
#define PG8_BAR __builtin_amdgcn_s_barrier()
#define PG8_SCHED __builtin_amdgcn_sched_barrier(0)
    typename Sched::Unit cur, nxt; int ui = 0;
    if (!S.next(0, cur)) return;
    unsigned va0[2], va1[2], vn0[2], vn1[2];
    const char* cA = Ab; const char* nA = Ab;
    if constexpr (Sched::GATHER) {
#pragma unroll
        for (int i = 0; i < 2; ++i) { va0[i] = S.a_off(cur, Rr[i]) + (unsigned)Cc2[i]; va1[i] = S.a_off(cur, HALF + Rr[i]) + (unsigned)Cc2[i]; }
    } else {
#pragma unroll
        for (int i = 0; i < 2; ++i) { va0[i] = (unsigned)(Rr[i] * RB + Cc2[i]); va1[i] = va0[i] + (unsigned)hstep; vn0[i] = va0[i]; vn1[i] = va1[i]; }
        cA = Ab + S.a_base(cur);
    }
    bf16x8 At[4][2], B0[2][2], B1[2][2]; i32x8 At8[4], B08[2], B18[2];
    int scw_ = SC_W8, sca_ = SC_ONE; asm volatile("" : "+v"(scw_), "+v"(sca_));
    const char* cB = S.b_base(cur);
    PG8_STAGE(PG8_SB(0, 0), cB, voffB); PG8_STAGE(PG8_SB(0, 1), cB + hstep, voffB); PG8_STAGE(PG8_SA(0, 0), cA, va0); PG8_STAGE(PG8_SA(0, 1), cA, va1);
    if (wr == 1) PG8_BAR;
    PG8_WAIT_V(2); PG8_BAR;
    PG8_STAGE(PG8_SB(1, 0), cB + kstep, voffB); PG8_STAGE(PG8_SA(1, 0), cA + kstep, va0); PG8_STAGE(PG8_SB(1, 1), cB + hstep + kstep, voffB);
    PG8_WAIT_V(6); PG8_BAR;
    __builtin_amdgcn_sched_barrier(0);
    f32x4 acc[2][2][4][2];
#pragma unroll
    for (int a = 0; a < 2; ++a)
#pragma unroll
        for (int b = 0; b < 2; ++b)
#pragma unroll
            for (int m = 0; m < 4; ++m)
#pragma unroll
                for (int n = 0; n < 2; ++n) acc[a][b][m][n] = (f32x4){0.f, 0.f, 0.f, 0.f};
    for (;;) {
        const bool has_next = S.next(ui + 1, nxt);
        const char* nB = cB; nA = cA;
        if (has_next) { nB = S.b_base(nxt);
            if constexpr (Sched::GATHER) { u32x4 pk; int t2 = tid; asm volatile("" : "+v"(t2));
#pragma unroll
                for (int i = 0; i < 2; ++i) { int R, C; stage_rc(t2 * 16 + i * 8192, R, C);
                    pk[i] = S.a_off(nxt, R) + (unsigned)(C * 2); pk[2 + i] = S.a_off(nxt, HALF + R) + (unsigned)(C * 2); }
                *(LAS u32x4*)(lds + STAGE_BYTES + tid * 16) = pk;
            } else nA = Ab + S.a_base(nxt);
        } else if constexpr (Sched::GATHER) { *(LAS u32x4*)(lds + STAGE_BYTES + tid * 16) = (u32x4){va0[0], va0[1], va1[0], va1[1]}; }
        for (int t = 0; t < nt; t += 2) {
            const bool last = (t == nt - 2);
            const char* a1 = cA + (size_t)(t + 1) * kstep;
            const char* a2 = last ? nA : cA + (size_t)(t + 2) * kstep; const char* b2 = last ? nB : cB + (size_t)(t + 2) * kstep;
            const char* a3 = a2 + kstep; const char* b3 = b2 + kstep;
            unsigned w0[2], w1[2];
#pragma unroll
            for (int i = 0; i < 2; ++i) { w0[i] = va0[i]; w1[i] = va1[i]; }
            if constexpr (Sched::GATHER) { if (last) { const u32x4 pk = *(const LAS u32x4*)(lds + STAGE_BYTES + tid * 16); w0[0] = pk[0]; w0[1] = pk[1]; w1[0] = pk[2]; w1[1] = pk[3]; } }
            PG8_LDB(B0, 0, 0); PG8_LDB(B1, 0, 1); PG8_SCHED; PG8_LDA(At, 0, 0); PG8_STAGE(PG8_SA(1, 1), a1, va1);
            PG8_WAIT_V(8); PG8_WAIT_L(0); PG8_BAR; PG8_MMA(0, 0, At, B0); PG8_MMA(0, 1, At, B1); PG8_BAR; PG8_SCHED;
            PG8_LDA(At, 0, 1); PG8_STAGE(PG8_SB(0, 0), b2, voffB); PG8_STAGE(PG8_SB(0, 1), b2 + hstep, voffB); PG8_STAGE(PG8_SA(0, 0), a2, w0);
            PG8_WAIT_V(8); PG8_WAIT_L(0); PG8_BAR; PG8_MMA(1, 0, At, B0); PG8_MMA(1, 1, At, B1); PG8_BAR; PG8_SCHED;
            PG8_LDB(B0, 1, 0); PG8_LDB(B1, 1, 1); PG8_SCHED; PG8_LDA(At, 1, 0); PG8_STAGE(PG8_SA(0, 1), a2, w1);
            PG8_WAIT_V(8); PG8_WAIT_L(0); PG8_BAR; PG8_MMA(0, 0, At, B0); PG8_MMA(0, 1, At, B1); PG8_BAR; PG8_SCHED;
            PG8_LDA(At, 1, 1); PG8_STAGE(PG8_SB(1, 0), b3, voffB); PG8_STAGE(PG8_SB(1, 1), b3 + hstep, voffB); PG8_STAGE(PG8_SA(1, 0), a3, w0);
            PG8_WAIT_V(8); PG8_WAIT_L(0); PG8_BAR; PG8_MMA(1, 0, At, B0); PG8_MMA(1, 1, At, B1); PG8_BAR; PG8_SCHED;
        }
        if (wr == 0) PG8_BAR;
        if constexpr (FP8) asm volatile("s_nop 15\n\ts_nop 15" ::: "memory");
        E(acc, cur, wr, wc, fr, fq);
        if (!has_next) break;
#pragma unroll
        for (int a = 0; a < 2; ++a)
#pragma unroll
            for (int b = 0; b < 2; ++b)
#pragma unroll
                for (int m = 0; m < 4; ++m)
#pragma unroll
                    for (int n = 0; n < 2; ++n) acc[a][b][m][n] = (f32x4){0.f, 0.f, 0.f, 0.f};
        cur = nxt; cB = nB; cA = nA; ++ui;
        if constexpr (Sched::GATHER) { const u32x4 pk = *(const LAS u32x4*)(lds + STAGE_BYTES + tid * 16); va0[0] = pk[0]; va0[1] = pk[1]; va1[0] = pk[2]; va1[1] = pk[3]; }
        if (wr == 1) PG8_BAR;
    }
    PG8_WAIT_V(0);
    PG8_BAR;
#undef PG8_SA
#undef PG8_SB
#undef PG8_STAGE
#undef PG8_LD8
#undef PG8_LDA
#undef PG8_LDB
#undef PG8_MMA
#undef PG8_WAIT_V
#undef PG8_WAIT_L
#undef PG8_BAR
#undef PG8_SCHED
}

struct DUnit { int pm, pn; };
template <int NM, int NN>
struct DenseSched {
    typedef DUnit Unit; static constexpr bool GATHER = false;
    int G, c, K; const bf16_t* Bt;
    __device__ __forceinline__ bool next(int i, Unit& u) const {
        constexpr int nwg = NM * NN, q = nwg / NXCD; static_assert(nwg % NXCD == 0 && NM % WGM == 0, "tile counts");
        const int L = i * G + c; if (L >= nwg) return false;
        const int wgid = (L % NXCD) * q + L / NXCD;
        constexpr int nig = WGM * NN; const int gid = wgid / nig, fm = gid * WGM;
        u.pm = fm + ((wgid % nig) % WGM); u.pn = (wgid % nig) / WGM; return true;
    }
    __device__ __forceinline__ size_t a_base(const Unit& u) const { return (size_t)u.pm * BM * K * 2; }
    __device__ __forceinline__ unsigned a_off(const Unit&, int) const { return 0u; }
    __device__ __forceinline__ const char* b_base(const Unit& u) const { return (const char*)(Bt + (size_t)u.pn * BM * K); }
};
struct MUnit { int e, mt, pn, cnt, hoff; };
template <bool DOWN>
struct MoeSched {
    typedef MUnit Unit; static constexpr bool GATHER = !DOWN;
    __device__ __forceinline__ size_t a_base(const Unit& u) const { return DOWN ? (size_t)(u.hoff + u.mt * BM) * DE : 0; }
    const LAS int* cntL; const LAS int* hoffL; const LAS int* tstartL;
    int G, vc; const int* ltok; const unsigned char* Bt;
    __device__ __forceinline__ bool next(int i, Unit& u) const {
        const int total = tstartL[NE] * 4; const long L = (long)i * G + vc; if (L >= total) return false;
        const int mtg = (int)L >> 2; u.pn = (int)L & 3;
        int e = 0;
#pragma unroll 1
        for (int k = 1; k < NE; ++k) if (tstartL[k] <= mtg) e = k;
        u.e = e; u.mt = mtg - tstartL[e]; u.cnt = cntL[e]; u.hoff = hoffL[e]; return true;
    }
    __device__ __forceinline__ unsigned a_off(const Unit& u, int row) const {
        int idx = u.mt * BM + row; idx = idx < u.cnt ? idx : u.cnt - 1;
        if (DOWN) return (unsigned)(u.hoff + idx) * (unsigned)DE;
        const int t2 = ltok[(size_t)u.e * M + idx]; return (unsigned)(t2 >> 1) * (unsigned)D;
    }
    __device__ __forceinline__ const char* b_base(const Unit& u) const { return (const char*)Bt + ((size_t)u.e * 1024 + (size_t)u.pn * BM) * (DOWN ? DE : D); }
};

struct EpiProj {
    static constexpr bool PERM = true;
    bf16_t* O; int ldc;
    __device__ __forceinline__ void operator()(const f32x4 (&acc)[2][2][4][2], const DUnit& u, int wr, int wc, int fr, int fq) const {
        const int row0 = u.pm * BM + wr * 64 + fr, col0 = u.pn * BM + wc * 32 + 8 * fq;
#pragma unroll
        for (int ai = 0; ai < 2; ++ai)
#pragma unroll
            for (int m = 0; m < 4; ++m) { bf16_t* rowp = O + (size_t)(row0 + ai * HALF + m * 16) * ldc + col0;
#pragma unroll
                for (int bj = 0; bj < 2; ++bj) { const f32x4 v0 = acc[ai][bj][m][0], v1 = acc[ai][bj][m][1];
                    u32x4 w; w.x = cvt_pk_bf16(v0[0], v0[1]); w.y = cvt_pk_bf16(v0[2], v0[3]); w.z = cvt_pk_bf16(v1[0], v1[1]); w.w = cvt_pk_bf16(v1[2], v1[3]);
                    *(u32x4*)(rowp + bj * HALF) = w; } }
    }
};
struct EpiResid {
    static constexpr bool PERM = false;
    const float* resid; float* out; int ldc;
    __device__ __forceinline__ void operator()(const f32x4 (&acc)[2][2][4][2], const DUnit& u, int wr, int wc, int fr, int fq) const {
        const int row0 = u.pm * BM + wr * 64 + fr, col0 = u.pn * BM + wc * 32 + 4 * fq;
#pragma unroll
        for (int ai = 0; ai < 2; ++ai)
#pragma unroll
            for (int m = 0; m < 4; ++m) { const size_t off = (size_t)(row0 + ai * HALF + m * 16) * ldc + col0;
#pragma unroll
                for (int bj = 0; bj < 2; ++bj)
#pragma unroll
                    for (int n = 0; n < 2; ++n) { const f32x4 r = *(const f32x4*)(resid + off + bj * HALF + n * 16); *(f32x4*)(out + off + bj * HALF + n * 16) = r + acc[ai][bj][m][n]; } }
    }
};
struct EpiGU {
    static constexpr bool PERM = true;
    unsigned char* HID;
    __device__ __forceinline__ void operator()(const f32x4 (&acc)[2][2][4][2], const MUnit& u, int wr, int wc, int fr, int fq) const {
        const int r0 = wr * 64 + fr, j0 = u.pn * 128 + wc * 16 + 4 * fq;
#pragma unroll
        for (int ai = 0; ai < 2; ++ai)
#pragma unroll
            for (int m = 0; m < 4; ++m) { const int idx = u.mt * BM + r0 + ai * HALF + m * 16;
                if (idx < u.cnt) { unsigned char* rowp = HID + (size_t)(u.hoff + idx) * DE + j0;
#pragma unroll
                    for (int bj = 0; bj < 2; ++bj) { const f32x4 v0 = acc[ai][bj][m][0], v1 = acc[ai][bj][m][1];
                        const float h0 = siluf(v0[0]) * v0[1], h1 = siluf(v0[2]) * v0[3], h2 = siluf(v1[0]) * v1[1], h3 = siluf(v1[2]) * v1[3];
                        int w = __builtin_amdgcn_cvt_pk_fp8_f32(h0, h1, 0, false); w = __builtin_amdgcn_cvt_pk_fp8_f32(h2, h3, w, true);
                        *(int*)(rowp + bj * 64) = w; } } }
    }
};
struct EpiDown {
    static constexpr bool PERM = true;
    bf16_t* YS; const int* ltok; const float* lgate;
    __device__ __forceinline__ void operator()(const f32x4 (&acc)[2][2][4][2], const MUnit& u, int wr, int wc, int fr, int fq) const {
        const int r0 = wr * 64 + fr, col0 = u.pn * BM + wc * 32 + 8 * fq;
#pragma unroll
        for (int ai = 0; ai < 2; ++ai)
#pragma unroll
            for (int m = 0; m < 4; ++m) { const int idx = u.mt * BM + r0 + ai * HALF + m * 16;
                if (idx < u.cnt) { const int t2 = ltok[(size_t)u.e * M + idx]; const float g = lgate[(size_t)u.e * M + idx];
                    bf16_t* rowp = YS + (size_t)t2 * D + col0;
#pragma unroll
                    for (int bj = 0; bj < 2; ++bj) { const f32x4 v0 = acc[ai][bj][m][0] * g, v1 = acc[ai][bj][m][1] * g;
                        u32x4 w; w.x = cvt_pk_bf16(v0[0], v0[1]); w.y = cvt_pk_bf16(v0[2], v0[3]); w.z = cvt_pk_bf16(v1[0], v1[1]); w.w = cvt_pk_bf16(v1[2], v1[3]);
                        *(u32x4*)(rowp + bj * HALF) = w; } } }
    }
};
}

#define XB_TMO      128
#define XB_XCNT(j)  (256  + 64 * (j))
#define XB_XSUB(j)  (1280 + 64 * (j))
#define XB_XGEN(j)  (2304 + 64 * (j))
#define XB_TOP      3328
#define XB_TOPGEN   3392
#define XCD_BAR_WORDS 3456
#define XB_SPIN_CAP (1u << 22)
__device__ __forceinline__ unsigned xb_ld(unsigned* p)              { return __hip_atomic_load(p, __ATOMIC_RELAXED, __HIP_MEMORY_SCOPE_AGENT); }
__device__ __forceinline__ unsigned xb_add(unsigned* p, unsigned v) { return __hip_atomic_fetch_add(p, v, __ATOMIC_RELAXED, __HIP_MEMORY_SCOPE_AGENT); }
__device__ __forceinline__ unsigned xb_xcc_id() { return (unsigned)__builtin_amdgcn_s_getreg((3 << 11) | 20) & 0xFu; }
#define XB_SPIN(cond, bar) do { unsigned _sp = 0; while (cond) { __builtin_amdgcn_s_sleep(1); \
    if ((++_sp & 255u) == 0u) { if (xb_ld(&(bar)[XB_TMO])) break; if (_sp > XB_SPIN_CAP) { atomicAdd(&(bar)[XB_TMO], 1u); break; } } } } while (0)
struct XcdBarrier { unsigned* bar; unsigned x; volatile LAS unsigned* st; };
__device__ __forceinline__ XcdBarrier xcd_barrier_post(unsigned* bar, volatile LAS unsigned* st, int tid) {
    XcdBarrier b; b.bar = bar; b.x = xb_xcc_id(); b.st = st;
    if (tid == 0) (void)xb_add(&bar[XB_XCNT(b.x)], 1u);
    return b;
}
__device__ __forceinline__ void xcd_barrier_complete(unsigned* bar, unsigned x, unsigned& nloc, unsigned& nx) {
    const unsigned G = gridDim.x * gridDim.y * gridDim.z;
    unsigned sum, cnt, mine, sp = 0u;
    for (;;) {
        sum = 0u; cnt = 0u; mine = 0u;
#pragma unroll
        for (unsigned j = 0; j < 16; ++j) { const unsigned c = xb_ld(&bar[XB_XCNT(j)]); sum += c; cnt += (c > 0u) ? 1u : 0u; mine = (j == x) ? c : mine; }
        if (sum == G) break;
        __builtin_amdgcn_s_sleep(1);
        if ((++sp & 255u) == 0u) { if (xb_ld(&bar[XB_TMO])) break; if (sp > XB_SPIN_CAP) { atomicAdd(&bar[XB_TMO], 1u); break; } }
    }
    nloc = mine > 0u ? mine : 1u; nx = cnt > 0u ? cnt : 1u;
}
__device__ __forceinline__ void xcd_barrier(const XcdBarrier& b, int tid) {
    asm volatile("s_waitcnt vmcnt(0)" ::: "memory");
    __syncthreads();
    if (tid == 0) {
        unsigned* bar = b.bar;
        __builtin_amdgcn_s_waitcnt(0);
        unsigned nloc = b.st[0], nx = b.st[1];
        if (nloc == 0u) { xcd_barrier_complete(bar, b.x, nloc, nx); b.st[0] = nloc; b.st[1] = nx; }
        const unsigned old = xb_add(&bar[XB_XSUB(b.x)], 1u);
        const unsigned gen = old / nloc;
        if (old + 1u == (gen + 1u) * nloc) {
            __builtin_amdgcn_fence(__ATOMIC_RELEASE, "agent");
            asm volatile("s_waitcnt vmcnt(0)" ::: "memory");
            const unsigned og = xb_add(&bar[XB_TOP], 1u);
            const unsigned tg = og / nx;
            if (og + 1u == (tg + 1u) * nx) xb_add(&bar[XB_TOPGEN], 1u);
            else XB_SPIN(xb_ld(&bar[XB_TOPGEN]) == tg, bar);
            __builtin_amdgcn_fence(__ATOMIC_ACQUIRE, "agent");
            xb_add(&bar[XB_XGEN(b.x)], 1u);
            asm volatile("s_waitcnt vmcnt(0)" ::: "memory");
        } else {
            XB_SPIN(xb_ld(&bar[XB_XGEN(b.x)]) == gen, bar);
            __builtin_amdgcn_fence(__ATOMIC_ACQUIRE, "agent");
            asm volatile("s_waitcnt vmcnt(0)" ::: "memory");
        }
    }
    __syncthreads();
}

struct Args {
    const float* in[23]; float* out; unsigned char* ws; int ph_lo, ph_hi;
};
struct Frame {
    LAS unsigned char* lds; volatile LAS unsigned* MISC; unsigned* ctl;
    int tid, lane, wave, vcu, G, gw, NGW;
};
enum { I_X = 0, I_NORM_MIX, I_W_IN, I_DN_CONV, I_DN_ALOG, I_DN_DTB, I_DN_ONORM, I_AT_QN, I_AT_KN, I_RELB, I_CV_DW, I_CV_DWB, I_CV_LNG, I_CV_LNB,
       I_W_OUT, I_NORM_FFN, I_RG_W, I_RG_B, I_RE_W, I_RE_B, I_EX_GATE, I_EX_UP, I_EX_DOWN };

__device__ __forceinline__ void transpose_item(const float* W, int ldw, int src_col0, int k0, bf16_t* WT, int Kd, int dst_row0, int dst_mul, LAS float* scr, int lane) {
    const float* wp = W + (size_t)k0 * ldw + src_col0 + lane;
#pragma unroll
    for (int h2 = 0; h2 < 2; ++h2) { float v[32];
#pragma unroll
        for (int i = 0; i < 32; ++i) v[i] = wp[(size_t)(h2 * 32 + i) * ldw];
#pragma unroll
        for (int i = 0; i < 32; ++i) scr[(h2 * 32 + i) * 65 + lane] = v[i]; }
    LDS_WAIT(); asm volatile("" ::: "memory");
    const int c = lane & 7;
#pragma unroll
    for (int j = 0; j < 8; ++j) { const int n = (lane >> 3) + 8 * j; const LAS float* s = scr + (8 * c) * 65 + n;
        u32x4 o; o.x = pk2(s[0 * 65], s[1 * 65]); o.y = pk2(s[2 * 65], s[3 * 65]); o.z = pk2(s[4 * 65], s[5 * 65]); o.w = pk2(s[6 * 65], s[7 * 65]);
        *(u32x4*)(WT + (size_t)(dst_row0 + dst_mul * n) * Kd + k0 + 8 * c) = o; }
    LDS_WAIT(); asm volatile("" ::: "memory");
}
__device__ __forceinline__ void transpose_item8(const float* W, int ldw, int src_col0, int k0, unsigned char* WT, int Kd, int dst_row0, int dst_mul, LAS float* scr, int lane) {
    const float* wp = W + (size_t)k0 * ldw + src_col0 + lane;
#pragma unroll
    for (int h2 = 0; h2 < 2; ++h2) { float v[32];
#pragma unroll
        for (int i = 0; i < 32; ++i) v[i] = wp[(size_t)(h2 * 32 + i) * ldw];
#pragma unroll
        for (int i = 0; i < 32; ++i) scr[(h2 * 32 + i) * 65 + lane] = v[i]; }
    LDS_WAIT(); asm volatile("" ::: "memory");
    const int c = lane & 3;
#pragma unroll
    for (int j = 0; j < 4; ++j) { const int n = (lane >> 2) + 16 * j; const LAS float* s = scr + (16 * c) * 65 + n; int o[4];
#pragma unroll
        for (int q = 0; q < 4; ++q) { int w = __builtin_amdgcn_cvt_pk_fp8_f32(s[(4 * q) * 65] * 64.f, s[(4 * q + 1) * 65] * 64.f, 0, false); w = __builtin_amdgcn_cvt_pk_fp8_f32(s[(4 * q + 2) * 65] * 64.f, s[(4 * q + 3) * 65] * 64.f, w, true); o[q] = w; }
        *(u32x4*)(WT + (size_t)(dst_row0 + dst_mul * n) * Kd + k0 + 16 * c) = (u32x4){(unsigned)o[0], (unsigned)o[1], (unsigned)o[2], (unsigned)o[3]}; }
    LDS_WAIT(); asm volatile("" ::: "memory");
}
constexpr int TR_SCR = 64 * 65 * 4;

__device__ __forceinline__ void phase_p0(const Frame& F, const Args& A, int layer) {
    unsigned char* ws = A.ws;
    LAS float* scr = (LAS float*)(F.lds + F.wave * TR_SCR);
    const float* w_in = A.in[I_W_IN] + (size_t)layer * D * NIN;
    const float* w_out = A.in[I_W_OUT] + (size_t)layer * D * D;
    bf16_t* WIN = (bf16_t*)(ws + WS_WIN); bf16_t* WOUT = (bf16_t*)(ws + WS_WOUT);
    constexpr int I_IN = (D / 64) * (NPROJ / 64), I_OUT = (D / 64) * (D / 64);
    for (int it = F.gw; it < I_IN + I_OUT; it += F.NGW) {
        if (it < I_IN) { const int nblk = NPROJ / 64, kb = it / nblk, nb = it % nblk, n0 = nb * 64; const int src = n0 < 1024 ? n0 : n0 + 8;
            transpose_item(w_in, NIN, src, kb * 64, WIN, D, n0, 1, scr, F.lane); }
        else { const int r = it - I_IN, nblk = D / 64, kb = r / nblk, nb = r % nblk;
            transpose_item(w_out, D, nb * 64, kb * 64, WOUT, D, nb * 64, 1, scr, F.lane); }
    }
    const float* xin = layer == 0 ? A.in[I_X] : A.out;
    const float* gmix = A.in[I_NORM_MIX] + layer * D;
    bf16_t* H = (bf16_t*)(ws + WS_H); float* AB = (float*)(ws + WS_AB);
    const bf16_t* YS = (const bf16_t*)(ws + WS_A + 64 * MiB);
    __syncthreads();
    LAS float* wabT = (LAS float*)F.lds;
    for (int idx = F.tid; idx < 2 * D; idx += NTHREADS) { const int k = idx & (D - 1), o4 = idx >> 10; const f32x4 w = *(const f32x4*)(w_in + (size_t)k * NIN + 1024 + 4 * o4);
        wabT[(4 * o4 + 0) * D + k] = w.x; wabT[(4 * o4 + 1) * D + k] = w.y; wabT[(4 * o4 + 2) * D + k] = w.z; wabT[(4 * o4 + 3) * D + k] = w.w; }
    __syncthreads();
    f32x4 gv[4];
#pragma unroll
    for (int j = 0; j < 4; ++j) gv[j] = *((const f32x4*)gmix + F.lane + 64 * j);
    f32x4 nv[4]; u32x2 na[4], nb[4];
    if (F.gw < M) { const f32x4* xr = (const f32x4*)(xin + (size_t)F.gw * D) + F.lane;
#pragma unroll
        for (int j = 0; j < 4; ++j) nv[j] = xr[64 * j];
        if (layer > 0) { const u32x2* y0 = (const u32x2*)(YS + (size_t)(2 * F.gw) * D) + F.lane; const u32x2* y1 = (const u32x2*)(YS + (size_t)(2 * F.gw + 1) * D) + F.lane;
#pragma unroll
            for (int j = 0; j < 4; ++j) { na[j] = y0[64 * j]; nb[j] = y1[64 * j]; } } }
    for (int m = F.gw; m < M; m += F.NGW) {
        f32x4 v[4]; float s = 0.f; u32x2 ya[4], yb[4];
#pragma unroll
        for (int j = 0; j < 4; ++j) { v[j] = nv[j]; ya[j] = na[j]; yb[j] = nb[j]; }
        if (m + F.NGW < M) { const int mn = m + F.NGW; const f32x4* xr = (const f32x4*)(xin + (size_t)mn * D) + F.lane;
#pragma unroll
            for (int j = 0; j < 4; ++j) nv[j] = xr[64 * j];
            if (layer > 0) { const u32x2* y0 = (const u32x2*)(YS + (size_t)(2 * mn) * D) + F.lane; const u32x2* y1 = (const u32x2*)(YS + (size_t)(2 * mn + 1) * D) + F.lane;
#pragma unroll
                for (int j = 0; j < 4; ++j) { na[j] = y0[64 * j]; nb[j] = y1[64 * j]; } } }
        if (layer > 0) {
#pragma unroll
            for (int j = 0; j < 4; ++j) { const u32x2 a = ya[j], b = yb[j];
                v[j].x += bf2f(a.x & 0xffffu) + bf2f(b.x & 0xffffu); v[j].y += bf2f(a.x >> 16) + bf2f(b.x >> 16);
                v[j].z += bf2f(a.y & 0xffffu) + bf2f(b.y & 0xffffu); v[j].w += bf2f(a.y >> 16) + bf2f(b.y >> 16); }
            f32x4* xo = (f32x4*)(A.out + (size_t)m * D) + F.lane;
#pragma unroll
            for (int j = 0; j < 4; ++j) xo[64 * j] = v[j];
        }
#pragma unroll
        for (int j = 0; j < 4; ++j) s += (v[j].x * v[j].x + v[j].y * v[j].y) + (v[j].z * v[j].z + v[j].w * v[j].w);
        const float rstd = rsqrtf(wave_sum(s) * (1.f / D) + EPS);
        u32x2* ho = (u32x2*)(H + (size_t)m * D) + F.lane;
        float ab[8]; f32x2 ab2[8];
#pragma unroll
        for (int o = 0; o < 8; ++o) ab2[o] = (f32x2){0.f, 0.f};
#pragma unroll
        for (int j = 0; j < 4; ++j) { v[j] = v[j] * rstd * gv[j];
            u32x2 w; w.x = pk2(v[j].x, v[j].y); w.y = pk2(v[j].z, v[j].w); ho[64 * j] = w;
#pragma unroll
            for (int o = 0; o < 8; ++o) { const f32x4 wv = *((const LAS f32x4*)(wabT + o * D) + F.lane + 64 * j); ab2[o] = __builtin_elementwise_fma((f32x2){v[j].x, v[j].y}, (f32x2){wv.x, wv.y}, ab2[o]); ab2[o] = __builtin_elementwise_fma((f32x2){v[j].z, v[j].w}, (f32x2){wv.z, wv.w}, ab2[o]); } }
#pragma unroll
        for (int o = 0; o < 8; ++o) ab[o] = ab2[o].x + ab2[o].y;
        float t8[8]; fold8(ab, t8, F.lane);
        float mine = 0.f;
#pragma unroll
        for (int o = 0; o < 8; ++o) if (F.lane == o) mine = t8[o];
        if (F.lane < 8) AB[(size_t)m * 8 + F.lane] = mine;
    }
}

__device__ __forceinline__ void phase_dn_pre(const Frame& F, const Args& A, int layer) {
    const bf16_t* PROJ = (const bf16_t*)(A.ws + WS_A); float* SCR = (float*)(A.ws + WS_SCR); float* AB = (float*)(A.ws + WS_AB);
    const float* cw = A.in[I_DN_CONV] + (size_t)layer * 4 * 768;
    const float* alog = A.in[I_DN_ALOG] + layer * 4; const float* dtb = A.in[I_DN_DTB] + layer * 4;
    for (int m = F.gw; m < M; m += F.NGW) {
        const int s = m % SEQ;
#pragma unroll
        for (int j = 0; j < 12; ++j) { const int c = F.lane + 64 * j; float y = 0.f;
#pragma unroll
            for (int i = 0; i < 4; ++i) { if (s - 3 + i >= 0) y += cw[i * 768 + c] * bf2f(PROJ[(size_t)(m - 3 + i) * NPROJ + c]); }
            y = siluf(y);
            if (j < 8) { const float ss = wave_sum(y * y); y *= rsqrtf(ss + EPS) * (j < 4 ? 0.125f : 1.f); }
            SCR[(size_t)m * 768 + c] = y; }
        if (F.lane < 8) { const float a = AB[(size_t)m * 8 + F.lane]; float r;
            if (F.lane < 4) { const float x = a + dtb[F.lane]; const float sp = fmaxf(x, 0.f) + log1pf(expf(-fabsf(x))); r = -expf(alog[F.lane]) * sp; }
            else r = sigm(a);
            AB[(size_t)m * 8 + F.lane] = r; }
    }
}
__device__ __forceinline__ void phase_dn_scan_naive(const Frame& F, const Args& A) {
    if (blockIdx.x >= 32) return;
    const float* SCR = (const float*)(A.ws + WS_SCR); const float* AB = (const float*)(A.ws + WS_AB); float* O = (float*)(A.ws + WS_O);
    const int pair = blockIdx.x * 2 + (F.wave >> 2), b = pair >> 2, h = pair & 3;
    const int j = (F.wave & 3) * 16 + (F.lane >> 2), dg = F.lane & 3;
    float S[16];
#pragma unroll
    for (int i = 0; i < 16; ++i) S[i] = 0.f;
    for (int s = 0; s < SEQ; ++s) { const size_t m = (size_t)b * SEQ + s;
        const f32x4* kp = (const f32x4*)(SCR + m * 768 + 256 + h * 64 + dg * 16); const f32x4* qp = (const f32x4*)(SCR + m * 768 + h * 64 + dg * 16);
        const float v = SCR[m * 768 + 512 + h * 64 + j]; const float eg = expf(AB[m * 8 + h]), beta = AB[m * 8 + 4 + h];
        float k[16], q[16];
#pragma unroll
        for (int i = 0; i < 4; ++i) { const f32x4 a = kp[i], c = qp[i]; k[4 * i] = a.x; k[4 * i + 1] = a.y; k[4 * i + 2] = a.z; k[4 * i + 3] = a.w; q[4 * i] = c.x; q[4 * i + 1] = c.y; q[4 * i + 2] = c.z; q[4 * i + 3] = c.w; }
        float ks = 0.f;
#pragma unroll
        for (int i = 0; i < 16; ++i) ks += k[i] * S[i];
        ks += __shfl_xor(ks, 1); ks += __shfl_xor(ks, 2);
        const float c = beta * (v - eg * ks); float o = 0.f;
#pragma unroll
        for (int i = 0; i < 16; ++i) { S[i] = eg * S[i] + k[i] * c; o += q[i] * S[i]; }
        o += __shfl_xor(o, 1); o += __shfl_xor(o, 2);
        if (dg == 0) O[m * 256 + h * 64 + j] = o;
    }
}
__device__ __forceinline__ void phase_dn_gate(const Frame& F, const Args& A, int layer) {
    const bf16_t* PROJ = (const bf16_t*)(A.ws + WS_A); const float* O = (const float*)(A.ws + WS_O); bf16_t* MIXED = (bf16_t*)(A.ws + WS_MIXED);
    const float gn = A.in[I_DN_ONORM][layer * 64 + F.lane];
    for (int idx = F.gw; idx < M * DNH; idx += F.NGW) { const int m = idx >> 2, h = idx & 3;
        const float o = O[(size_t)m * 256 + h * 64 + F.lane]; const float ms = wave_sum(o * o) * (1.f / 64.f);
        const float z = bf2f(PROJ[(size_t)m * NPROJ + C_DZ + h * 64 + F.lane]);
        MIXED[(size_t)m * D + h * 64 + F.lane] = (bf16_t)f2bf(o * rsqrtf(ms + EPS) * gn * siluf(z)); }
}
__device__ __forceinline__ float t5_bias(const float* relb, int h, int dist) {
    int bucket;
    if (dist < 16) bucket = dist;
    else { const int lb = 16 + (int)(logf((float)dist / 16.f) / 4.852030263919617f * 16.f); bucket = lb < 31 ? lb : 31; }
    return relb[bucket * ATH + h];
}
__device__ __forceinline__ void phase_attn_naive(const Frame& F, const Args& A, int layer) {
    const bf16_t* PROJ = (const bf16_t*)(A.ws + WS_A); bf16_t* MIXED = (bf16_t*)(A.ws + WS_MIXED);
    LAS float* qk = (LAS float*)(F.lds + F.wave * 4096); LAS float* pl = qk + 64;
    const float qn = A.in[I_AT_QN][layer * 64 + F.lane], kn = A.in[I_AT_KN][layer * 64 + F.lane];
    const float* relb = A.in[I_RELB];
    const int dil[3] = {1, 4, 16};
    for (int idx = F.gw; idx < M * ATH; idx += F.NGW) { const int m = idx >> 3, h = idx & 7, s = m % SEQ;
        const float qv = bf2f(PROJ[(size_t)m * NPROJ + C_AQ + h * 64 + F.lane]);
        const float qss = wave_sum(qv * qv) * (1.f / 64.f);
        qk[F.lane] = qv * rsqrtf(qss + EPS) * qn * 0.125f * kn;
        LDS_WAIT(); asm volatile("" ::: "memory");
        float sc[9]; float mx = -1e30f;
#pragma unroll
        for (int di = 0; di < 3; ++di)
#pragma unroll
            for (int jb = 0; jb < 3; ++jb) { const int j = jb * 64 + F.lane, p = s - j * dil[di]; float v = -1e30f;
                if (j <= 128 && p >= 0) { const u32x4* kr = (const u32x4*)(PROJ + (size_t)(m - j * dil[di]) * NPROJ + C_AK + h * 64);
                    float dot = 0.f, ss = 0.f;
#pragma unroll
                    for (int c = 0; c < 8; ++c) { const u32x4 w = kr[c]; const unsigned ww[4] = {w.x, w.y, w.z, w.w};
#pragma unroll
                        for (int e = 0; e < 4; ++e) { const float k0 = bf2f(ww[e] & 0xffffu), k1 = bf2f(ww[e] >> 16);
                            dot += k0 * qk[c * 8 + 2 * e] + k1 * qk[c * 8 + 2 * e + 1]; ss += k0 * k0 + k1 * k1; } }
                    v = dot * rsqrtf(ss * (1.f / 64.f) + EPS) + t5_bias(relb, h, dil[di] * j); }
                sc[di * 3 + jb] = v; mx = fmaxf(mx, v); }
        mx = wave_max(mx);
        float sum = 0.f;
#pragma unroll
        for (int i = 0; i < 9; ++i) { const float p = sc[i] > -1e29f ? expf(sc[i] - mx) : 0.f; sum += p; pl[i * 64 + F.lane] = p; }
        sum = wave_sum(sum);
        LDS_WAIT(); asm volatile("" ::: "memory");
        float o = 0.f;
#pragma unroll 1
        for (int di = 0; di < 3; ++di) { const int jmax = (s / dil[di]) < 128 ? (s / dil[di]) : 128;
            for (int j = 0; j <= jmax; ++j) o += pl[(di * 3 + (j >> 6)) * 64 + (j & 63)] * bf2f(PROJ[(size_t)(m - j * dil[di]) * NPROJ + C_AV + h * 64 + F.lane]); }
        MIXED[(size_t)m * D + 256 + h * 64 + F.lane] = (bf16_t)f2bf(o / sum);
        LDS_WAIT(); asm volatile("" ::: "memory");
    }
}


typedef float f32x16 __attribute__((ext_vector_type(16)));
typedef short s16x4 __attribute__((ext_vector_type(4)));
#define MFMA32(a, b, c) __builtin_amdgcn_mfma_f32_32x32x16_bf16((a), (b), (c), 0, 0, 0)
__device__ __forceinline__ int crow(int i, int h) { return (i & 3) + 8 * (i >> 2) + 4 * h; }
__device__ __forceinline__ unsigned cvtpk(float lo, float hi) { return pg8::cvt_pk_bf16(lo, hi); }
__device__ __forceinline__ bf16x8 pack8(const f32x16& x, int s) {
    u32x4 w; w.x = cvtpk(x[8 * s], x[8 * s + 1]); w.y = cvtpk(x[8 * s + 2], x[8 * s + 3]); w.z = cvtpk(x[8 * s + 4], x[8 * s + 5]); w.w = cvtpk(x[8 * s + 6], x[8 * s + 7]);
    return __builtin_bit_cast(bf16x8, w);
}
__device__ __forceinline__ f32x16 zero16() { f32x16 z;
#pragma unroll
    for (int i = 0; i < 16; ++i) z[i] = 0.f;
    return z; }
__device__ __forceinline__ float fsilu(float y) { return y * __builtin_amdgcn_rcpf(1.f + __expf(-y)); }

namespace att {
constexpr int TB_STRIDE = 200, TB_PAD = 32;
constexpr int TB_OFF = RING_BYTES;
constexpr float LOG2E = 1.4426950408889634f;
struct Sub { int b, h, dil, di, res, n; };
__device__ __forceinline__ void build_table(const Frame& F, const float* relb) {
    LAS float* T = (LAS float*)(F.lds + TB_OFF);
    for (int e = F.tid; e < 3 * 8 * TB_STRIDE; e += NTHREADS) { const int di = e / (8 * TB_STRIDE), h = (e / TB_STRIDE) % 8, x = e % TB_STRIDE - TB_PAD; const int rel = 128 - x;
        float v = -1e30f;
        if (rel >= 0 && rel <= 128) { const int dist = rel * (di == 0 ? 1 : di == 1 ? 4 : 16); v = t5_bias(relb, h, dist) * LOG2E; }
        T[e] = v; }
}
struct KV { u32x4 kr[8], vr[8]; bf16x8 qf[4]; };
__device__ __forceinline__ void fetch(const Frame& F, const Args& A, const Sub& sb, KV& R) {
    const bf16_t* PROJ = (const bf16_t*)(A.ws + WS_A);
    const int wq = F.wave & 3, r = F.lane & 31, hh = F.lane >> 5; const size_t tok0 = (size_t)sb.b * SEQ;
    const int ht = F.tid & 255, c = ht & 7; const int kstart = sb.n == 0 ? 128 : 0;
#pragma unroll
    for (int i = 0; i < 8; ++i) { const int kj = (ht >> 3) + 32 * i;
        if (kj >= kstart) { const int p = (sb.n - 1) * 128 + kj; const bf16_t* row = PROJ + (tok0 + (size_t)p * sb.dil + sb.res) * NPROJ + sb.h * 64 + c * 8;
            R.kr[i] = *(const u32x4*)(row + C_AK); R.vr[i] = *(const u32x4*)(row + C_AV); } }
    const int qpos = sb.n * 128 + wq * 32 + r; const size_t mq = tok0 + (size_t)qpos * sb.dil + sb.res;
#pragma unroll
    for (int s = 0; s < 4; ++s) R.qf[s] = *(const bf16x8*)(PROJ + mq * NPROJ + C_AQ + sb.h * 64 + 16 * s + 8 * hh);
}
__device__ __forceinline__ void commit(const Frame& F, const Sub& sb, const KV& R) {
    const int sub = F.wave >> 2; LAS unsigned char* Kb = F.lds + sub * 65536; LAS unsigned char* Vb = Kb + 32768;
    const int ht = F.tid & 255, c = ht & 7; const int kstart = sb.n == 0 ? 128 : 0;
#pragma unroll
    for (int i = 0; i < 8; ++i) { const int kj = (ht >> 3) + 32 * i;
        if (kj >= kstart) { *(LAS u32x4*)(Kb + kj * 128 + ((c ^ ((kj >> 1) & 7)) << 4)) = R.kr[i]; *(LAS u32x4*)(Vb + kj * 128 + ((c ^ (((kj >> 1) & 1) << 2)) << 4)) = R.vr[i]; } }
}
template <bool COMBINE>
__device__ __forceinline__ void compute(const Frame& F, const Args& A, const Sub& sb, const bf16x8 (&qf)[4]) {
    const int sub = F.wave >> 2, wq = F.wave & 3, lane = F.lane, r = lane & 31, hh = lane >> 5;
    LAS unsigned char* Kb = F.lds + sub * 65536; LAS unsigned char* Vb = Kb + 32768;
    const size_t tok0 = (size_t)sb.b * SEQ;
    const int qpos = sb.n * 128 + wq * 32 + r; const size_t mq = tok0 + (size_t)qpos * sb.dil + sb.res;
    const int dmin = sb.n == 0 ? 4 - wq : 0;
    const LAS float* T = (const LAS float*)(F.lds + TB_OFF) + (sb.di * 8 + sb.h) * TB_STRIDE + TB_PAD - r + 4 * hh;
    f32x16 p[5]; float mx = -1e30f;
#pragma unroll
    for (int t = 0; t < 5; ++t) {
        if (t >= dmin) { const int row = (wq + t) * 32 + r; f32x16 acc;
#pragma unroll
            for (int i = 0; i < 16; ++i) acc[i] = 0.f;
#pragma unroll
            for (int s = 0; s < 4; ++s) { const bf16x8 kf = *(const LAS bf16x8*)(Kb + row * 128 + (((2 * s + hh) ^ ((row >> 1) & 7)) << 4));
                acc = __builtin_amdgcn_mfma_f32_32x32x16_bf16(kf, qf[s], acc, 0, 0, 0); }
#pragma unroll
            for (int i = 0; i < 16; ++i) { acc[i] += T[32 * t + (i & 3) + 8 * (i >> 2)]; mx = fmaxf(mx, acc[i]); }
            p[t] = acc; }
    }
    mx = fmaxf(mx, __shfl_xor(mx, 32));
    float l = 0.f;
#pragma unroll
    for (int t = 0; t < 5; ++t) if (t >= dmin) {
#pragma unroll
        for (int i = 0; i < 16; ++i) { const float e = __builtin_amdgcn_exp2f(p[t][i] - mx); p[t][i] = e; l += e; } }
    l += __shfl_xor(l, 32);
    f32x16 o[2];
#pragma unroll
    for (int i = 0; i < 16; ++i) { o[0][i] = 0.f; o[1][i] = 0.f; }
    const int q4 = (lane & 15) >> 2, p4 = lane & 3, blk = (lane >> 4) & 1, sw = (lane >> 3) & 1;
    const int vlane = (4 * hh + q4) * 128 + ((2 * blk + (p4 >> 1)) << 4) + 8 * (p4 & 1);
    const int voff0 = vlane + sw * 64, voff1 = vlane + (1 - sw) * 64;
#pragma unroll
    for (int t = 0; t < 5; ++t) if (t >= dmin) {
#pragma unroll
        for (int s = 0; s < 2; ++s) { const bf16x8 pf = pack8(p[t], s); const int rowb = ((wq + t) * 32 + 16 * s) * 128;
            const s16x4 a0 = __builtin_amdgcn_ds_read_tr16_b64_v4i16((LAS s16x4*)(Vb + rowb + voff0)), a1 = __builtin_amdgcn_ds_read_tr16_b64_v4i16((LAS s16x4*)(Vb + rowb + 1024 + voff0));
            const s16x4 b0 = __builtin_amdgcn_ds_read_tr16_b64_v4i16((LAS s16x4*)(Vb + rowb + voff1)), b1 = __builtin_amdgcn_ds_read_tr16_b64_v4i16((LAS s16x4*)(Vb + rowb + 1024 + voff1));
            const bf16x8 v0 = __builtin_shufflevector(a0, a1, 0, 1, 2, 3, 4, 5, 6, 7), v1 = __builtin_shufflevector(b0, b1, 0, 1, 2, 3, 4, 5, 6, 7);
            o[0] = __builtin_amdgcn_mfma_f32_32x32x16_bf16(v0, pf, o[0], 0, 0, 0);
            o[1] = __builtin_amdgcn_mfma_f32_32x32x16_bf16(v1, pf, o[1], 0, 0, 0); } }
    const float inv = 1.f / l; const float lse2 = mx + __builtin_amdgcn_logf(l);
    if (COMBINE) {
        const bf16_t* O4 = (const bf16_t*)(A.ws + WS_ATTO); const bf16_t* O16 = O4 + (size_t)M * 512; const float* L4 = (const float*)(A.ws + WS_ATTL); const float* L16 = L4 + (size_t)M * 8;
        const float l4 = L4[mq * 8 + sb.h], l16 = L16[mq * 8 + sb.h]; const float mm = fmaxf(lse2, fmaxf(l4, l16));
        const float w1 = __builtin_amdgcn_exp2f(lse2 - mm), w4 = __builtin_amdgcn_exp2f(l4 - mm), w16 = __builtin_amdgcn_exp2f(l16 - mm); const float wi = 1.f / (w1 + w4 + w16);
        const float c1 = w1 * wi * inv, c4 = w4 * wi, c16 = w16 * wi;
        bf16_t* MX = (bf16_t*)(A.ws + WS_MIXED) + mq * D + 256 + sb.h * 64;
#pragma unroll
        for (int dt = 0; dt < 2; ++dt)
#pragma unroll
            for (int g = 0; g < 4; ++g) { const int d = 32 * dt + 8 * g + 4 * hh; const u32x2 a = *(const u32x2*)(O4 + mq * 512 + sb.h * 64 + d), b = *(const u32x2*)(O16 + mq * 512 + sb.h * 64 + d);
                const float y0 = c1 * o[dt][4 * g] + c4 * bf2f(a.x & 0xffffu) + c16 * bf2f(b.x & 0xffffu), y1 = c1 * o[dt][4 * g + 1] + c4 * bf2f(a.x >> 16) + c16 * bf2f(b.x >> 16);
                const float y2 = c1 * o[dt][4 * g + 2] + c4 * bf2f(a.y & 0xffffu) + c16 * bf2f(b.y & 0xffffu), y3 = c1 * o[dt][4 * g + 3] + c4 * bf2f(a.y >> 16) + c16 * bf2f(b.y >> 16);
                u32x2 w; w.x = cvtpk(y0, y1); w.y = cvtpk(y2, y3); *(u32x2*)(MX + d) = w; }
    } else {
        bf16_t* OD = (bf16_t*)(A.ws + WS_ATTO) + (size_t)(sb.di - 1) * M * 512 + mq * 512 + sb.h * 64; float* LD = (float*)(A.ws + WS_ATTL) + (size_t)(sb.di - 1) * M * 8;
#pragma unroll
        for (int dt = 0; dt < 2; ++dt)
#pragma unroll
            for (int g = 0; g < 4; ++g) { const int d = 32 * dt + 8 * g + 4 * hh;
                u32x2 w; w.x = cvtpk(o[dt][4 * g] * inv, o[dt][4 * g + 1] * inv); w.y = cvtpk(o[dt][4 * g + 2] * inv, o[dt][4 * g + 3] * inv); *(u32x2*)(OD + d) = w; }
        if (hh == 0) LD[mq * 8 + sb.h] = lse2;
    }
}
__device__ __forceinline__ Sub decode_a(int bi, int sub) { const int round = bi >> 8, j = bi & 255; Sub sb;
    if (round < 4) { const int id = round * 256 + j, bh = id >> 3, kk = 2 * (id & 7) + sub; sb.b = bh >> 3; sb.h = bh & 7; sb.dil = 4; sb.di = 1; sb.res = kk >> 2; sb.n = kk & 3; }
    else { const int id = (round - 4) * 256 + j, bh = id >> 3, kk = 2 * (id & 7) + sub; sb.b = bh >> 3; sb.h = bh & 7; sb.dil = 16; sb.di = 2; sb.res = kk; sb.n = 0; }
    return sb; }
__device__ __forceinline__ Sub decode_b(int bi, int sub) { const int bh = bi >> 3; Sub sb; sb.b = bh >> 3; sb.h = bh & 7; sb.dil = 1; sb.di = 0; sb.res = 0; sb.n = 2 * (bi & 7) + sub; return sb; }
__device__ __forceinline__ void phase_a(const Frame& F, const Args& A, unsigned* qhead) {
    build_table(F, A.in[I_RELB]);
    volatile LAS unsigned* slot = F.MISC + 16;
    if (F.tid == 0) { slot[0] = __hip_atomic_fetch_add(qhead, 1u, RLX_AGENT); slot[1] = __hip_atomic_fetch_add(qhead, 1u, RLX_AGENT); }
    __syncthreads();
    const int sub = F.wave >> 2;
    int bi = (int)slot[0]; if (bi >= 2048) return;
    Sub cur = decode_a(bi, sub); KV R; fetch(F, A, cur, R); commit(F, cur, R);
    bf16x8 qf[4];
#pragma unroll
    for (int s = 0; s < 4; ++s) qf[s] = R.qf[s];
    __syncthreads();
    for (int k = 0;; ++k) {
        const int nb = (int)slot[(k + 1) & 1]; const bool has_next = nb < 2048; Sub nxt = cur;
        if (has_next) { nxt = decode_a(nb, sub); fetch(F, A, nxt, R); }
        compute<false>(F, A, cur, qf);
        __syncthreads();
        if (F.tid == 0) slot[k & 1] = __hip_atomic_fetch_add(qhead, 1u, RLX_AGENT);
        if (!has_next) break;
        commit(F, nxt, R);
#pragma unroll
        for (int s = 0; s < 4; ++s) qf[s] = R.qf[s];
        __syncthreads();
        cur = nxt;
    }
}
__device__ __forceinline__ void phase_b(const Frame& F, const Args& A) {
    build_table(F, A.in[I_RELB]); __syncthreads();
    const int sub = F.wave >> 2;
    int bi = F.vcu; if (bi >= 1024) return;
    Sub cur = decode_b(bi, sub); KV R; fetch(F, A, cur, R); commit(F, cur, R);
    bf16x8 qf[4];
#pragma unroll
    for (int s = 0; s < 4; ++s) qf[s] = R.qf[s];
    __syncthreads();
    for (;;) {
        const int nb = bi + F.G; const bool has_next = nb < 1024; Sub nxt = cur;
        if (has_next) { nxt = decode_b(nb, sub); fetch(F, A, nxt, R); }
        compute<true>(F, A, cur, qf);
        __syncthreads();
        if (!has_next) break;
        commit(F, nxt, R);
#pragma unroll
        for (int s = 0; s < 4; ++s) qf[s] = R.qf[s];
        __syncthreads();
        cur = nxt; bi = nb;
    }
}
__device__ __forceinline__ void phase_qknorm(const Frame& F, const Args& A, int layer) {
    bf16_t* PROJ = (bf16_t*)(A.ws + WS_A);
    const int d0 = (F.lane & 7) * 8; float qs[8];
#pragma unroll
    for (int e = 0; e < 8; ++e) qs[e] = A.in[I_AT_QN][layer * 64 + d0 + e] * A.in[I_AT_KN][layer * 64 + d0 + e] * 0.125f * LOG2E;
    for (int m = F.gw; m < M; m += F.NGW) { bf16_t* row = PROJ + (size_t)m * NPROJ + C_AQ + F.lane * 8;
#pragma unroll
        for (int part = 0; part < 2; ++part) { u32x4* p = (u32x4*)(row + part * 512); const u32x4 w = *p; const unsigned ww[4] = {w.x, w.y, w.z, w.w}; float v[8]; float ss = 0.f;
#pragma unroll
            for (int e = 0; e < 4; ++e) { v[2 * e] = bf2f(ww[e] & 0xffffu); v[2 * e + 1] = bf2f(ww[e] >> 16); ss += v[2 * e] * v[2 * e] + v[2 * e + 1] * v[2 * e + 1]; }
            ss += __shfl_xor(ss, 1); ss += __shfl_xor(ss, 2); ss += __shfl_xor(ss, 4);
            const float rs = rsqrtf(ss * (1.f / 64.f) + EPS); u32x4 o;
            if (part == 0) { o.x = cvtpk(v[0] * rs * qs[0], v[1] * rs * qs[1]); o.y = cvtpk(v[2] * rs * qs[2], v[3] * rs * qs[3]); o.z = cvtpk(v[4] * rs * qs[4], v[5] * rs * qs[5]); o.w = cvtpk(v[6] * rs * qs[6], v[7] * rs * qs[7]); }
            else { o.x = cvtpk(v[0] * rs, v[1] * rs); o.y = cvtpk(v[2] * rs, v[3] * rs); o.z = cvtpk(v[4] * rs, v[5] * rs); o.w = cvtpk(v[6] * rs, v[7] * rs); }
            *p = o; } }
}
}


namespace dn {
constexpr int BUFB = 67 * 128, WV_SMALL = 1536, WV_BYTES = 2 * BUFB + WV_SMALL;
constexpr int IT_BYTES = 40960, F_W = 0, F_QD = 8, F_QK = 16, F_KD = 22, F_U = 30, GL_OFF = 38912;
static_assert(8 * WV_BYTES <= LDSCTL_OFF, "DN-1 LDS");
__device__ __forceinline__ int sw16(int row, int chunk) { return row * 128 + ((chunk ^ ((row >> 1) & 7)) << 4); }
__device__ __forceinline__ void stage_raw(LAS unsigned char* buf, const bf16_t* colbase  , int n, int lane) {
#pragma unroll
    for (int i = 0; i < 9; ++i) { const int e = lane + 64 * i;
        if (e < 67 * 8) { const int row = e >> 3, c = e & 7, s = n * 64 + row - 3; u32x4 v = {0u, 0u, 0u, 0u};
            if (s >= 0) v = *(const u32x4*)(colbase + (size_t)s * NPROJ + c * 8);
            *(LAS u32x4*)(buf + sw16(row, c)) = v; } }
}
template <bool ROWS, bool TR>
__device__ __forceinline__ float conv64(LAS unsigned char* buf, LAS unsigned char* bufT, const float* cw, int lane) {
    float ss = 0.f;
#pragma unroll 1
    for (int c8 = 0; c8 < 8; ++c8) {
        u32x4 x[4];
#pragma unroll
        for (int tap = 0; tap < 4; ++tap) x[tap] = *(const LAS u32x4*)(buf + sw16(lane + tap, c8));
        unsigned yp[4];
#pragma unroll
        for (int e = 0; e < 4; ++e) { float y0 = 0.f, y1 = 0.f;
#pragma unroll
            for (int tap = 0; tap < 4; ++tap) { const unsigned w = x[tap][e]; y0 += cw[tap * 768 + 8 * c8 + 2 * e] * bf2f(w & 0xffffu); y1 += cw[tap * 768 + 8 * c8 + 2 * e + 1] * bf2f(w >> 16); }
            y0 = fsilu(y0); y1 = fsilu(y1); ss += y0 * y0 + y1 * y1; yp[e] = cvtpk(y0, y1); }
        if (ROWS) *(LAS u32x4*)(buf + sw16(lane, c8)) = (u32x4){yp[0], yp[1], yp[2], yp[3]};
        if (TR) {
#pragma unroll
            for (int e = 0; e < 4; ++e) { *(LAS unsigned short*)(bufT + sw16(8 * c8 + 2 * e, lane >> 3) + (lane & 7) * 2) = (unsigned short)(yp[e] & 0xffffu);
                *(LAS unsigned short*)(bufT + sw16(8 * c8 + 2 * e + 1, lane >> 3) + (lane & 7) * 2) = (unsigned short)(yp[e] >> 16); } } }
    return ss;
}
__device__ __forceinline__ u32x2 rd8(const LAS unsigned char* buf, int row, int e0) { return *(const LAS u32x2*)(buf + sw16(row, e0 >> 3) + (e0 & 4) * 2); }
__device__ __forceinline__ bf16x8 frag_perm(const LAS unsigned char* buf, int row, int ebase, int s, int hh) {
    const u32x2 a = rd8(buf, row, ebase + 16 * s + 4 * hh), b = rd8(buf, row, ebase + 16 * s + 8 + 4 * hh); u32x4 w = {a.x, a.y, b.x, b.y}; return __builtin_bit_cast(bf16x8, w); }
__device__ __forceinline__ bf16x8 frag_perm_scaled(const LAS unsigned char* buf, int row, int ebase, int s, int hh, f32x4 s0, f32x4 s1) {
    const u32x2 a = rd8(buf, row, ebase + 16 * s + 4 * hh), b = rd8(buf, row, ebase + 16 * s + 8 + 4 * hh);
    u32x4 w; w.x = cvtpk(bf2f(a.x & 0xffffu) * s0.x, bf2f(a.x >> 16) * s0.y); w.y = cvtpk(bf2f(a.y & 0xffffu) * s0.z, bf2f(a.y >> 16) * s0.w);
    w.z = cvtpk(bf2f(b.x & 0xffffu) * s1.x, bf2f(b.x >> 16) * s1.y); w.w = cvtpk(bf2f(b.y & 0xffffu) * s1.z, bf2f(b.y >> 16) * s1.w); return __builtin_bit_cast(bf16x8, w); }
__device__ __forceinline__ bf16x8 frag_row(const LAS unsigned char* buf, int row, int s, int hh) { return *(const LAS bf16x8*)(buf + sw16(row, 2 * s + hh)); }
__device__ __forceinline__ void dump(unsigned char* it, int f, int lane, bf16x8 v) { *(bf16x8*)(it + f * 1024 + lane * 16) = v; }
__device__ __forceinline__ void invert32(f32x16 X, f32x16 Y, f32x16& TT, int r, int hh) {
#pragma unroll
    for (int i = 0; i < 16; ++i) { const float id = (crow(i, hh) == r) ? 1.f : 0.f; TT[i] = id + Y[i]; }
#pragma unroll
    for (int lev = 0; lev < 4; ++lev) {
        { const bf16x8 x0 = pack8(X, 0), x1 = pack8(X, 1), y0 = pack8(Y, 0), y1 = pack8(Y, 1);
          f32x16 Xn = MFMA32(y0, x0, zero16()); Xn = MFMA32(y1, x1, Xn);
          if (lev < 3) { f32x16 Yn = MFMA32(x0, y0, zero16()); Yn = MFMA32(x1, y1, Yn); Y = Yn; }
          X = Xn; }
        const bf16x8 n0 = pack8(X, 0), n1 = pack8(X, 1), t0 = pack8(TT, 0), t1 = pack8(TT, 1);
        f32x16 TTn = MFMA32(n0, t0, TT); TTn = MFMA32(n1, t1, TTn);
        TT = TTn;
    }
}
__device__ __forceinline__ f32x16 transpose32(const f32x16& X, LAS float* scr, int r, int hh) {
#pragma unroll
    for (int i = 0; i < 16; ++i) scr[r * 33 + crow(i, hh)] = X[i];
    f32x16 T;
#pragma unroll
    for (int i = 0; i < 16; ++i) T[i] = scr[crow(i, hh) * 33 + r];
    return T;
}
__device__ __forceinline__ void make_xy(const f32x16& kk, const LAS float* Gs, const LAS float* BR, const LAS float* RK, int blk, float Gc, float rkc, float brc, int r, int hh, f32x16& X, f32x16& Y) {
#pragma unroll
    for (int g4 = 0; g4 < 4; ++g4) { const f32x4 Ga = *(const LAS f32x4*)(Gs + blk * 32 + 8 * g4 + 4 * hh), bra = *(const LAS f32x4*)(BR + blk * 32 + 8 * g4 + 4 * hh), rka = *(const LAS f32x4*)(RK + blk * 32 + 8 * g4 + 4 * hh);
#pragma unroll
        for (int e = 0; e < 4; ++e) { const int i = 4 * g4 + e, a = 8 * g4 + 4 * hh + e;
            X[i] = a > r ? -(bra[e] * rkc * __expf(fminf(Ga[e] - Gc, 0.f))) * kk[i] : 0.f;
            Y[i] = r > a ? -(brc * rka[e] * __expf(fminf(Gc - Ga[e], 0.f))) * kk[i] : 0.f; } }
}
__device__ __forceinline__ void dn1_item(LAS unsigned char* wl, const Args& A, int layer, int b, int h, int n, int lane_in) {
    int lane = lane_in; asm volatile("" : "+v"(lane));
    LAS unsigned char* bufX = wl; LAS unsigned char* bufY = wl + BUFB;
    LAS float* Gs = (LAS float*)(wl + 2 * BUFB); LAS float* RK = Gs + 64; LAS float* BR = Gs + 128; LAS float* SW = Gs + 192; LAS float* SB = Gs + 256; LAS float* SK = Gs + 320;
    const bf16_t* PROJ = (const bf16_t*)(A.ws + WS_A) + (size_t)b * SEQ * NPROJ + h * 64;
    const float* cw = A.in[I_DN_CONV] + (size_t)layer * 4 * 768 + h * 64;
    unsigned char* item = A.ws + WS_SCR + (size_t)((b * 4 + h) * 32 + n) * IT_BYTES;
    int r = lane & 31, hh = lane >> 5;
    const size_t m = (size_t)b * SEQ + n * 64 + lane;
    stage_raw(bufX, PROJ + C_DK, n, lane);
    stage_raw(bufY, PROJ + C_DQ, n, lane);
    const float ssk = conv64<true, false>(bufX, bufX, cw + 256, lane);
    const float rk = rsqrtf(ssk + EPS);
    const float* AB = (const float*)(A.ws + WS_AB);
    const float av = AB[m * 8 + h], bv = AB[m * 8 + 4 + h];
    float g; { const float x = av + A.in[I_DN_DTB][layer * 4 + h]; const float sp = fmaxf(x, 0.f) + log1pf(expf(-fabsf(x))); g = -expf(A.in[I_DN_ALOG][layer * 4 + h]) * sp; }
    const float beta = 1.f / (1.f + expf(-bv));
    float G = g;
#pragma unroll
    for (int o = 1; o < 64; o <<= 1) { const float t = __shfl_up(G, o); if (lane >= o) G += t; }
    const float Glast = __shfl(G, 63);
    Gs[lane] = G; RK[lane] = rk; BR[lane] = beta * rk; SW[lane] = beta * rk * expf(G); SB[lane] = beta; SK[lane] = rk * expf(Glast - G);
    const float ssq = conv64<true, false>(bufY, bufY, cw, lane);
    const float rqe = rsqrtf(ssq + EPS) * 0.125f;
    const float Gc0 = __shfl(G, r), Gc1 = __shfl(G, 32 + r), rkc0 = __shfl(rk, r), rkc1 = __shfl(rk, 32 + r);
    const float brc0 = __shfl(beta * rk, r), brc1 = __shfl(beta * rk, 32 + r), rqc0 = __shfl(rqe, r), rqc1 = __shfl(rqe, 32 + r);
    __builtin_amdgcn_sched_barrier(0); asm volatile("" : "+v"(lane)); r = lane & 31; hh = lane >> 5;
#pragma unroll
    for (int tile = 0; tile < 3; ++tile) { const int jt = tile == 2 ? 1 : 0, it = tile == 0 ? 0 : 1;
        f32x16 acc = zero16();
#pragma unroll
        for (int s = 0; s < 4; ++s) acc = MFMA32(frag_row(bufX, jt * 32 + r, s, hh), frag_row(bufY, it * 32 + r, s, hh), acc);
        const float Gi = it ? Gc1 : Gc0, rqi = it ? rqc1 : rqc0;
#pragma unroll
        for (int g4 = 0; g4 < 4; ++g4) { const f32x4 Gj = *(const LAS f32x4*)(Gs + jt * 32 + 8 * g4 + 4 * hh), rkj = *(const LAS f32x4*)(RK + jt * 32 + 8 * g4 + 4 * hh);
#pragma unroll
            for (int e = 0; e < 4; ++e) { const int i = 4 * g4 + e; const int jrow = 8 * g4 + 4 * hh + e;
                const float v = rqi * rkj[e] * __expf(fminf(Gi - Gj[e], 0.f)) * acc[i];
                acc[i] = (tile == 1 || r >= jrow) ? v : 0.f; } }
        dump(item, F_QK + tile * 2, lane, pack8(acc, 0)); dump(item, F_QK + tile * 2 + 1, lane, pack8(acc, 1)); }
    __builtin_amdgcn_sched_barrier(0); asm volatile("" : "+v"(lane)); r = lane & 31; hh = lane >> 5;
#pragma unroll
    for (int it = 0; it < 2; ++it) { const float sc = (it ? rqc1 : rqc0) * __expf(it ? Gc1 : Gc0); const f32x4 s4 = {sc, sc, sc, sc};
#pragma unroll
        for (int dkt = 0; dkt < 2; ++dkt)
#pragma unroll
            for (int s = 0; s < 2; ++s) dump(item, F_QD + it * 4 + dkt * 2 + s, lane, frag_perm_scaled(bufY, it * 32 + r, dkt * 32, s, hh, s4, s4)); }
    __builtin_amdgcn_sched_barrier(0); asm volatile("" : "+v"(lane)); r = lane & 31; hh = lane >> 5;
    f32x16 TT1, TT2, TT21;
    {
        { f32x16 kk = zero16();
#pragma unroll
          for (int s = 0; s < 4; ++s) { const bf16x8 f = frag_row(bufX, r, s, hh); kk = MFMA32(f, f, kk); }
          f32x16 X, Y; make_xy(kk, Gs, BR, RK, 0, Gc0, rkc0, brc0, r, hh, X, Y);
          invert32(X, Y, TT1, r, hh); }
        __builtin_amdgcn_sched_barrier(0); asm volatile("" : "+v"(lane)); r = lane & 31; hh = lane >> 5;
        { f32x16 kk = zero16();
#pragma unroll
          for (int s = 0; s < 4; ++s) { const bf16x8 f = frag_row(bufX, 32 + r, s, hh); kk = MFMA32(f, f, kk); }
          f32x16 X, Y; make_xy(kk, Gs, BR, RK, 1, Gc1, rkc1, brc1, r, hh, X, Y);
          invert32(X, Y, TT2, r, hh); }
        __builtin_amdgcn_sched_barrier(0); asm volatile("" : "+v"(lane)); r = lane & 31; hh = lane >> 5;
        f32x16 kk = zero16();
#pragma unroll
        for (int s = 0; s < 4; ++s) kk = MFMA32(frag_row(bufX, 32 + r, s, hh), frag_row(bufX, r, s, hh), kk);
#pragma unroll
        for (int g4 = 0; g4 < 4; ++g4) { const f32x4 Ga = *(const LAS f32x4*)(Gs + 32 + 8 * g4 + 4 * hh), bra = *(const LAS f32x4*)(BR + 32 + 8 * g4 + 4 * hh);
#pragma unroll
            for (int e = 0; e < 4; ++e) { const int i = 4 * g4 + e; kk[i] = (bra[e] * rkc0 * __expf(fminf(Ga[e] - Gc0, 0.f))) * kk[i]; } }
        f32x16 Q1 = MFMA32(pack8(kk, 0), pack8(TT2, 0), zero16()); Q1 = MFMA32(pack8(kk, 1), pack8(TT2, 1), Q1);
        const f32x16 T1 = transpose32(TT1, (LAS float*)bufY, r, hh);
        f32x16 P = MFMA32(pack8(T1, 0), pack8(Q1, 0), zero16()); P = MFMA32(pack8(T1, 1), pack8(Q1, 1), P);
#pragma unroll
        for (int i = 0; i < 16; ++i) TT21[i] = -P[i];
    }
    __builtin_amdgcn_sched_barrier(0); asm volatile("" : "+v"(lane)); r = lane & 31; hh = lane >> 5;
    stage_raw(bufX, PROJ + C_DK, n, lane);
    (void)conv64<false, true>(bufX, bufY, cw + 256, lane);
    __builtin_amdgcn_sched_barrier(0); asm volatile("" : "+v"(lane)); r = lane & 31; hh = lane >> 5;
#pragma unroll
    for (int dkt = 0; dkt < 2; ++dkt)
#pragma unroll
        for (int tt = 0; tt < 2; ++tt)
#pragma unroll
            for (int s = 0; s < 2; ++s) { const f32x4 s0 = *(const LAS f32x4*)(SK + tt * 32 + 16 * s + 4 * hh), s1 = *(const LAS f32x4*)(SK + tt * 32 + 16 * s + 8 + 4 * hh);
                dump(item, F_KD + dkt * 4 + tt * 2 + s, lane, frag_perm_scaled(bufY, dkt * 32 + r, tt * 32, s, hh, s0, s1)); }

    __builtin_amdgcn_sched_barrier(0); asm volatile("" : "+v"(lane)); r = lane & 31; hh = lane >> 5;
    {
        bf16x8 wB[3][2];
#pragma unroll
        for (int tile = 0; tile < 3; ++tile) { const int jt = tile == 2 ? 1 : 0; const f32x16& TTx = tile == 0 ? TT1 : tile == 1 ? TT21 : TT2; f32x16 a;
#pragma unroll
            for (int g4 = 0; g4 < 4; ++g4) { const f32x4 sw = *(const LAS f32x4*)(SW + jt * 32 + 8 * g4 + 4 * hh);
#pragma unroll
                for (int e = 0; e < 4; ++e) a[4 * g4 + e] = TTx[4 * g4 + e] * sw[e]; }
            wB[tile][0] = pack8(a, 0); wB[tile][1] = pack8(a, 1); }
#pragma unroll
        for (int dkt = 0; dkt < 2; ++dkt) {
            const bf16x8 x00 = frag_perm(bufY, dkt * 32 + r, 0, 0, hh), x01 = frag_perm(bufY, dkt * 32 + r, 0, 1, hh), x10 = frag_perm(bufY, dkt * 32 + r, 32, 0, hh), x11 = frag_perm(bufY, dkt * 32 + r, 32, 1, hh);
            f32x16 w0 = MFMA32(x00, wB[0][0], zero16()); w0 = MFMA32(x01, wB[0][1], w0);
            f32x16 w1 = MFMA32(x00, wB[1][0], zero16()); w1 = MFMA32(x01, wB[1][1], w1); w1 = MFMA32(x10, wB[2][0], w1); w1 = MFMA32(x11, wB[2][1], w1);
#pragma unroll
            for (int i = 0; i < 16; ++i) { w0[i] = -w0[i]; w1[i] = -w1[i]; }
            dump(item, F_W + 0 * 4 + dkt * 2 + 0, lane, pack8(w0, 0)); dump(item, F_W + 0 * 4 + dkt * 2 + 1, lane, pack8(w0, 1));
            dump(item, F_W + 1 * 4 + dkt * 2 + 0, lane, pack8(w1, 0)); dump(item, F_W + 1 * 4 + dkt * 2 + 1, lane, pack8(w1, 1)); }
    }
    __builtin_amdgcn_sched_barrier(0); asm volatile("" : "+v"(lane)); r = lane & 31; hh = lane >> 5;
    stage_raw(bufX, PROJ + C_DV, n, lane);
    (void)conv64<false, true>(bufX, bufY, cw + 512, lane);
    __builtin_amdgcn_sched_barrier(0); asm volatile("" : "+v"(lane)); r = lane & 31; hh = lane >> 5;
    {
        bf16x8 uA[3][2];
#pragma unroll
        for (int tile = 0; tile < 3; ++tile) { const int jt = tile == 2 ? 1 : 0; const f32x16& TTx = tile == 0 ? TT1 : tile == 1 ? TT21 : TT2; f32x16 c;
#pragma unroll
            for (int g4 = 0; g4 < 4; ++g4) { const f32x4 sb = *(const LAS f32x4*)(SB + jt * 32 + 8 * g4 + 4 * hh);
#pragma unroll
                for (int e = 0; e < 4; ++e) c[4 * g4 + e] = TTx[4 * g4 + e] * sb[e]; }
            uA[tile][0] = pack8(c, 0); uA[tile][1] = pack8(c, 1); }
#pragma unroll
        for (int dvt = 0; dvt < 2; ++dvt) {
            const bf16x8 v00 = frag_perm(bufY, dvt * 32 + r, 0, 0, hh), v01 = frag_perm(bufY, dvt * 32 + r, 0, 1, hh), v10 = frag_perm(bufY, dvt * 32 + r, 32, 0, hh), v11 = frag_perm(bufY, dvt * 32 + r, 32, 1, hh);
            f32x16 u0 = MFMA32(uA[0][0], v00, zero16()); u0 = MFMA32(uA[0][1], v01, u0);
            f32x16 u1 = MFMA32(uA[1][0], v00, zero16()); u1 = MFMA32(uA[1][1], v01, u1); u1 = MFMA32(uA[2][0], v10, u1); u1 = MFMA32(uA[2][1], v11, u1);
            *(bf16x8*)(item + (F_U + 2 * (0 * 2 + dvt)) * 1024 + lane * 32) = pack8(u0, 0); *(bf16x8*)(item + (F_U + 2 * (0 * 2 + dvt)) * 1024 + lane * 32 + 16) = pack8(u0, 1);
            *(bf16x8*)(item + (F_U + 2 * (1 * 2 + dvt)) * 1024 + lane * 32) = pack8(u1, 0); *(bf16x8*)(item + (F_U + 2 * (1 * 2 + dvt)) * 1024 + lane * 32 + 16) = pack8(u1, 1); }
    }
    if (lane == 0) *(float*)(item + GL_OFF) = expf(Glast);
}
__device__ __forceinline__ void phase1(const Frame& F, const Args& A, int layer) {
    LAS unsigned char* wl = F.lds + F.wave * WV_BYTES;
    for (int it = F.gw; it < BATCH * 32 * DNH; it += F.NGW) { const int h = it & 3, cg = it >> 2; dn1_item(wl, A, layer, cg >> 5, h, cg & 31, F.lane); }
}
constexpr int SC_FRAG = 0, SC_FRAGB = 39936, SC_O = 2 * SC_FRAGB, SC_OB = 64 * 68 * 4;
static_assert(SC_O + 2 * SC_OB <= LDSCTL_OFF, "scan LDS");
struct ScanRegs { u32x4 v[19]; float gl; };
__device__ __forceinline__ void scan_fetch(ScanRegs& R, const unsigned char* item, int t128) {
#pragma unroll
    for (int i = 0; i < 19; ++i) R.v[i] = *(const u32x4*)(item + (t128 + 128 * i) * 16);
    R.gl = *(const float*)(item + GL_OFF);
}
__device__ __forceinline__ void scan_put(const ScanRegs& R, LAS unsigned char* dst, int t128) {
#pragma unroll
    for (int i = 0; i < 19; ++i) *(LAS u32x4*)(dst + (t128 + 128 * i) * 16) = R.v[i];
    if (t128 == 0) *(LAS float*)(dst + GL_OFF) = R.gl;
}
struct GateZ { u32x4 z0, z1; };
__device__ __forceinline__ void gate_fetch(GateZ& Z, const Args& A, int b, int h, int c, int gwv, int lane) {
    const int row = gwv * 16 + (lane >> 2), dq = lane & 3; const size_t m = (size_t)b * SEQ + c * 64 + row;
    const bf16_t* zp = (const bf16_t*)(A.ws + WS_A) + m * NPROJ + C_DZ + h * 64 + dq * 16; Z.z0 = *(const u32x4*)zp; Z.z1 = *(const u32x4*)(zp + 8);
}
__device__ __forceinline__ void gate_rows(const LAS unsigned char* ob, const Args& A, int layer, int b, int h, int c, int gwv, int lane, const GateZ& Z) {
    const int row = gwv * 16 + (lane >> 2), dq = lane & 3; const size_t m = (size_t)b * SEQ + c * 64 + row;
    const LAS f32x4* op = (const LAS f32x4*)(ob + (row * 68 + dq * 16) * 4);
    f32x4 o4[4]; float ss = 0.f;
#pragma unroll
    for (int k = 0; k < 4; ++k) { o4[k] = op[k]; ss += (o4[k].x * o4[k].x + o4[k].y * o4[k].y) + (o4[k].z * o4[k].z + o4[k].w * o4[k].w); }
    ss += __shfl_xor(ss, 1); ss += __shfl_xor(ss, 2);
    const float rs = rsqrtf(ss * (1.f / 64.f) + EPS);
    const float* gn = A.in[I_DN_ONORM] + layer * 64 + dq * 16;
    const unsigned zz[8] = {Z.z0.x, Z.z0.y, Z.z0.z, Z.z0.w, Z.z1.x, Z.z1.y, Z.z1.z, Z.z1.w};
    unsigned out[8];
#pragma unroll
    for (int k = 0; k < 8; ++k) { const float a = o4[k >> 1][(k & 1) * 2] * rs * gn[2 * k] * fsilu(bf2f(zz[k] & 0xffffu)), c2 = o4[k >> 1][(k & 1) * 2 + 1] * rs * gn[2 * k + 1] * fsilu(bf2f(zz[k] >> 16)); out[k] = cvtpk(a, c2); }
    bf16_t* mp = (bf16_t*)(A.ws + WS_MIXED) + m * D + h * 64 + dq * 16;
    *(u32x4*)mp = (u32x4){out[0], out[1], out[2], out[3]}; *(u32x4*)(mp + 8) = (u32x4){out[4], out[5], out[6], out[7]};
}
__device__ __forceinline__ void scan(const Frame& F, const Args& A, int layer, int pair) {
    const int b = pair >> 2, h = pair & 3, lane = F.lane, r = lane & 31, hh = lane >> 5, wv = F.wave;
    const unsigned char* items = A.ws + WS_SCR + (size_t)(pair * 32) * IT_BYTES;
    if (wv == 4 || wv == 5) {
        ScanRegs SR; const int t128 = (wv - 4) * 64 + lane;
        scan_fetch(SR, items, t128); scan_put(SR, F.lds + SC_FRAG, t128); scan_fetch(SR, items + IT_BYTES, t128);
        __syncthreads();
        for (int c = 0; c < 32; ++c) {
            if (c + 1 < 32) { scan_put(SR, F.lds + SC_FRAG + ((c + 1) & 1) * SC_FRAGB, t128); if (c + 2 < 32) scan_fetch(SR, items + (size_t)(c + 2) * IT_BYTES, t128); }
            __syncthreads(); }
        __syncthreads();
    } else if (wv >= 2) {
        const int gwv = wv < 4 ? wv - 2 : wv - 4;
        GateZ Z; gate_fetch(Z, A, b, h, 0, gwv, lane);
        __syncthreads();
        for (int c = 0; c < 32; ++c) { if (c > 0) { const GateZ Zc = Z; gate_fetch(Z, A, b, h, c, gwv, lane); gate_rows(F.lds + SC_O + ((c - 1) & 1) * SC_OB, A, layer, b, h, c - 1, gwv, lane, Zc); } __syncthreads(); }
        gate_rows(F.lds + SC_O + (31 & 1) * SC_OB, A, layer, b, h, 31, gwv, lane, Z);
        __syncthreads();
    } else {
        const int dvt = wv;
        f32x16 st[2]; st[0] = zero16(); st[1] = zero16();
        __syncthreads();
        for (int c = 0; c < 32; ++c) {
            const LAS unsigned char* fb = F.lds + SC_FRAG + (c & 1) * SC_FRAGB; LAS unsigned char* ob = F.lds + SC_O + (c & 1) * SC_OB;
            bf16x8 sB[2][2];
#pragma unroll
            for (int dkt = 0; dkt < 2; ++dkt) { sB[dkt][0] = pack8(st[dkt], 0); sB[dkt][1] = pack8(st[dkt], 1); }
            f32x16 vn[2], o[2];
#pragma unroll
            for (int it = 0; it < 2; ++it) { const LAS u32x4* up = (const LAS u32x4*)(fb + (F_U + 2 * (it * 2 + dvt)) * 1024 + lane * 32); const u32x4 a = up[0], c2 = up[1];
                const unsigned uu[8] = {a.x, a.y, a.z, a.w, c2.x, c2.y, c2.z, c2.w};
#pragma unroll
                for (int k = 0; k < 8; ++k) { vn[it][2 * k] = bf2f(uu[k] & 0xffffu); vn[it][2 * k + 1] = bf2f(uu[k] >> 16); }
                o[it] = zero16();
#pragma unroll
                for (int dkt = 0; dkt < 2; ++dkt)
#pragma unroll
                    for (int s = 0; s < 2; ++s) { vn[it] = MFMA32(*(const LAS bf16x8*)(fb + (F_W + it * 4 + dkt * 2 + s) * 1024 + lane * 16), sB[dkt][s], vn[it]);
                        o[it] = MFMA32(*(const LAS bf16x8*)(fb + (F_QD + it * 4 + dkt * 2 + s) * 1024 + lane * 16), sB[dkt][s], o[it]); } }
            bf16x8 vB[2][2];
#pragma unroll
            for (int tt = 0; tt < 2; ++tt) { vB[tt][0] = pack8(vn[tt], 0); vB[tt][1] = pack8(vn[tt], 1); }
#pragma unroll
            for (int s = 0; s < 2; ++s) { o[0] = MFMA32(*(const LAS bf16x8*)(fb + (F_QK + 0 + s) * 1024 + lane * 16), vB[0][s], o[0]);
                o[1] = MFMA32(*(const LAS bf16x8*)(fb + (F_QK + 2 + s) * 1024 + lane * 16), vB[0][s], o[1]);
                o[1] = MFMA32(*(const LAS bf16x8*)(fb + (F_QK + 4 + s) * 1024 + lane * 16), vB[1][s], o[1]); }
            const float gl = *(const LAS float*)(fb + GL_OFF);
#pragma unroll
            for (int dkt = 0; dkt < 2; ++dkt) {
#pragma unroll
                for (int i = 0; i < 16; ++i) st[dkt][i] *= gl;
#pragma unroll
                for (int tt = 0; tt < 2; ++tt)
#pragma unroll
                    for (int s = 0; s < 2; ++s) st[dkt] = MFMA32(*(const LAS bf16x8*)(fb + (F_KD + dkt * 4 + tt * 2 + s) * 1024 + lane * 16), vB[tt][s], st[dkt]); }
#pragma unroll
            for (int it = 0; it < 2; ++it)
#pragma unroll
                for (int i = 0; i < 16; ++i) *(LAS float*)(ob + ((it * 32 + crow(i, hh)) * 68 + dvt * 32 + r) * 4) = o[it][i];
            __syncthreads();
        }
        __syncthreads();
    }
}
}


namespace cv {
constexpr int TT = 128, ROWS = TT + 30;
__device__ __forceinline__ void tile(const Frame& F, const Args& A, int layer, int tidx) {
    const bf16_t* PROJ = (const bf16_t*)(A.ws + WS_A); bf16_t* MIXED = (bf16_t*)(A.ws + WS_MIXED);
    const int m0 = tidx * TT, s0 = m0 % SEQ, lane = F.lane;
    for (int rho = F.wave; rho < ROWS; rho += NWAVES) { u32x2 y = {0u, 0u};
        if (s0 - 30 + rho >= 0) { const bf16_t* row = PROJ + (size_t)(m0 - 30 + rho) * NPROJ; const u32x2 a = *((const u32x2*)(row + C_CU) + lane), g = *((const u32x2*)(row + C_CG) + lane);
            y.x = cvtpk(bf2f(a.x & 0xffffu) * __builtin_amdgcn_rcpf(1.f + __expf(-bf2f(g.x & 0xffffu))), bf2f(a.x >> 16) * __builtin_amdgcn_rcpf(1.f + __expf(-bf2f(g.x >> 16))));
            y.y = cvtpk(bf2f(a.y & 0xffffu) * __builtin_amdgcn_rcpf(1.f + __expf(-bf2f(g.y & 0xffffu))), bf2f(a.y >> 16) * __builtin_amdgcn_rcpf(1.f + __expf(-bf2f(g.y >> 16)))); }
        *(LAS u32x2*)(F.lds + rho * 512 + lane * 8) = y; }
    const float* dw = A.in[I_CV_DW] + (size_t)layer * CVK * CVW;
    LAS f32x4* wl = (LAS f32x4*)(F.lds + ROWS * 512);
    for (int i = F.tid; i < CVK * 64; i += NTHREADS) wl[i] = *((const f32x4*)dw + i);
    const f32x4 bias = *((const f32x4*)(A.in[I_CV_DWB] + layer * CVW) + lane), lg = *((const f32x4*)(A.in[I_CV_LNG] + layer * CVW) + lane), lb = *((const f32x4*)(A.in[I_CV_LNB] + layer * CVW) + lane);
    __syncthreads();
#pragma unroll 1
    for (int k = 0; k < TT / NWAVES; ++k) { const int tau = F.wave * (TT / NWAVES) + k; f32x4 acc = bias;
#pragma unroll
        for (int i = 0; i < CVK; ++i) { const u32x2 y = *(const LAS u32x2*)(F.lds + (tau + i) * 512 + lane * 8); const f32x4 w = wl[i * 64 + lane];
            acc.x += w.x * bf2f(y.x & 0xffffu); acc.y += w.y * bf2f(y.x >> 16); acc.z += w.z * bf2f(y.y & 0xffffu); acc.w += w.w * bf2f(y.y >> 16); }
        const float mean = wave_sum((acc.x + acc.y) + (acc.z + acc.w)) * (1.f / CVW);
        const f32x4 d = acc - mean; const float var = wave_sum((d.x * d.x + d.y * d.y) + (d.z * d.z + d.w * d.w)) * (1.f / CVW);
        const float rs = rsqrtf(var + EPS); const f32x4 yv = d * rs * lg + lb;
        u32x2 o; o.x = cvtpk(fsilu(yv.x), fsilu(yv.y)); o.y = cvtpk(fsilu(yv.z), fsilu(yv.w));
        *((u32x2*)(MIXED + (size_t)(m0 + tau) * D + 768) + lane) = o; }
    __syncthreads();
}
__device__ __forceinline__ void phase(const Frame& F, const Args& A, int layer) { for (int t = F.vcu; t < M / TT; t += F.G) tile(F, A, layer, t); }
}

__device__ __forceinline__ void phase_conf_naive(const Frame& F, const Args& A, int layer) {
    const bf16_t* PROJ = (const bf16_t*)(A.ws + WS_A); bf16_t* MIXED = (bf16_t*)(A.ws + WS_MIXED);
    const float* dw = A.in[I_CV_DW] + (size_t)layer * CVK * CVW;
    const f32x4 bias = *((const f32x4*)(A.in[I_CV_DWB] + layer * CVW) + F.lane), lg = *((const f32x4*)(A.in[I_CV_LNG] + layer * CVW) + F.lane), lb = *((const f32x4*)(A.in[I_CV_LNB] + layer * CVW) + F.lane);
    for (int m = F.gw; m < M; m += F.NGW) { const int s = m % SEQ;
        f32x4 acc = bias;
#pragma unroll 1
        for (int i = 0; i < CVK; ++i) { if (s - 30 + i < 0) continue;
            const u32x2 a = *((const u32x2*)(PROJ + (size_t)(m - 30 + i) * NPROJ + C_CU) + F.lane), g = *((const u32x2*)(PROJ + (size_t)(m - 30 + i) * NPROJ + C_CG) + F.lane);
            const f32x4 w = *((const f32x4*)(dw + i * CVW) + F.lane);
            acc.x += w.x * bf2f(a.x & 0xffffu) * sigm(bf2f(g.x & 0xffffu)); acc.y += w.y * bf2f(a.x >> 16) * sigm(bf2f(g.x >> 16));
            acc.z += w.z * bf2f(a.y & 0xffffu) * sigm(bf2f(g.y & 0xffffu)); acc.w += w.w * bf2f(a.y >> 16) * sigm(bf2f(g.y >> 16)); }
        const float mean = wave_sum((acc.x + acc.y) + (acc.z + acc.w)) * (1.f / CVW);
        const f32x4 d = acc - mean; const float var = wave_sum((d.x * d.x + d.y * d.y) + (d.z * d.z + d.w * d.w)) * (1.f / CVW);
        const float rs = rsqrtf(var + EPS); f32x4 y = d * rs * lg + lb;
        u32x2 w; w.x = pk2(siluf(y.x), siluf(y.y)); w.y = pk2(siluf(y.z), siluf(y.w));
        *((u32x2*)(MIXED + (size_t)m * D + 768) + F.lane) = w;
    }
}
__device__ __forceinline__ void phase_p4(const Frame& F, const Args& A, int layer) {
    unsigned char* ws = A.ws;
    const float* gffn = A.in[I_NORM_FFN] + layer * D;
    const float* rgw = A.in[I_RG_W] + (size_t)layer * D * NGRP; const float* rgb = A.in[I_RG_B] + layer * NGRP;
    const float* rew = A.in[I_RE_W] + (size_t)layer * D * NE; const float* reb = A.in[I_RE_B] + layer * NE;
    bf16_t* H = (bf16_t*)(ws + WS_H); unsigned char* H8 = ws + WS_MIXED; int* ltok = (int*)(ws + WS_LTOK); float* lgate = (float*)(ws + WS_LGATE);
    unsigned* cnt = F.ctl + CW_CNT + layer * NE * 16;
    LAS float* wgT = (LAS float*)F.lds; LAS float* weT = wgT + 4 * D;
    for (int idx = F.tid; idx < D; idx += NTHREADS) { const f32x4 w = *(const f32x4*)(rgw + (size_t)idx * NGRP); wgT[idx] = w.x; wgT[D + idx] = w.y; wgT[2 * D + idx] = w.z; wgT[3 * D + idx] = w.w; }
    for (int idx = F.tid; idx < D * 8; idx += NTHREADS) { const int k = idx & (D - 1), o4 = idx >> 10; const f32x4 w = *(const f32x4*)(rew + (size_t)k * NE + 4 * o4);
        weT[(4 * o4 + 0) * D + k] = w.x; weT[(4 * o4 + 1) * D + k] = w.y; weT[(4 * o4 + 2) * D + k] = w.z; weT[(4 * o4 + 3) * D + k] = w.w; }
    __syncthreads();
    f32x4 gv[4];
#pragma unroll
    for (int j = 0; j < 4; ++j) gv[j] = *((const f32x4*)gffn + F.lane + 64 * j);
    bool have_prev = false; int pe = 0, ptok = 0; unsigned ppos = 0u; float pg = 0.f;
    const float* xres = layer == 0 ? A.in[I_X] : A.out;
    f32x4 nv[4]; u32x2 nd[4];
    if (F.gw < M) { const f32x4* xr = (const f32x4*)(xres + (size_t)F.gw * D) + F.lane; const u32x2* dr = (const u32x2*)(H + (size_t)F.gw * D) + F.lane;
#pragma unroll
        for (int j = 0; j < 4; ++j) { nv[j] = xr[64 * j]; nd[j] = dr[64 * j]; } }
    for (int m = F.gw; m < M; m += F.NGW) {
        f32x4 v[4]; float s = 0.f;
#pragma unroll
        for (int j = 0; j < 4; ++j) { v[j] = nv[j]; v[j].x += bf2f(nd[j].x & 0xffffu); v[j].y += bf2f(nd[j].x >> 16); v[j].z += bf2f(nd[j].y & 0xffffu); v[j].w += bf2f(nd[j].y >> 16);
            s += (v[j].x * v[j].x + v[j].y * v[j].y) + (v[j].z * v[j].z + v[j].w * v[j].w); }
        { f32x4* xo = (f32x4*)(A.out + (size_t)m * D) + F.lane;
#pragma unroll
          for (int j = 0; j < 4; ++j) xo[64 * j] = v[j]; }
        { const int mn = (m + F.NGW < M) ? m + F.NGW : m; const f32x4* xr = (const f32x4*)(xres + (size_t)mn * D) + F.lane; const u32x2* dr = (const u32x2*)(H + (size_t)mn * D) + F.lane;
#pragma unroll
          for (int j = 0; j < 4; ++j) { nv[j] = xr[64 * j]; nd[j] = dr[64 * j]; } }
        const float rstd = rsqrtf(wave_sum(s) * (1.f / D) + EPS);
        int* ho = (int*)(H8 + (size_t)m * D) + F.lane;
        float gl[4]; f32x2 gl2[4] = {{0.f, 0.f}, {0.f, 0.f}, {0.f, 0.f}, {0.f, 0.f}};
#pragma unroll
        for (int j = 0; j < 4; ++j) { v[j] = v[j] * rstd * gv[j];
            { int w = __builtin_amdgcn_cvt_pk_fp8_f32(v[j].x, v[j].y, 0, false); w = __builtin_amdgcn_cvt_pk_fp8_f32(v[j].z, v[j].w, w, true); ho[64 * j] = w; }
#pragma unroll
            for (int o = 0; o < 4; ++o) { const f32x4 wv = *((const LAS f32x4*)(wgT + o * D) + F.lane + 64 * j); gl2[o] = __builtin_elementwise_fma((f32x2){v[j].x, v[j].y}, (f32x2){wv.x, wv.y}, gl2[o]); gl2[o] = __builtin_elementwise_fma((f32x2){v[j].z, v[j].w}, (f32x2){wv.z, wv.w}, gl2[o]); } }
#pragma unroll
        for (int o = 0; o < 4; ++o) gl[o] = gl2[o].x + gl2[o].y;
        { float t[4]; fold4(gl, t, F.lane);
#pragma unroll
          for (int o = 0; o < 4; ++o) gl[o] = t[o] + rgb[o]; }
        int gs = 0; float gm = gl[0];
#pragma unroll
        for (int o = 1; o < 4; ++o) if (gl[o] > gm) { gm = gl[o]; gs = o; }
        float den = 0.f;
#pragma unroll
        for (int o = 0; o < 4; ++o) den += __expf(gl[o] - gm);
        const float pgrp = 1.f / den;
        float el[8]; f32x2 el2[8];
#pragma unroll
        for (int o = 0; o < 8; ++o) el2[o] = (f32x2){0.f, 0.f};
        const LAS float* wsel = weT + gs * EPG * D;
#pragma unroll
        for (int j = 0; j < 4; ++j)
#pragma unroll
            for (int o = 0; o < 8; ++o) { const f32x4 wv = *((const LAS f32x4*)(wsel + o * D) + F.lane + 64 * j); el2[o] = __builtin_elementwise_fma((f32x2){v[j].x, v[j].y}, (f32x2){wv.x, wv.y}, el2[o]); el2[o] = __builtin_elementwise_fma((f32x2){v[j].z, v[j].w}, (f32x2){wv.z, wv.w}, el2[o]); }
#pragma unroll
        for (int o = 0; o < 8; ++o) el[o] = el2[o].x + el2[o].y;
        { float t[8]; fold8(el, t, F.lane);
#pragma unroll
          for (int o = 0; o < 8; ++o) el[o] = t[o] + reb[gs * EPG + o]; }
        int i0 = 0; float v0 = el[0];
#pragma unroll
        for (int o = 1; o < 8; ++o) if (el[o] > v0) { v0 = el[o]; i0 = o; }
        int i1 = -1; float v1 = -3.0e38f;
#pragma unroll
        for (int o = 0; o < 8; ++o) if (o != i0 && el[o] > v1) { v1 = el[o]; i1 = o; }
        const float e1 = __expf(v1 - v0), g0 = pgrp / (1.f + e1), g1 = pgrp * e1 / (1.f + e1);
        {
            if (have_prev && F.lane < 2) { ltok[(size_t)pe * M + ppos] = ptok; lgate[(size_t)pe * M + ppos] = pg; }
            if (F.lane < 2) { pe = gs * EPG + (F.lane == 0 ? i0 : i1); pg = F.lane == 0 ? g0 : g1; ptok = 2 * m + F.lane; ppos = atomicAdd(cnt + pe * 16, 1u); }
            have_prev = true;
        }
    }
    if (have_prev && F.lane < 2) { ltok[(size_t)pe * M + ppos] = ptok; lgate[(size_t)pe * M + ppos] = pg; }
    __syncthreads();
    REP(9) {
    LAS float* scr = (LAS float*)(F.lds + F.wave * TR_SCR);
    const float* eg = A.in[I_EX_GATE] + (size_t)layer * NE * D * DE; const float* eu = A.in[I_EX_UP] + (size_t)layer * NE * D * DE; const float* ed = A.in[I_EX_DOWN] + (size_t)layer * NE * DE * D;
    unsigned char* WGU = ws + WS_WGU; unsigned char* WD = ws + WS_WD;
    for (int it = F.gw; it < NE * 384; it += F.NGW) { const int e = it / 384, r = it % 384;
        if (r < 128) { const int kb = r / 8, nb = r % 8; transpose_item8(eg + (size_t)e * D * DE, DE, nb * 64, kb * 64, WGU + (size_t)e * 1024 * D, D, 2 * nb * 64, 2, scr, F.lane); }
        else if (r < 256) { const int q = r - 128, kb = q / 8, nb = q % 8; transpose_item8(eu + (size_t)e * D * DE, DE, nb * 64, kb * 64, WGU + (size_t)e * 1024 * D, D, 2 * nb * 64 + 1, 2, scr, F.lane); }
        else { const int q = r - 256, kb = q / 16, nb = q % 16; transpose_item8(ed + (size_t)e * DE * D, D, nb * 64, kb * 64, WD + (size_t)e * 1024 * DE, DE, nb * 64, 1, scr, F.lane); }
    }
    }
}
__device__ __forceinline__ void moe_tables(const Frame& F, int layer) {
    LAS int* cntL = (LAS int*)(F.lds + MOE_OFF); LAS int* hoffL = cntL + 32; LAS int* tstartL = hoffL + 32;
    __syncthreads();
    if (F.tid < NE) cntL[F.tid] = (int)__hip_atomic_load(F.ctl + CW_CNT + (layer * NE + F.tid) * 16, RLX_AGENT);
    __syncthreads();
    if (F.tid == 0) { int h = 0, t = 0; for (int e = 0; e < NE; ++e) { hoffL[e] = h; tstartL[e] = t; h += cntL[e]; t += (cntL[e] + 255) >> 8; } tstartL[NE] = t; }
    __syncthreads();
}
__device__ __forceinline__ void phase_final(const Frame& F, const Args& A) {
    const bf16_t* YS = (const bf16_t*)(A.ws + WS_A + 64 * MiB);
    for (int m0 = F.gw; m0 < M; m0 += 2 * F.NGW) {
        f32x4 v[2][4]; u32x2 a[2][4], b[2][4];
#pragma unroll
        for (int q = 0; q < 2; ++q) { const int m = m0 + q * F.NGW; if (m < M) { const f32x4* xr = (const f32x4*)(A.out + (size_t)m * D) + F.lane;
            const u32x2* y0 = (const u32x2*)(YS + (size_t)(2 * m) * D) + F.lane; const u32x2* y1 = (const u32x2*)(YS + (size_t)(2 * m + 1) * D) + F.lane;
#pragma unroll
            for (int j = 0; j < 4; ++j) { v[q][j] = xr[64 * j]; a[q][j] = y0[64 * j]; b[q][j] = y1[64 * j]; } } }
#pragma unroll
        for (int q = 0; q < 2; ++q) { const int m = m0 + q * F.NGW; if (m < M) { f32x4* xr = (f32x4*)(A.out + (size_t)m * D) + F.lane;
#pragma unroll
            for (int j = 0; j < 4; ++j) { f32x4 w = v[q][j];
                w.x += bf2f(a[q][j].x & 0xffffu) + bf2f(b[q][j].x & 0xffffu); w.y += bf2f(a[q][j].x >> 16) + bf2f(b[q][j].x >> 16);
                w.z += bf2f(a[q][j].y & 0xffffu) + bf2f(b[q][j].y & 0xffffu); w.w += bf2f(a[q][j].y >> 16) + bf2f(b[q][j].y >> 16); xr[64 * j] = w; } } }
    }
}

constexpr int PH_PER_LAYER = 9, N_PHASES = NLAYER * PH_PER_LAYER + 1;
__global__ void __launch_bounds__(NTHREADS, 2) hymba_fwd(Args args) {
    extern __shared__ __attribute__((aligned(16))) unsigned char lds_raw[];
    Frame F;
    F.lds = (LAS unsigned char*)lds_raw; F.MISC = (volatile LAS unsigned*)(F.lds + MISC_OFF);
    F.tid = threadIdx.x; F.lane = F.tid & 63; F.wave = __builtin_amdgcn_readfirstlane(F.tid >> 6);
    F.G = gridDim.x; { const int bx = blockIdx.x; F.vcu = (F.G % 8 == 0) ? (bx % 8) * (F.G / 8) + bx / 8 : bx; }
    F.gw = F.vcu * NWAVES + F.wave; F.NGW = F.G * NWAVES;
    F.ctl = (unsigned*)(args.ws + WS_CTL);
    for (int u = F.tid; u < (LDS_BYTES - LDSCTL_OFF) / 4; u += NTHREADS) ((LAS unsigned*)(F.lds + LDSCTL_OFF))[u] = 0u;
    __syncthreads();
    if (F.tid < 23) ((LAS unsigned long long*)(F.lds + PTR_OFF))[F.tid] = (unsigned long long)args.in[F.tid];
    __syncthreads();
    XcdBarrier bar; bar.bar = F.ctl + CW_BAR; bar.x = 0; bar.st = nullptr;
#if MK_ONE_LAUNCH
    bar = xcd_barrier_post(F.ctl + CW_BAR, F.MISC + 8, F.tid);
#define GRID_BAR() xcd_barrier(bar, Fp.wave * 64 + lane_id())
#else
#define GRID_BAR() do { } while (0)
#endif
    const int lo = args.ph_lo, hi = args.ph_hi;
    for (int ph = lo; ph < hi; ++ph) {
        Frame Fp = F; asm volatile("" : "+s"(Fp.wave)); Fp.tid = Fp.wave * 64 + lane_id(); asm volatile("" : "+v"(Fp.tid)); Fp.lane = Fp.tid & 63;
        asm volatile("" : "+s"(Fp.wave), "+s"(Fp.vcu), "+s"(Fp.G), "+s"(Fp.lds));
        Fp.gw = Fp.vcu * NWAVES + Fp.wave; Fp.NGW = Fp.G * NWAVES; Fp.MISC = (volatile LAS unsigned*)(Fp.lds + MISC_OFF);
        Args Ap; Ap.out = args.out; Ap.ws = args.ws; Ap.ph_lo = lo; Ap.ph_hi = hi;
        asm volatile("" : "+s"(Ap.out), "+s"(Ap.ws));
        unsigned char* ws = Ap.ws;
        int ptoff = PTR_OFF; asm volatile("" : "+s"(ptoff));
        const LAS unsigned char* ptab = Fp.lds + ptoff;
        Fp.ctl = (unsigned*)(Ap.ws + WS_CTL);
#pragma unroll
        for (int i = 0; i < 23; ++i) { const unsigned long long v = ((const LAS unsigned long long*)ptab)[i];
            const unsigned plo = __builtin_amdgcn_readfirstlane((unsigned)v), phi = __builtin_amdgcn_readfirstlane((unsigned)(v >> 32)); Ap.in[i] = (const float*)(((unsigned long long)phi << 32) | plo); }
        const int layer = ph / PH_PER_LAYER, p = ph % PH_PER_LAYER;
        if (ph == N_PHASES - 1) { phase_final(Fp, Ap); }
        else if (p == 0) { phase_p0(Fp, Ap, layer); if ((((PROBE_REP) >> 8) & 1) && layer == 0) phase_p0(Fp, Ap, layer); }
        else if (p == 1) {
            pg8::DenseSched<M / 256, NPROJ / 256> S{Fp.G, (int)blockIdx.x, D, (const bf16_t*)(ws + WS_WIN)};
            pg8::EpiProj E{(bf16_t*)(ws + WS_A), NPROJ};
            REP(0) pg8::gemm_phase<pg8::EpiProj, pg8::DenseSched<M / 256, NPROJ / 256>>(Fp.lds, ws + WS_H, D * 2, S, E, Fp.wave);
        }
        else if (p == 2) { REP(3) cv::phase(Fp, Ap, layer); att::phase_qknorm(Fp, Ap, layer); REP(4) dn::phase1(Fp, Ap, layer); }
        else if (p == 3) { if (blockIdx.x < 64) { dn::scan(Fp, Ap, layer, (int)blockIdx.x); if (((PROBE_REP) >> 1) & 1) dn::scan(Fp, Ap, layer, (int)blockIdx.x); } att::phase_a(Fp, Ap, Fp.ctl + CW_Q + layer * 16); }
        else if (p == 4) { REP(5) att::phase_b(Fp, Ap); }
        else if (p == 5) {
            pg8::DenseSched<M / 256, D / 256> S{Fp.G, (int)blockIdx.x, D, (const bf16_t*)(ws + WS_WOUT)};
            pg8::EpiProj E{(bf16_t*)(ws + WS_H), D};
            REP(10) pg8::gemm_phase<pg8::EpiProj, pg8::DenseSched<M / 256, D / 256>>(Fp.lds, ws + WS_MIXED, D * 2, S, E, Fp.wave);
        }
        else if (p == 6) { phase_p4(Fp, Ap, layer); }
        else if (p == 7) {
            moe_tables(Fp, layer);
            pg8::MoeSched<false> S; S.cntL = (const LAS int*)(Fp.lds + MOE_OFF); S.hoffL = S.cntL + 32; S.tstartL = S.hoffL + 32; S.G = Fp.G; S.vc = Fp.vcu;
            S.ltok = (const int*)(ws + WS_LTOK); S.Bt = (const unsigned char*)(ws + WS_WGU);
            pg8::EpiGU E{(unsigned char*)(ws + WS_A)};
            REP(6) pg8::gemm_phase<pg8::EpiGU, pg8::MoeSched<false>, true>(Fp.lds, ws + WS_MIXED, D, S, E, Fp.wave);
        }
        else {
            moe_tables(Fp, layer);
            pg8::MoeSched<true> S; S.cntL = (const LAS int*)(Fp.lds + MOE_OFF); S.hoffL = S.cntL + 32; S.tstartL = S.hoffL + 32; S.G = Fp.G; S.vc = Fp.vcu;
            S.ltok = (const int*)(ws + WS_LTOK); S.Bt = (const unsigned char*)(ws + WS_WD);
            pg8::EpiDown E{(bf16_t*)(ws + WS_A + 64 * MiB), (const int*)(ws + WS_LTOK), (const float*)(ws + WS_LGATE)};
            REP(7) pg8::gemm_phase<pg8::EpiDown, pg8::MoeSched<true>, true>(Fp.lds, ws + WS_A, DE, S, E, Fp.wave);
        }
        if (ph + 1 < hi) GRID_BAR();
    }
}

extern "C" void kernel_launch(void* const* d_in, const int* in_sizes, int n_in, void* d_out, int out_size, void* d_ws, size_t ws_size, hipStream_t stream) {
    static int grid = 0;
    if (grid == 0) {
        if (n_in != 23 || out_size != M * D || ws_size < WS_END) { fprintf(stderr, "kernel_launch: unexpected shapes (n_in %d out %d ws %zu)\n", n_in, out_size, ws_size); grid = -1; return; }
        int dev = 0, cus = 0, per_cu = 0;
        if (hipGetDevice(&dev) != hipSuccess || hipDeviceGetAttribute(&cus, hipDeviceAttributeMultiprocessorCount, dev) != hipSuccess) { grid = -1; return; }
        if (hipFuncSetAttribute((const void*)hymba_fwd, hipFuncAttributeMaxDynamicSharedMemorySize, LDS_BYTES) != hipSuccess) { fprintf(stderr, "kernel_launch: hipFuncSetAttribute failed\n"); grid = -1; return; }
        if (hipOccupancyMaxActiveBlocksPerMultiprocessor(&per_cu, (const void*)hymba_fwd, NTHREADS, LDS_BYTES) != hipSuccess || per_cu < 1) { fprintf(stderr, "kernel_launch: occupancy query says %d\n", per_cu); per_cu = 1; }
        (void)hipGetLastError();
        grid = cus;
    }
    if (grid < 0) return;
    (void)hipMemsetAsync((char*)d_ws + WS_CTL, 0, CTL_ZERO_BYTES, stream);
    Args a{};
    for (int i = 0; i < 23; ++i) a.in[i] = (const float*)d_in[i];
    a.out = (float*)d_out; a.ws = (unsigned char*)d_ws;
#if MK_ONE_LAUNCH
    a.ph_lo = 0; a.ph_hi = N_PHASES;
    void* kargs[] = {&a};
    hipError_t e = hipLaunchCooperativeKernel((const void*)hymba_fwd, dim3(grid), dim3(NTHREADS), kargs, LDS_BYTES, stream);
    if (e != hipSuccess) fprintf(stderr, "kernel_launch: cooperative launch failed: %s (grid %d)\n", hipGetErrorString(e), grid);
#else
    for (int ph = 0; ph < N_PHASES; ++ph) { a.ph_lo = ph; a.ph_hi = ph + 1;
        hipLaunchKernelGGL(hymba_fwd, dim3(grid), dim3(NTHREADS), LDS_BYTES, stream, a); }
#endif
}
```
